# Optimizing an MI355X kernel written in HIP

```python
import math
import jax, jax.numpy as jnp
from jax import lax
import numpy as np

D_MODEL = 1024
BATCH = 2
SEQ = 8192
DEPTH = 1
DEC_BATCH = 128
DEC_SEQ = 4
PAST_LEN = 8192
PAGE_SIZE = 128

SSM_HEADS = 16
SSM_HEAD_DIM = 64
SSM_WIDTH = SSM_HEADS * SSM_HEAD_DIM
SSM_GROUPS = 2
SSM_STATE = 128
CONV_WIDTH = 4
CONV_DIM = SSM_WIDTH + 2 * SSM_GROUPS * SSM_STATE
SSD_CHUNK = 128
DT_MIN = 0.001
DT_MAX = 0.1
ATTN_HEADS = 16
ATTN_KV_HEADS = 4
Q_PER_KV = ATTN_HEADS // ATTN_KV_HEADS
ATTN_HEAD_DIM = 64
ATTN_WIDTH = ATTN_HEADS * ATTN_HEAD_DIM
KV_WIDTH = ATTN_KV_HEADS * ATTN_HEAD_DIM
WINDOW = 128
ATTN_BLOCK = 128
ATTN_SCALE = ATTN_HEAD_DIM ** -0.5
REL_BUCKETS = 32
REL_MAX_DIST = 128
MIX_WIDTH = SSM_WIDTH + ATTN_WIDTH
IN_WIDTH = SSM_WIDTH + CONV_DIM + SSM_HEADS + ATTN_WIDTH + 2 * KV_WIDTH + ATTN_WIDTH
EPS = 1e-6

kernel_name = "hymba_ssd_swa_sink_decode_step"


def rmsnorm(x, w):
    xf = x.astype(jnp.float32)
    y = xf * lax.rsqrt(jnp.mean(xf * xf, axis=-1, keepdims=True) + EPS)
    return (y * w.astype(jnp.float32)).astype(x.dtype)


def rel_bucket(dist):
    max_exact = REL_BUCKETS // 2
    d_f = jnp.maximum(dist, 1).astype(jnp.float32)
    large = max_exact + (jnp.log(d_f / max_exact) / math.log(REL_MAX_DIST / max_exact)
                         * (REL_BUCKETS - max_exact)).astype(jnp.int32)
    return jnp.where(dist < max_exact, dist, jnp.minimum(large, REL_BUCKETS - 1))


def band_bias_mask(dist, rel_table):
    mask = (dist >= 0) & (dist <= WINDOW)
    bias = rel_table[rel_bucket(jnp.clip(dist, 0, WINDOW))].astype(jnp.float32)
    bias = jnp.transpose(bias, (2, 0, 1)).reshape(ATTN_KV_HEADS, Q_PER_KV, dist.shape[0], dist.shape[1])
    return bias, mask


def sink_attention(q, k, v, bias, mask, sinks):
    s = jnp.einsum("...qngd,...snd->...ngqs", q, k).astype(jnp.float32) * ATTN_SCALE + bias
    s = jnp.where(mask, s, -jnp.inf)
    sink = jnp.broadcast_to(sinks.astype(jnp.float32).reshape(ATTN_KV_HEADS, Q_PER_KV, 1, 1),
                            s.shape[:-1] + (1,))
    p = jax.nn.softmax(jnp.concatenate([s, sink], axis=-1), axis=-1)[..., :-1]
    return jnp.einsum("...ngqs,...snd->...qngd", p.astype(v.dtype), v)


def window_attention_prompt(q, k, v, sinks, rel_table):
    b, l = q.shape[:2]
    T = ATTN_BLOCK
    nb = l // T
    qb = q.reshape(b, nb, T, ATTN_KV_HEADS, Q_PER_KV, ATTN_HEAD_DIM)

    def with_prev(t):
        t = t.reshape(b, nb, T, ATTN_KV_HEADS, ATTN_HEAD_DIM)
        prev = jnp.concatenate([jnp.zeros_like(t[:, :1]), t[:, :-1]], axis=1)
        return jnp.concatenate([prev, t], axis=2)

    kpos = jnp.arange(2 * T) - T
    dist = jnp.arange(T)[:, None] - kpos[None, :]
    bias, mask = band_bias_mask(dist, rel_table)
    first_ok = (jnp.arange(nb)[:, None, None] > 0) | (kpos >= 0)[None, None, :]
    mask = (mask[None] & first_ok)[:, None, None]
    o = sink_attention(qb, with_prev(k), with_prev(v), bias, mask, sinks)
    return o.reshape(b, l, ATTN_WIDTH)


def window_attention_sample(q, k, v, k_prev, v_prev, sinks, rel_table):
    b, l = q.shape[:2]
    keys = jnp.concatenate([k_prev, k], axis=1)
    vals = jnp.concatenate([v_prev, v], axis=1)
    dist = (jnp.arange(l) + WINDOW)[:, None] - jnp.arange(WINDOW + l)[None, :]
    bias, mask = band_bias_mask(dist, rel_table)
    o = sink_attention(q.reshape(b, l, ATTN_KV_HEADS, Q_PER_KV, ATTN_HEAD_DIM), keys, vals, bias, mask, sinks)
    return o.reshape(b, l, ATTN_WIDTH), keys[:, -WINDOW:], vals[:, -WINDOW:]


def causal_dwconv(u, prev, w, bias):
    full = jnp.concatenate([prev, u], axis=1)
    l = u.shape[1]
    out = bias + full[:, 0:l] * w[0]
    for tap in range(1, CONV_WIDTH):
        out = out + full[:, tap:tap + l] * w[tap]
    return jax.nn.silu(out), full[:, -(CONV_WIDTH - 1):]


def ssd_chunked(x, dt, A, B, C, init_state, chunk):
    b, l, h, p = x.shape
    g, n = B.shape[-2:]
    e = h // g
    c = l // chunk
    f32 = jnp.float32
    xc = x.reshape(b, c, chunk, g, e, p).astype(f32)
    dtc = dt.reshape(b, c, chunk, g, e)
    Bc = B.reshape(b, c, chunk, g, n).astype(f32)
    Cc = C.reshape(b, c, chunk, g, n).astype(f32)
    a_cum = jnp.cumsum(dtc * A.reshape(g, e), axis=2)
    xdt = xc * dtc[..., None]
    causal = jnp.tril(jnp.ones((chunk, chunk), bool))[None, None, :, :, None, None]
    seg = a_cum[:, :, :, None] - a_cum[:, :, None, :]
    decay = jnp.exp(jnp.where(causal, seg, -jnp.inf))
    cb = jnp.einsum("bclgn,bcsgn->bclsg", Cc, Bc)
    y_diag = jnp.einsum("bclsg,bclsge,bcsgep->bclgep", cb, decay, xdt)
    decay_to_end = jnp.exp(a_cum[:, :, -1:] - a_cum)
    chunk_states = jnp.einsum("bclgn,bclge,bclgep->bcgepn", Bc, decay_to_end, xdt)
    chunk_decay = jnp.exp(a_cum[:, :, -1])

    def step(carry, inp):
        st, dec = inp
        return carry * dec[..., None, None] + st, carry

    final, prev = lax.scan(step, init_state.reshape(b, g, e, p, n).astype(f32),
                           (jnp.swapaxes(chunk_states, 0, 1), jnp.swapaxes(chunk_decay, 0, 1)))
    prev = jnp.swapaxes(prev, 0, 1)
    y_off = jnp.einsum("bclgn,bcgepn,bclge->bclgep", Cc, prev, jnp.exp(a_cum))
    y = (y_diag + y_off).reshape(b, l, h, p)
    return y, final.reshape(b, h, p, n).astype(init_state.dtype)


def hybrid_layer(x, conv_prev, ssm_prev, k_prev, v_prev, norm_w, w_in, conv_w, conv_b, dt_bias,
                 a_log, d_skip, ssm_norm_w, q_norm_w, k_norm_w, sinks, rel_table, w_out):
    is_prompt = k_prev is None
    b, l, _ = x.shape
    f32 = jnp.float32
    h = rmsnorm(x, norm_w)
    u = jnp.einsum("bld,de->ble", h, w_in)
    sizes = (SSM_WIDTH, CONV_DIM, SSM_HEADS, ATTN_WIDTH, KV_WIDTH, KV_WIDTH, ATTN_WIDTH)
    z_ssm, xbc, dt_raw, q, k, v, z_attn = jnp.split(u, np.cumsum(sizes)[:-1].tolist(), axis=-1)

    xbc, conv_new = causal_dwconv(xbc, conv_prev, conv_w, conv_b)
    xs, Bm, Cm = jnp.split(xbc, [SSM_WIDTH, SSM_WIDTH + SSM_GROUPS * SSM_STATE], axis=-1)
    xs = xs.reshape(b, l, SSM_HEADS, SSM_HEAD_DIM)
    Bm = Bm.reshape(b, l, SSM_GROUPS, SSM_STATE)
    Cm = Cm.reshape(b, l, SSM_GROUPS, SSM_STATE)
    dt = jax.nn.softplus(dt_raw.astype(f32) + dt_bias.astype(f32))
    A = -jnp.exp(a_log.astype(f32))
    chunk = SSD_CHUNK if is_prompt else l
    y, ssm_new = ssd_chunked(xs, dt, A, Bm, Cm, ssm_prev, chunk)
    y = y + d_skip.astype(f32)[:, None] * xs.astype(f32)
    gy = (y.reshape(b, l, SSM_WIDTH) * jax.nn.silu(z_ssm.astype(f32)))
    gy = gy.reshape(b, l, SSM_GROUPS, SSM_WIDTH // SSM_GROUPS)
    gy = gy * lax.rsqrt(jnp.mean(gy * gy, axis=-1, keepdims=True) + EPS)
    y_ssm = (gy.reshape(b, l, SSM_WIDTH) * ssm_norm_w.astype(f32)).astype(x.dtype)

    q = rmsnorm(q.reshape(b, l, ATTN_HEADS, ATTN_HEAD_DIM), q_norm_w)
    k = rmsnorm(k.reshape(b, l, ATTN_KV_HEADS, ATTN_HEAD_DIM), k_norm_w)
    v = v.reshape(b, l, ATTN_KV_HEADS, ATTN_HEAD_DIM)
    if is_prompt:
        o = window_attention_prompt(q, k, v, sinks, rel_table)
        k_new, v_new = k[:, -WINDOW:], v[:, -WINDOW:]
    else:
        o, k_new, v_new = window_attention_sample(q, k, v, k_prev, v_prev, sinks, rel_table)
    y_attn = o * jax.nn.silu(z_attn)

    out = jnp.einsum("ble,ed->bld", jnp.concatenate([y_ssm, y_attn], axis=-1), w_out)
    return x + out, conv_new, ssm_new, k_new, v_new


def setup_inputs(seed: int = 0) -> dict:
    key = jax.random.key(seed)
    ks = jax.random.split(key, 20)
    f32 = jnp.float32
    nrm = jax.random.normal
    x_prompt = nrm(ks[0], (BATCH, SEQ, D_MODEL), f32)
    x_sample = nrm(ks[1], (DEC_BATCH, DEC_SEQ, D_MODEL), f32)
    cache_k = nrm(ks[2], (DEPTH, DEC_BATCH, WINDOW, ATTN_KV_HEADS, ATTN_HEAD_DIM), f32)
    cache_v = nrm(ks[3], (DEPTH, DEC_BATCH, WINDOW, ATTN_KV_HEADS, ATTN_HEAD_DIM), f32)
    state_ssm = 0.1 * nrm(ks[4], (DEPTH, DEC_BATCH, SSM_HEADS, SSM_HEAD_DIM, SSM_STATE), f32)
    state_conv = nrm(ks[5], (DEPTH, DEC_BATCH, CONV_WIDTH - 1, CONV_DIM), f32)
    norm_w = 1.0 + 0.02 * nrm(ks[6], (DEPTH, D_MODEL), f32)
    w_in = nrm(ks[7], (DEPTH, D_MODEL, IN_WIDTH), f32) * D_MODEL ** -0.5
    conv_w = nrm(ks[8], (DEPTH, CONV_WIDTH, CONV_DIM), f32) * CONV_WIDTH ** -0.5
    conv_b = 0.02 * nrm(ks[9], (DEPTH, CONV_DIM), f32)
    dt0 = jnp.exp(jax.random.uniform(ks[10], (DEPTH, SSM_HEADS), f32, math.log(DT_MIN), math.log(DT_MAX)))
    dt_bias = dt0 + jnp.log(-jnp.expm1(-dt0))
    a_log = jnp.log(jax.random.uniform(ks[11], (DEPTH, SSM_HEADS), f32, 1.0, 16.0))
    d_skip = 1.0 + 0.1 * nrm(ks[12], (DEPTH, SSM_HEADS), f32)
    ssm_norm_w = 1.0 + 0.02 * nrm(ks[13], (DEPTH, SSM_WIDTH), f32)
    q_norm_w = 1.0 + 0.02 * nrm(ks[14], (DEPTH, ATTN_HEAD_DIM), f32)
    k_norm_w = 1.0 + 0.02 * nrm(ks[15], (DEPTH, ATTN_HEAD_DIM), f32)
    sinks = 0.5 * nrm(ks[16], (DEPTH, ATTN_HEADS), f32)
    rel_table = 0.1 * nrm(ks[17], (REL_BUCKETS, ATTN_HEADS), f32)
    w_out = nrm(ks[18], (DEPTH, MIX_WIDTH, D_MODEL), f32) * MIX_WIDTH ** -0.5
    return {"x_prompt": x_prompt, "x_sample": x_sample, "cache_k": cache_k, "cache_v": cache_v,
            "state_ssm": state_ssm, "state_conv": state_conv, "norm_w": norm_w, "w_in": w_in,
            "conv_w": conv_w, "conv_b": conv_b, "dt_bias": dt_bias, "a_log": a_log, "d_skip": d_skip,
            "ssm_norm_w": ssm_norm_w, "q_norm_w": q_norm_w, "k_norm_w": k_norm_w, "sinks": sinks,
            "rel_table": rel_table, "w_out": w_out}


def reference(x_prompt, x_sample, cache_k, cache_v, state_ssm, state_conv, norm_w, w_in, conv_w, conv_b,
              dt_bias, a_log, d_skip, ssm_norm_w, q_norm_w, k_norm_w, sinks, rel_table, w_out):
    yp, ys = x_prompt, x_sample
    kp_l, vp_l, sp_l, cp_l = [], [], [], []
    ks_l, vs_l, ss_l, cs_l = [], [], [], []
    for layer in range(DEPTH):
        lw = dict(norm_w=norm_w[layer], w_in=w_in[layer], conv_w=conv_w[layer], conv_b=conv_b[layer],
                  dt_bias=dt_bias[layer], a_log=a_log[layer], d_skip=d_skip[layer],
                  ssm_norm_w=ssm_norm_w[layer], q_norm_w=q_norm_w[layer], k_norm_w=k_norm_w[layer],
                  sinks=sinks[layer], rel_table=rel_table, w_out=w_out[layer])
        conv0 = jnp.zeros((yp.shape[0], CONV_WIDTH - 1, CONV_DIM), yp.dtype)
        ssm0 = jnp.zeros((yp.shape[0], SSM_HEADS, SSM_HEAD_DIM, SSM_STATE), yp.dtype)
        yp, cp, sp, kp, vp = hybrid_layer(yp, conv0, ssm0, None, None, **lw)
        ys, cs, ss, kss, vss = hybrid_layer(ys, state_conv[layer], state_ssm[layer],
                                            cache_k[layer], cache_v[layer], **lw)
        kp_l.append(kp); vp_l.append(vp); sp_l.append(sp); cp_l.append(cp)
        ks_l.append(kss); vs_l.append(vss); ss_l.append(ss); cs_l.append(cs)
    return (yp, ys, jnp.stack(kp_l), jnp.stack(vp_l), jnp.stack(sp_l), jnp.stack(cp_l),
            jnp.stack(ks_l), jnp.stack(vs_l), jnp.stack(ss_l), jnp.stack(cs_l))
```

```cpp
#include <hip/hip_runtime.h>
#include <cstdio>
#include <cstdint>

#ifndef MK_N_LAUNCHES
#define MK_N_LAUNCHES 6
#endif

#define LAS __attribute__((address_space(3)))
#define GAS __attribute__((address_space(1)))
typedef unsigned short bf16_t;
typedef short bf16x8 __attribute__((ext_vector_type(8)));
typedef short bf16x4 __attribute__((ext_vector_type(4)));
typedef float f32x4 __attribute__((ext_vector_type(4)));
typedef float f32x2 __attribute__((ext_vector_type(2)));
typedef unsigned u32x4 __attribute__((ext_vector_type(4)));
typedef unsigned u32x2 __attribute__((ext_vector_type(2)));

constexpr int DM = 1024, SEQ = 8192, NB = 2, MP = NB * SEQ;
constexpr int DB = 128, DL = 4, MS = DB * DL, MT = MP + MS;
constexpr int NIN = 5136, NINP = 5376;
constexpr int UW = 5120;
constexpr int C_Z = 0, C_X = 1024, C_B = 2048, C_C = 2304, C_Q = 2560, C_K = 3584, C_V = 3840, C_ZA = 4096;
constexpr int CONVD = 1536;
constexpr float EPS = 1e-6f;
constexpr float LOG2E = 1.4426950408889634f;

constexpr size_t MiB = 1u << 20;
constexpr size_t WS_CTL = 0, CTL_ZERO_BYTES = 1 * MiB;
constexpr size_t WS_WIN = 1 * MiB;
constexpr size_t WS_WOUT = 12 * MiB;
constexpr size_t WS_DT = 16 * MiB;
constexpr size_t WS_DEC = 17 * MiB + 512 * 1024;
constexpr size_t WS_U = 18 * MiB;
constexpr size_t WS_H = 183 * MiB;
constexpr size_t WS_ST = 183 * MiB;
constexpr size_t WS_END = 247 * MiB;
constexpr int CW_BAR = 4096;

constexpr size_t O_YP = 0, O_YS = 16777216, O_KP = 17301504, O_VP = 17367040, O_SP = 17432576, O_CP = 17694720,
                 O_KS = 17703936, O_VS = 21898240, O_SS = 26092544, O_CS = 42869760, O_END = 43459584;

__device__ __forceinline__ unsigned f2bf(float f) { unsigned u = __builtin_bit_cast(unsigned, f); return (u + 0x7fffu + ((u >> 16) & 1u)) >> 16; }
__device__ __forceinline__ unsigned pk2(float lo, float hi) { return f2bf(lo) | (f2bf(hi) << 16); }
__device__ __forceinline__ float bf2f(unsigned v) { return __builtin_bit_cast(float, v << 16); }
__device__ __forceinline__ float bflo(unsigned w) { return __builtin_bit_cast(float, w << 16); }
__device__ __forceinline__ float bfhi(unsigned w) { return __builtin_bit_cast(float, w & 0xffff0000u); }
__device__ __forceinline__ float silu_f(float x) { return x * __builtin_amdgcn_rcpf(1.0f + __expf(-x)); }
__device__ __forceinline__ float softplus_f(float x) { return fmaxf(x, 0.f) + log1pf(__expf(-fabsf(x))); }
__device__ __forceinline__ float wave_sum(float v) {
#pragma unroll
    for (int o = 1; o < 64; o <<= 1) v += __shfl_xor(v, o);
    return v;
}
__device__ __forceinline__ f32x4 mfma16(bf16x8 a, bf16x8 b, f32x4 c) { return __builtin_amdgcn_mfma_f32_16x16x32_bf16(a, b, c, 0, 0, 0); }
#define LDS_WAIT() asm volatile("s_waitcnt lgkmcnt(0)" ::: "memory")
#define VM_WAIT() asm volatile("s_waitcnt vmcnt(0)" ::: "memory")

namespace pg8 {
constexpr int BM = 256, BK = 64, HALF = 128, HTB = HALF * BK * 2, STAGE_BYTES = 8 * HTB, NXCD = 8, WGM = 8;
__host__ __device__ __forceinline__ int lds_byte(int r, int c) { const int st = (r >> 4) * 2 + (c >> 5), rr = r & 15, cc = c & 31, ob = rr * 64 + cc * 2; return st * 1024 + (ob ^ (((ob >> 9) & 1) << 5)); }
__host__ __device__ __forceinline__ void stage_rc(int b, int& R, int& C) { const int st = b / 1024, sb = b % 1024, swz = sb ^ (((sb >> 9) & 1) << 5); R = (st >> 1) * 16 + swz / 64; C = (st & 1) * 32 + (swz % 64) / 2; }
__host__ __device__ __forceinline__ int perm32(int rho) { const int n = rho >> 4, i = rho & 15; return 8 * (i >> 2) + 4 * n + (i & 3); }

struct Unit { int pm, pn; };
struct Gemm { const bf16_t* A; const bf16_t* Bt; int M, N, K, lda, kseg; size_t segskip; };

struct StaticOrder {
    int nM, nN, nwg, G, c;
    __host__ __device__ void init(int M, int N, int G_, int c_) { nM = M / BM; nN = N / BM; nwg = nM * nN; G = G_; c = c_; }
    __host__ __device__ bool next(int i, Unit& u) const {
        const long L = (long)i * G + c; if (L >= nwg) return false;
        int wgid = (int)L; { const int q = nwg / NXCD, r = nwg % NXCD, xcd = wgid % NXCD, off = wgid / NXCD; wgid = (xcd < r ? xcd * (q + 1) : r * (q + 1) + (xcd - r) * q) + off; }
        const int nig = WGM * nN, gid = wgid / nig, fm = gid * WGM, gsz = (nM - fm) < WGM ? (nM - fm) : WGM;
        u.pm = fm + ((wgid % nig) % gsz); u.pn = (wgid % nig) / gsz; return true;
    }
};

__device__ __forceinline__ unsigned cvt_pk_bf16(float lo, float hi) { unsigned r; asm volatile("v_cvt_pk_bf16_f32 %0, %1, %2" : "=v"(r) : "v"(lo), "v"(hi)); return r; }

struct EpiU {
    static constexpr bool PERM = true;
    bf16_t* U; float* DT;
    __device__ __forceinline__ void operator()(const f32x4 (&acc)[2][2][4][2], const Unit& u, int wr, int wc, int fr, int fq) const {
        const int row0 = u.pm * BM + wr * 64 + fr;
        if (u.pn < 20) {
            const int col0 = u.pn * BM + wc * 32 + 8 * fq;
#pragma unroll
            for (int ai = 0; ai < 2; ++ai)
#pragma unroll
                for (int m = 0; m < 4; ++m) { bf16_t* rowp = U + (size_t)(row0 + ai * HALF + m * 16) * UW + col0;
#pragma unroll
                    for (int bj = 0; bj < 2; ++bj) { const f32x4 v0 = acc[ai][bj][m][0], v1 = acc[ai][bj][m][1];
                        u32x4 w; w.x = cvt_pk_bf16(v0[0], v0[1]); w.y = cvt_pk_bf16(v0[2], v0[3]); w.z = cvt_pk_bf16(v1[0], v1[1]); w.w = cvt_pk_bf16(v1[2], v1[3]);
                        *(u32x4*)(rowp + bj * HALF) = w; } }
        } else if (wc == 0 && fq < 2) {
#pragma unroll
            for (int ai = 0; ai < 2; ++ai)
#pragma unroll
                for (int m = 0; m < 4; ++m) { float* rowp = DT + (size_t)(row0 + ai * HALF + m * 16) * 16 + 8 * fq;
                    *(f32x4*)(rowp) = acc[ai][0][m][0]; *(f32x4*)(rowp + 4) = acc[ai][0][m][1]; }
        }
    }
};
struct EpiOut {
    static constexpr bool PERM = false;
    const float* xp; const float* xs; float* out;
    __device__ __forceinline__ void operator()(const f32x4 (&acc)[2][2][4][2], const Unit& u, int wr, int wc, int fr, int fq) const {
        const int col0 = u.pn * BM + wc * 32 + 4 * fq;
#pragma unroll
        for (int ai = 0; ai < 2; ++ai)
#pragma unroll
            for (int m = 0; m < 4; ++m) { const int row = u.pm * BM + ai * HALF + wr * 64 + m * 16 + fr;
                const float* xb = (row < MP) ? xp + (size_t)row * DM : xs + (size_t)(row - MP) * DM; float* ob = out + (size_t)row * DM;
#pragma unroll
                for (int bj = 0; bj < 2; ++bj)
#pragma unroll
                    for (int n = 0; n < 2; ++n) { const int c = col0 + bj * HALF + n * 16; const f32x4 xv = *(const f32x4*)(xb + c); *(f32x4*)(ob + c) = xv + acc[ai][bj][m][n]; } }
    }
};

template <class Epi, class Sched, bool ALIGN_EPI>
__device__ __forceinline__ void gemm_phase(LAS unsigned char* lds, const Gemm g, const Sched& S, const Epi& E) {
    const int tid = threadIdx.x, wid = __builtin_amdgcn_readfirstlane(tid >> 6), lane = tid & 63, wr = wid >> 2, wc = wid & 3, fr = lane & 15, fq = lane >> 4;
    const int K = g.K, nt = K / BK, lda = g.lda, kseg = g.kseg;
    unsigned voffA[2], voffB[2];
#pragma unroll
    for (int i = 0; i < 2; ++i) { int R, C; stage_rc(tid * 16 + i * 8192, R, C); const int Rb = Epi::PERM ? ((R & ~31) + perm32(R & 31)) : R;
        voffA[i] = (unsigned)(R * lda + C) * 2u; voffB[i] = (unsigned)(Rb * K + C) * 2u; }
    const size_t kstep = (size_t)(BK * 2);
    const size_t hstepA = (size_t)HALF * lda * 2, tstepA = 2 * hstepA;
    const size_t hstepB = (size_t)HALF * K * 2, tstepB = 2 * hstepB;
    const size_t segskip = g.segskip;
#define KOFFA(t) ((size_t)(t) * kstep + (((t) >= kseg) ? segskip : (size_t)0))
    const unsigned ldsw = (unsigned)wid * 1024u;
    const int aoff = lds_byte(wr * 64 + fr, fq * 8), boff = lds_byte(wc * 32 + fr, fq * 8);
#define PG8_SA(b, h) (((b) * 2 + (h)) * HTB)
#define PG8_SB(b, h) ((4 + (b) * 2 + (h)) * HTB)
#define PG8_STAGE(bufoff, gbase, voff) do { _Pragma("unroll") for (int _i = 0; _i < 2; ++_i) \
        __builtin_amdgcn_global_load_lds((const unsigned*)((const char*)(gbase) + (voff)[_i]), (LAS unsigned*)(lds + (bufoff) + ldsw + _i * 8192), 16, 0, 0); } while (0)
#define PG8_LDA(dst, b, h) do { _Pragma("unroll") for (int m = 0; m < 4; ++m) _Pragma("unroll") for (int k = 0; k < 2; ++k) dst[m][k] = *(const LAS bf16x8*)(lds + PG8_SA(b, h) + aoff + m * 2048 + k * 1024); } while (0)
#define PG8_LDB(dst, b, h) do { _Pragma("unroll") for (int n = 0; n < 2; ++n) _Pragma("unroll") for (int k = 0; k < 2; ++k) dst[n][k] = *(const LAS bf16x8*)(lds + PG8_SB(b, h) + boff + n * 2048 + k * 1024); } while (0)
#define PG8_MMA(ai, bj, At, Bt) do { __builtin_amdgcn_s_setprio(1); _Pragma("unroll") for (int m = 0; m < 4; ++m) _Pragma("unroll") for (int n = 0; n < 2; ++n) _Pragma("unroll") for (int k = 0; k < 2; ++k) \
        acc[ai][bj][m][n] = __builtin_amdgcn_mfma_f32_16x16x32_bf16(Bt[n][k], At[m][k], acc[ai][bj][m][n], 0, 0, 0); __builtin_amdgcn_s_setprio(0); } while (0)
#define PG8_WAIT_V(n) asm volatile("s_waitcnt vmcnt(" #n ")" ::: "memory")
#define PG8_WAIT_L(n) asm volatile("s_waitcnt lgkmcnt(" #n ")" ::: "memory")
#define PG8_BAR __builtin_amdgcn_s_barrier()
#define PG8_SCHED __builtin_amdgcn_sched_barrier(0)
    Unit cur, nxt; int ui = 0;
    if (!S.next(0, cur)) return;
    f32x4 acc[2][2][4][2];
#pragma unroll
    for (int a = 0; a < 2; ++a)
#pragma unroll
        for (int b = 0; b < 2; ++b)
#pragma unroll
            for (int m = 0; m < 4; ++m)
#pragma unroll
                for (int n = 0; n < 2; ++n) acc[a][b][m][n] = (f32x4){0.f, 0.f, 0.f, 0.f};
    bf16x8 At[4][2], B0[2][2], B1[2][2];
    const char* cA = (const char*)g.A + (size_t)cur.pm * tstepA; const char* cB = (const char*)g.Bt + (size_t)cur.pn * tstepB;
    PG8_STAGE(PG8_SB(0, 0), cB, voffB); PG8_STAGE(PG8_SB(0, 1), cB + hstepB, voffB); PG8_STAGE(PG8_SA(0, 0), cA, voffA); PG8_STAGE(PG8_SA(0, 1), cA + hstepA, voffA);
    if (wr == 1) PG8_BAR;
    PG8_WAIT_V(2); PG8_BAR;
    PG8_STAGE(PG8_SB(1, 0), cB + kstep, voffB); PG8_STAGE(PG8_SA(1, 0), cA + KOFFA(1), voffA); PG8_STAGE(PG8_SB(1, 1), cB + hstepB + kstep, voffB);
    PG8_WAIT_V(6); PG8_BAR;
    for (;;) {
        const bool has_next = S.next(ui + 1, nxt);
        const char* nA = has_next ? (const char*)g.A + (size_t)nxt.pm * tstepA : cA; const char* nB = has_next ? (const char*)g.Bt + (size_t)nxt.pn * tstepB : cB;
        for (int t = 0; t < nt; t += 2) {
            const bool last = (t == nt - 2);
            const char* a1 = cA + KOFFA(t + 1);
            const char* a2 = last ? nA : cA + KOFFA(t + 2); const char* b2 = last ? nB : cB + (size_t)(t + 2) * kstep;
            const char* a3 = last ? nA + KOFFA(1) : cA + KOFFA(t + 3); const char* b3 = b2 + kstep;
            PG8_LDB(B0, 0, 0); PG8_LDB(B1, 0, 1); PG8_SCHED; PG8_LDA(At, 0, 0); PG8_STAGE(PG8_SA(1, 1), a1 + hstepA, voffA);
            PG8_WAIT_V(8); PG8_WAIT_L(0); PG8_BAR; PG8_MMA(0, 0, At, B0); PG8_MMA(0, 1, At, B1); PG8_BAR; PG8_SCHED;
            PG8_LDA(At, 0, 1); PG8_STAGE(PG8_SB(0, 0), b2, voffB); PG8_STAGE(PG8_SB(0, 1), b2 + hstepB, voffB); PG8_STAGE(PG8_SA(0, 0), a2, voffA);
            PG8_WAIT_V(8); PG8_WAIT_L(0); PG8_BAR; PG8_MMA(1, 0, At, B0); PG8_MMA(1, 1, At, B1); PG8_BAR; PG8_SCHED;
            PG8_LDB(B0, 1, 0); PG8_LDB(B1, 1, 1); PG8_SCHED; PG8_LDA(At, 1, 0); PG8_STAGE(PG8_SA(0, 1), a2 + hstepA, voffA);
            PG8_WAIT_V(8); PG8_WAIT_L(0); PG8_BAR; PG8_MMA(0, 0, At, B0); PG8_MMA(0, 1, At, B1); PG8_BAR; PG8_SCHED;
            PG8_LDA(At, 1, 1); PG8_STAGE(PG8_SB(1, 0), b3, voffB); PG8_STAGE(PG8_SB(1, 1), b3 + hstepB, voffB); PG8_STAGE(PG8_SA(1, 0), a3, voffA);
            PG8_WAIT_V(8); PG8_WAIT_L(0); PG8_BAR; PG8_MMA(1, 0, At, B0); PG8_MMA(1, 1, At, B1); PG8_BAR; PG8_SCHED;
        }
        if constexpr (ALIGN_EPI) { if (wr == 0) PG8_BAR; }
        E(acc, cur, wr, wc, fr, fq);
        if (!has_next) break;
#pragma unroll
        for (int a = 0; a < 2; ++a)
#pragma unroll
            for (int b = 0; b < 2; ++b)
#pragma unroll
                for (int m = 0; m < 4; ++m)
#pragma unroll
                    for (int n = 0; n < 2; ++n) acc[a][b][m][n] = (f32x4){0.f, 0.f, 0.f, 0.f};
        cur = nxt; cA = nA; cB = nB; ++ui;
        if constexpr (ALIGN_EPI) { if (wr == 1) PG8_BAR; }
    }
    PG8_WAIT_V(0);
    if constexpr (!ALIGN_EPI) { if (wr == 0) PG8_BAR; }
    PG8_BAR;
#undef KOFFA
#undef PG8_SA
#undef PG8_SB
#undef PG8_STAGE
#undef PG8_LDA
#undef PG8_LDB
#undef PG8_MMA
#undef PG8_WAIT_V
#undef PG8_WAIT_L
#undef PG8_BAR
#undef PG8_SCHED
}
}

typedef GAS unsigned gu32;
#define RLX_AGENT __ATOMIC_RELAXED, __HIP_MEMORY_SCOPE_AGENT
#define XB_TMO      128
#define XB_XCNT(j)  (256  + 64 * (j))
#define XB_XSUB(j)  (1280 + 64 * (j))
#define XB_XGEN(j)  (2304 + 64 * (j))
#define XB_TOP      3328
#define XB_TOPGEN   3392
#define XCD_BAR_WORDS 3456
#define XB_SPIN_CAP (1u << 18)
__device__ __forceinline__ unsigned xb_ld(unsigned* p)              { return __hip_atomic_load(p, __ATOMIC_RELAXED, __HIP_MEMORY_SCOPE_AGENT); }
__device__ __forceinline__ unsigned xb_add(unsigned* p, unsigned v) { return __hip_atomic_fetch_add(p, v, __ATOMIC_RELAXED, __HIP_MEMORY_SCOPE_AGENT); }
__device__ __forceinline__ unsigned xb_xcc_id() { return (unsigned)__builtin_amdgcn_s_getreg((3 << 11) | 20) & 0xFu; }
#define XB_SPIN(cond, bar) do { unsigned _sp = 0; while (cond) { __builtin_amdgcn_s_sleep(1); \
    if ((++_sp & 255u) == 0u) { if (xb_ld(&(bar)[XB_TMO])) break; if (_sp > XB_SPIN_CAP) { atomicAdd(&(bar)[XB_TMO], 1u); break; } } } } while (0)
struct XcdBarrier { unsigned* bar; unsigned x; volatile LAS unsigned* st; };
__device__ __forceinline__ XcdBarrier xcd_barrier_post(unsigned* bar, volatile LAS unsigned* st) {
    XcdBarrier b; b.bar = bar; b.x = xb_xcc_id(); b.st = st;
    if (threadIdx.x == 0) (void)xb_add(&bar[XB_XCNT(b.x)], 1u);
    return b;
}
__device__ __forceinline__ void xcd_barrier_complete(unsigned* bar, unsigned x, unsigned& nloc, unsigned& nx) {
    const unsigned G = gridDim.x * gridDim.y * gridDim.z;
    unsigned sum, cnt, mine, sp = 0u;
    for (;;) {
        sum = 0u; cnt = 0u; mine = 0u;
#pragma unroll
        for (unsigned j = 0; j < 16; ++j) { const unsigned c = xb_ld(&bar[XB_XCNT(j)]); sum += c; cnt += (c > 0u) ? 1u : 0u; mine = (j == x) ? c : mine; }
        if (sum == G) break;
        __builtin_amdgcn_s_sleep(1);
        if ((++sp & 255u) == 0u) { if (xb_ld(&bar[XB_TMO])) break; if (sp > XB_SPIN_CAP) { atomicAdd(&bar[XB_TMO], 1u); break; } }
    }
    nloc = mine > 0u ? mine : 1u; nx = cnt > 0u ? cnt : 1u;
}
__device__ __forceinline__ void xcd_barrier(const XcdBarrier& b) {
    asm volatile("s_waitcnt vmcnt(0)" ::: "memory");
    __syncthreads();
    if (threadIdx.x == 0) {
        unsigned* bar = b.bar;
        __builtin_amdgcn_s_waitcnt(0);
        unsigned nloc = b.st[0], nx = b.st[1];
        if (nloc == 0u) { xcd_barrier_complete(bar, b.x, nloc, nx); b.st[0] = nloc; b.st[1] = nx; }
        const unsigned old = xb_add(&bar[XB_XSUB(b.x)], 1u);
        const unsigned gen = old / nloc;
        if (old + 1u == (gen + 1u) * nloc) {
            __builtin_amdgcn_fence(__ATOMIC_RELEASE, "agent");
            asm volatile("s_waitcnt vmcnt(0)" ::: "memory");
            const unsigned og = xb_add(&bar[XB_TOP], 1u);
            const unsigned tg = og / nx;
            if (og + 1u == (tg + 1u) * nx) xb_add(&bar[XB_TOPGEN], 1u);
            else XB_SPIN(xb_ld(&bar[XB_TOPGEN]) == tg, bar);
            __builtin_amdgcn_fence(__ATOMIC_ACQUIRE, "agent");
            xb_add(&bar[XB_XGEN(b.x)], 1u);
            asm volatile("s_waitcnt vmcnt(0)" ::: "memory");
        } else {
            XB_SPIN(xb_ld(&bar[XB_XGEN(b.x)]) == gen, bar);
            __builtin_amdgcn_fence(__ATOMIC_ACQUIRE, "agent");
            asm volatile("s_waitcnt vmcnt(0)" ::: "memory");
        }
    }
    __syncthreads();
}

struct Args {
    const float *x_prompt, *x_sample, *cache_k, *cache_v, *state_ssm, *state_conv, *norm_w, *w_in, *conv_w, *conv_b,
                *dt_bias, *a_log, *d_skip, *ssm_norm_w, *q_norm_w, *k_norm_w, *sinks, *rel_table, *w_out;
    float* out; unsigned char* ws; int ph_lo, ph_hi;
};
constexpr int NWAVES = 8, NT = 512;
constexpr int RING_BYTES = 131072, MISC_OFF = RING_BYTES + 320, LDS_BYTES = 147456;

template <bool REMAP>
__device__ __forceinline__ void p0_transpose_item(const float* W, int K, int N, bf16_t* WT, LAS float* scr, int item, int lane) {
    const int nblk = (N + 31) / 32, kb = item / nblk, nb = item % nblk, k0 = 64 * kb, n0 = 32 * nb;
    const bool nok = (n0 + (lane & 31)) < N;
#pragma unroll 8
    for (int i = 0; i < 32; ++i) { const int kk = 2 * i + (lane >> 5); scr[kk * 33 + (lane & 31)] = nok ? W[(size_t)(k0 + kk) * N + n0 + (lane & 31)] : 0.f; }
    LDS_WAIT(); asm volatile("" ::: "memory");
    const int c = lane & 7;
#pragma unroll
    for (int j = 0; j < 4; ++j) { const int n = (lane >> 3) + 8 * j; const LAS float* s = scr + (8 * c) * 33 + n;
        u32x4 o; o.x = pk2(s[0 * 33], s[1 * 33]); o.y = pk2(s[2 * 33], s[3 * 33]); o.z = pk2(s[4 * 33], s[5 * 33]); o.w = pk2(s[6 * 33], s[7 * 33]);
        int ng = n0 + n;
        if (ng < N) { if (REMAP) ng = (ng < 2560) ? ng : (ng < 2576 ? ng + 2560 : ng - 16);
            *(u32x4*)(WT + (size_t)ng * K + k0 + 8 * c) = o; } }
    LDS_WAIT(); asm volatile("" ::: "memory");
}
__device__ __forceinline__ void p0_prologue(const Args& a, LAS unsigned char* lds, int vcu, int G, int wave, int lane) {
    LAS float* scr = (LAS float*)(lds + wave * 16384);
    bf16_t* WinT = (bf16_t*)(a.ws + WS_WIN); bf16_t* WoutT = (bf16_t*)(a.ws + WS_WOUT); bf16_t* H = (bf16_t*)(a.ws + WS_H);
    const int gw = vcu * NWAVES + wave, NGW = G * NWAVES;
    constexpr int I_IN = (DM / 64) * ((NIN + 31) / 32), I_OUT = (2048 / 64) * (DM / 32);
    for (int it = gw; it < I_IN + I_OUT; it += NGW) {
        if (it < I_IN) p0_transpose_item<true>(a.w_in, DM, NIN, WinT, scr, it, lane);
        else p0_transpose_item<false>(a.w_out, 2048, DM, WoutT, scr, it - I_IN, lane);
    }
    for (int r = gw; r < NINP - NIN; r += NGW) { u32x4* p = (u32x4*)(WinT + (size_t)(NIN + r) * DM); p[lane] = (u32x4){0u, 0u, 0u, 0u}; p[lane + 64] = (u32x4){0u, 0u, 0u, 0u}; }
    f32x4 nw[4];
#pragma unroll
    for (int j = 0; j < 4; ++j) nw[j] = ((const f32x4*)a.norm_w)[lane + 64 * j];
    for (int m = gw; m < MT; m += NGW) {
        const float* xrow = (m < MP) ? a.x_prompt + (size_t)m * DM : a.x_sample + (size_t)(m - MP) * DM;
        const f32x4* xr = (const f32x4*)xrow + lane;
        f32x4 v[4]; float s = 0.f;
#pragma unroll
        for (int j = 0; j < 4; ++j) { v[j] = xr[64 * j]; s += (v[j].x * v[j].x + v[j].y * v[j].y) + (v[j].z * v[j].z + v[j].w * v[j].w); }
        const float rstd = 1.0f / sqrtf(wave_sum(s) * (1.f / DM) + EPS);
        unsigned long long* o8 = (unsigned long long*)(H + (size_t)m * DM) + lane;
#pragma unroll
        for (int j = 0; j < 4; ++j) { const f32x4 h = v[j] * rstd * nw[j]; o8[64 * j] = (unsigned long long)pk2(h.x, h.y) | ((unsigned long long)pk2(h.z, h.w) << 32); }
    }
}

__device__ __forceinline__ float ssd_dt_scan(const float* DT, int R0, int h, int e, int lane, const float* dt_bias, const float* a_log, LAS float* dtv, LAS float* acum, float& d0o, float& d1o, float& c0o, float& c1o) {
    const float bias = dt_bias[h]; const float A = -expf(a_log[h]);
    const int l0 = 2 * lane;
    const float d0 = softplus_f(DT[(size_t)(R0 + l0) * 16 + h] + bias), d1 = softplus_f(DT[(size_t)(R0 + l0 + 1) * 16 + h] + bias);
    const float a0 = d0 * A, a1 = d1 * A; float s = a0 + a1;
#pragma unroll
    for (int o = 1; o < 64; o <<= 1) { const float t = __shfl_up(s, o); if (lane >= o) s += t; }
    const float excl = s - (a0 + a1);
    const float c0 = excl + a0, c1 = excl + a0 + a1;
    dtv[e * 128 + l0] = d0; dtv[e * 128 + l0 + 1] = d1; acum[e * 128 + l0] = c0; acum[e * 128 + l0 + 1] = c1;
    d0o = d0; d1o = d1; c0o = c0; c1o = c1;
    return __shfl(s, 63);
}

__device__ __forceinline__ void ssd_state_item(const Args& a, LAS unsigned char* lds, int item, int tid, int wave, int lane) {
    const int b = item >> 7, c = (item >> 1) & 63, g = item & 1;
    const int R0 = b * SEQ + c * 128;
    const bf16_t* U = (const bf16_t*)(a.ws + WS_U); const float* DT = (const float*)(a.ws + WS_DT);
    float* ST = (float*)(a.ws + WS_ST); float* DEC = (float*)(a.ws + WS_DEC);
    LAS bf16_t* Bt = (LAS bf16_t*)lds;
    LAS bf16_t* Xt = (LAS bf16_t*)(lds + 34816);
    LAS float* dtv = (LAS float*)(lds + 52224); LAS float* acum = dtv + 1024; LAS float* wv = acum + 1024;
    {
        float d0, d1, c0, c1; const int h = 8 * g + wave;
        const float aend = ssd_dt_scan(DT, R0, h, wave, lane, a.dt_bias, a.a_log, dtv, acum, d0, d1, c0, c1);
        wv[wave * 128 + 2 * lane] = d0 * __expf(aend - c0); wv[wave * 128 + 2 * lane + 1] = d1 * __expf(aend - c1);
        if (lane == 0) DEC[(b * 64 + c) * 16 + h] = __expf(aend);
    }
    {
        const int n = tid & 127, q = tid >> 7, ch = 1024 + 128 * g + n; const int col = C_X + ch;
        const float w0 = a.conv_w[ch], w1 = a.conv_w[CONVD + ch], w2 = a.conv_w[2 * CONVD + ch], w3 = a.conv_w[3 * CONVD + ch], cb = a.conv_b[ch];
        const int lb = 32 * q; const bool has_prev = (c > 0) || (lb > 0);
        const bf16_t* up = U + (size_t)(R0 + lb) * UW + col;
        float u0 = has_prev ? bf2f(up[-3 * UW]) : 0.f, u1 = has_prev ? bf2f(up[-2 * UW]) : 0.f, u2 = has_prev ? bf2f(up[-1 * UW]) : 0.f;
#pragma unroll 4
        for (int i = 0; i < 32; i += 2) {
            const float u3 = bf2f(up[(size_t)i * UW]), u4 = bf2f(up[(size_t)(i + 1) * UW]);
            const float v0 = silu_f(cb + w0 * u0 + w1 * u1 + w2 * u2 + w3 * u3), v1 = silu_f(cb + w0 * u1 + w1 * u2 + w2 * u3 + w3 * u4);
            *(LAS unsigned*)(Bt + n * 136 + lb + i) = pk2(v0, v1);
            u0 = u2; u1 = u3; u2 = u4;
        }
    }
    const int fr = lane & 15, grp = lane >> 4;
    for (int e = 0; e < 8; ++e) {
        const int h = 8 * g + e;
        {
            const int p = tid & 63, o = tid >> 6, ch = 64 * h + p; const int col = C_X + ch;
            const float w0 = a.conv_w[ch], w1 = a.conv_w[CONVD + ch], w2 = a.conv_w[2 * CONVD + ch], w3 = a.conv_w[3 * CONVD + ch], cb = a.conv_b[ch];
            const int lb = 16 * o; const bool has_prev = (c > 0) || (lb > 0);
            const bf16_t* up = U + (size_t)(R0 + lb) * UW + col;
            float u0 = has_prev ? bf2f(up[-3 * UW]) : 0.f, u1 = has_prev ? bf2f(up[-2 * UW]) : 0.f, u2 = has_prev ? bf2f(up[-1 * UW]) : 0.f;
            __syncthreads();
#pragma unroll 4
            for (int i = 0; i < 16; i += 2) {
                const float u3 = bf2f(up[(size_t)i * UW]), u4 = bf2f(up[(size_t)(i + 1) * UW]);
                const float v0 = silu_f(cb + w0 * u0 + w1 * u1 + w2 * u2 + w3 * u3) * wv[e * 128 + lb + i], v1 = silu_f(cb + w0 * u1 + w1 * u2 + w2 * u3 + w3 * u4) * wv[e * 128 + lb + i + 1];
                *(LAS unsigned*)(Xt + p * 136 + lb + i) = pk2(v0, v1);
                u0 = u2; u1 = u3; u2 = u4;
            }
        }
        __syncthreads();
        f32x4 acc[4];
#pragma unroll
        for (int pt = 0; pt < 4; ++pt) acc[pt] = (f32x4){0.f, 0.f, 0.f, 0.f};
#pragma unroll
        for (int ks = 0; ks < 4; ++ks) {
            const bf16x8 af = *(const LAS bf16x8*)(Bt + (16 * wave + fr) * 136 + 32 * ks + 8 * grp);
#pragma unroll
            for (int pt = 0; pt < 4; ++pt) { const bf16x8 bfr = *(const LAS bf16x8*)(Xt + (16 * pt + fr) * 136 + 32 * ks + 8 * grp); acc[pt] = mfma16(af, bfr, acc[pt]); }
        }
        float* stp = ST + ((size_t)((b * 64 + c) * 16 + h) * 64) * 128 + 16 * wave + 4 * grp;
#pragma unroll
        for (int pt = 0; pt < 4; ++pt) *(f32x4*)(stp + (size_t)(16 * pt + fr) * 128) = acc[pt];
    }
    __syncthreads();
}

__device__ __forceinline__ void ssd_scan(const Args& a, int gtid, int gthreads) {
    float* ST = (float*)(a.ws + WS_ST); const float* DEC = (const float*)(a.ws + WS_DEC);
    for (int el = gtid; el < NB * 16 * 4096; el += gthreads) {
        const int q = el & 4095, bh = el >> 12, b = bh >> 4, h = bh & 15;
        f32x2 carry = (f32x2){0.f, 0.f};
        float* p = ST + ((size_t)(b * 64) * 16 + h) * 8192 + 2 * q;
        const float* dp = DEC + (b * 64) * 16 + h;
#pragma unroll 8
        for (int c = 0; c < 64; ++c) {
            const f32x2 v = *(const f32x2*)(p + (size_t)c * 16 * 8192); const float d = dp[c * 16];
            *(f32x2*)(p + (size_t)c * 16 * 8192) = carry; carry = carry * d + v;
        }
        *(f32x2*)(a.out + O_SP + (size_t)bh * 8192 + 2 * q) = carry;
    }
}

__device__ __forceinline__ void ssd_out_item(const Args& a, LAS unsigned char* lds, int item, int tid, int wave, int lane) {
    const int b = item >> 7, c = (item >> 1) & 63, g = item & 1;
    const int R0 = b * SEQ + c * 128;
    bf16_t* U = (bf16_t*)(a.ws + WS_U); const float* DT = (const float*)(a.ws + WS_DT); const float* ST = (const float*)(a.ws + WS_ST);
    LAS bf16_t* Cn = (LAS bf16_t*)lds;
    LAS bf16_t* Bn = (LAS bf16_t*)(lds + 34816);
    LAS bf16_t* Xt = (LAS bf16_t*)(lds + 69632);
    LAS bf16_t* St = (LAS bf16_t*)(lds + 87040);
    LAS float* dtv = (LAS float*)(lds + 104448); LAS float* acum = dtv + 1024;
    { float d0, d1, c0, c1; (void)ssd_dt_scan(DT, R0, 8 * g + wave, wave, lane, a.dt_bias, a.a_log, dtv, acum, d0, d1, c0, c1); }
    {
        const int chn = tid & 255, hf = tid >> 8, ch = 1024 + ((chn < 128) ? (128 * g + chn) : (256 + 128 * g + (chn - 128))); const int col = C_X + ch;
        LAS bf16_t* dst = (chn < 128) ? (Bn + chn) : (Cn + (chn - 128));
        const float w0 = a.conv_w[ch], w1 = a.conv_w[CONVD + ch], w2 = a.conv_w[2 * CONVD + ch], w3 = a.conv_w[3 * CONVD + ch], cb = a.conv_b[ch];
        const int lb = 64 * hf; const bool has_prev = (c > 0) || (lb > 0);
        const bf16_t* up = U + (size_t)(R0 + lb) * UW + col;
        float u0 = has_prev ? bf2f(up[-3 * UW]) : 0.f, u1 = has_prev ? bf2f(up[-2 * UW]) : 0.f, u2 = has_prev ? bf2f(up[-1 * UW]) : 0.f;
#pragma unroll 4
        for (int i = 0; i < 64; ++i) {
            const float u3 = bf2f(up[(size_t)i * UW]);
            dst[(lb + i) * 136] = (bf16_t)f2bf(silu_f(cb + w0 * u0 + w1 * u1 + w2 * u2 + w3 * u3));
            u0 = u1; u1 = u2; u2 = u3;
        }
    }
    __syncthreads();
    const int fr = lane & 15, grp = lane >> 4;
    const int l = 16 * wave + fr;
    f32x4 cb[8];
#pragma unroll
    for (int st = 0; st < 8; ++st) cb[st] = (f32x4){0.f, 0.f, 0.f, 0.f};
#pragma unroll
    for (int ks = 0; ks < 4; ++ks) {
        const bf16x8 cf = *(const LAS bf16x8*)(Cn + (16 * wave + fr) * 136 + 32 * ks + 8 * grp);
#pragma unroll
        for (int st = 0; st < 8; ++st) if (st <= wave) { const bf16x8 bfm = *(const LAS bf16x8*)(Bn + (16 * st + fr) * 136 + 32 * ks + 8 * grp); cb[st] = mfma16(bfm, cf, cb[st]); }
    }
    float ssq = 0.f;
    bf16_t* yrow = U + (size_t)(R0 + l) * UW + C_Z + 512 * g + 4 * grp;
#pragma unroll 1
    for (int e = 0; e < 8; ++e) {
        const int h = 8 * g + e;
        __syncthreads();
        {
            const int p = tid & 63, o = tid >> 6, ch = 64 * h + p; const int col = C_X + ch;
            const float w0 = a.conv_w[ch], w1 = a.conv_w[CONVD + ch], w2 = a.conv_w[2 * CONVD + ch], w3 = a.conv_w[3 * CONVD + ch], cbias = a.conv_b[ch];
            const int lb = 16 * o; const bool has_prev = (c > 0) || (lb > 0);
            const bf16_t* up = U + (size_t)(R0 + lb) * UW + col;
            float u0 = has_prev ? bf2f(up[-3 * UW]) : 0.f, u1 = has_prev ? bf2f(up[-2 * UW]) : 0.f, u2 = has_prev ? bf2f(up[-1 * UW]) : 0.f;
#pragma unroll 4
            for (int i = 0; i < 16; i += 2) {
                const float u3 = bf2f(up[(size_t)i * UW]), u4 = bf2f(up[(size_t)(i + 1) * UW]);
                const float v0 = silu_f(cbias + w0 * u0 + w1 * u1 + w2 * u2 + w3 * u3), v1 = silu_f(cbias + w0 * u1 + w1 * u2 + w2 * u3 + w3 * u4);
                *(LAS unsigned*)(Xt + p * 136 + lb + i) = pk2(v0, v1);
                u0 = u2; u1 = u3; u2 = u4;
            }
        }
        {
            const int p = tid >> 3, n0 = 16 * (tid & 7);
            const f32x4* sp = (const f32x4*)(ST + ((size_t)((b * 64 + c) * 16 + h) * 64 + p) * 128 + n0);
            const f32x4 s0 = sp[0], s1 = sp[1], s2 = sp[2], s3 = sp[3];
            u32x4 w0; w0.x = pk2(s0.x, s0.y); w0.y = pk2(s0.z, s0.w); w0.z = pk2(s1.x, s1.y); w0.w = pk2(s1.z, s1.w);
            u32x4 w1; w1.x = pk2(s2.x, s2.y); w1.y = pk2(s2.z, s2.w); w1.z = pk2(s3.x, s3.y); w1.w = pk2(s3.z, s3.w);
            *(LAS u32x4*)(St + p * 136 + n0) = w0; *(LAS u32x4*)(St + p * 136 + n0 + 8) = w1;
        }
        __syncthreads();
        f32x4 accd[4], acco[4];
#pragma unroll
        for (int pt = 0; pt < 4; ++pt) { accd[pt] = (f32x4){0.f, 0.f, 0.f, 0.f}; acco[pt] = (f32x4){0.f, 0.f, 0.f, 0.f}; }
        const float al = acum[e * 128 + l];
#pragma unroll
        for (int ks = 0; ks < 4; ++ks) if (2 * ks <= wave) {
            const int sA = 32 * ks + 4 * grp, sB = sA + 16;
            const f32x4 acA = *(const LAS f32x4*)(acum + e * 128 + sA), acB = *(const LAS f32x4*)(acum + e * 128 + sB);
            const f32x4 dtA = *(const LAS f32x4*)(dtv + e * 128 + sA), dtB = *(const LAS f32x4*)(dtv + e * 128 + sB);
            float m[8];
#pragma unroll
            for (int j = 0; j < 4; ++j) {
                const float va = cb[2 * ks][j] * dtA[j] * __expf(al - acA[j]); m[j] = (sA + j <= l) ? va : 0.f;
                const float vb = cb[2 * ks + 1][j] * dtB[j] * __expf(al - acB[j]); m[4 + j] = (sB + j <= l) ? vb : 0.f;
            }
            u32x4 mw; mw.x = pk2(m[0], m[1]); mw.y = pk2(m[2], m[3]); mw.z = pk2(m[4], m[5]); mw.w = pk2(m[6], m[7]);
            const bf16x8 mf = __builtin_bit_cast(bf16x8, mw);
#pragma unroll
            for (int pt = 0; pt < 4; ++pt) {
                const u32x2 lo = *(const LAS u32x2*)(Xt + (16 * pt + fr) * 136 + sA), hi = *(const LAS u32x2*)(Xt + (16 * pt + fr) * 136 + sB);
                u32x4 aw; aw.x = lo.x; aw.y = lo.y; aw.z = hi.x; aw.w = hi.y;
                accd[pt] = mfma16(__builtin_bit_cast(bf16x8, aw), mf, accd[pt]);
            }
        }
#pragma unroll
        for (int ks = 0; ks < 4; ++ks) {
            const bf16x8 cf = *(const LAS bf16x8*)(Cn + (16 * wave + fr) * 136 + 32 * ks + 8 * grp);
#pragma unroll
            for (int pt = 0; pt < 4; ++pt) { const bf16x8 sf = *(const LAS bf16x8*)(St + (16 * pt + fr) * 136 + 32 * ks + 8 * grp); acco[pt] = mfma16(sf, cf, acco[pt]); }
        }
        const float eal = __expf(al), dsk = a.d_skip[h];
#pragma unroll
        for (int pt = 0; pt < 4; ++pt) {
            const u32x2 zz = *(const u32x2*)(yrow + 64 * e + 16 * pt);
            const float z[4] = {bflo(zz.x), bfhi(zz.x), bflo(zz.y), bfhi(zz.y)};
            float gy[4];
#pragma unroll
            for (int r = 0; r < 4; ++r) {
                const float xv = bf2f(Xt[(16 * pt + 4 * grp + r) * 136 + l]);
                const float y = accd[pt][r] + eal * acco[pt][r] + dsk * xv;
                gy[r] = y * silu_f(z[r]); ssq += gy[r] * gy[r];
            }
            u32x2 o; o.x = pk2(gy[0], gy[1]); o.y = pk2(gy[2], gy[3]);
            *(u32x2*)(yrow + 64 * e + 16 * pt) = o;
        }
    }
    ssq += __shfl_xor(ssq, 16); ssq += __shfl_xor(ssq, 32);
    const float rstd = 1.0f / sqrtf(ssq * (1.f / 512.f) + EPS);
#pragma unroll 2
    for (int e = 0; e < 8; ++e)
#pragma unroll
        for (int pt = 0; pt < 4; ++pt) {
            const f32x4 nw = *(const f32x4*)(a.ssm_norm_w + 512 * g + 64 * e + 16 * pt + 4 * grp);
            const u32x2 v = *(const u32x2*)(yrow + 64 * e + 16 * pt);
            u32x2 o; o.x = pk2(bflo(v.x) * rstd * nw.x, bfhi(v.x) * rstd * nw.y); o.y = pk2(bflo(v.y) * rstd * nw.z, bfhi(v.y) * rstd * nw.w);
            *(u32x2*)(yrow + 64 * e + 16 * pt) = o;
        }
    __syncthreads();
}

__device__ __forceinline__ int rel_bucket(int d) {
    if (d < 16) return d;
    const int lg = 16 + (int)(logf((float)d * (1.0f / 16.0f)) * (16.0f / 2.0794415416798357f));
    return lg < 31 ? lg : 31;
}
__device__ __forceinline__ void attn_unit(const Args& a, LAS unsigned char* lds, int unit, int tid, int wave, int lane, float m2) {
    const int b = unit >> 8, blk = (unit >> 2) & 63, kvh = unit & 3;
    const int R0 = b * SEQ + blk * 128;
    bf16_t* U = (bf16_t*)(a.ws + WS_U);
    LAS bf16_t* Kn = (LAS bf16_t*)lds;
    LAS bf16_t* Vt = (LAS bf16_t*)(lds + 41472);
    LAS float* bias2 = (LAS float*)(lds + 77312);
    __syncthreads();
    {
        const int j = tid >> 1, hf = tid & 1;
        const bool zero = (blk == 0 && j < 128);
        f32x4 kv[8];
        if (!zero) { const u32x4* kp = (const u32x4*)(U + (size_t)(R0 - 128 + j) * UW + C_K + 64 * kvh + 32 * hf);
#pragma unroll
            for (int i = 0; i < 4; ++i) { const u32x4 w = kp[i]; kv[2 * i] = (f32x4){bflo(w.x), bfhi(w.x), bflo(w.y), bfhi(w.y)}; kv[2 * i + 1] = (f32x4){bflo(w.z), bfhi(w.z), bflo(w.w), bfhi(w.w)}; } }
        else {
#pragma unroll
            for (int i = 0; i < 8; ++i) kv[i] = (f32x4){0.f, 0.f, 0.f, 0.f}; }
        float ss = 0.f;
#pragma unroll
        for (int i = 0; i < 8; ++i) ss += (kv[i].x * kv[i].x + kv[i].y * kv[i].y) + (kv[i].z * kv[i].z + kv[i].w * kv[i].w);
        ss += __shfl_xor(ss, 1);
        const float rstd = 1.0f / sqrtf(ss * (1.f / 64.f) + EPS);
#pragma unroll
        for (int i = 0; i < 8; ++i) { const f32x4 w = *(const f32x4*)(a.k_norm_w + 32 * hf + 4 * i); kv[i] = kv[i] * rstd * w; }
#pragma unroll
        for (int i = 0; i < 4; ++i) { u32x4 w; w.x = pk2(kv[2 * i].x, kv[2 * i].y); w.y = pk2(kv[2 * i].z, kv[2 * i].w); w.z = pk2(kv[2 * i + 1].x, kv[2 * i + 1].y); w.w = pk2(kv[2 * i + 1].z, kv[2 * i + 1].w);
            *(LAS u32x4*)(Kn + j * 72 + 32 * hf + 8 * i) = w; }
        if (blk == 63 && j >= 128) { float* o = a.out + O_KP + ((size_t)(b * 128 + (j - 128)) * 4 + kvh) * 64 + 32 * hf;
#pragma unroll
            for (int i = 0; i < 8; ++i) *(f32x4*)(o + 4 * i) = kv[i]; }
        if (tid < 288) *(LAS u32x4*)(Kn + 256 * 72 + tid * 8) = (u32x4){0u, 0u, 0u, 0u};
    }
    {
        const int j = tid & 255, dh = tid >> 8;
        const bool zero = (blk == 0 && j < 128);
        const u32x4* vp = (const u32x4*)(U + (size_t)(R0 - 128 + j) * UW + C_V + 64 * kvh + 32 * dh);
        float* o = a.out + O_VP + ((size_t)(b * 128 + (j - 128)) * 4 + kvh) * 64 + 32 * dh;
        const bool wout = (blk == 63 && j >= 128);
#pragma unroll
        for (int i = 0; i < 4; ++i) {
            u32x4 w = (u32x4){0u, 0u, 0u, 0u}; if (!zero) w = vp[i];
            LAS bf16_t* d = Vt + (32 * dh + 8 * i) * 280 + j;
            d[0] = (bf16_t)(w.x & 0xffffu); d[280] = (bf16_t)(w.x >> 16); d[2 * 280] = (bf16_t)(w.y & 0xffffu); d[3 * 280] = (bf16_t)(w.y >> 16);
            d[4 * 280] = (bf16_t)(w.z & 0xffffu); d[5 * 280] = (bf16_t)(w.z >> 16); d[6 * 280] = (bf16_t)(w.w & 0xffffu); d[7 * 280] = (bf16_t)(w.w >> 16);
            if (wout) { *(f32x4*)(o + 8 * i) = (f32x4){bflo(w.x), bfhi(w.x), bflo(w.y), bfhi(w.y)}; *(f32x4*)(o + 8 * i + 4) = (f32x4){bflo(w.z), bfhi(w.z), bflo(w.w), bfhi(w.w)}; }
        }
        for (int i = tid; i < 64 * 12; i += NT) { const int d0 = i / 12, cc = i % 12; *(LAS unsigned*)(Vt + d0 * 280 + 256 + 2 * cc) = 0u; }
    }
    if (tid < 516) { const int gq = tid / 129, d = tid % 129; bias2[gq * 132 + d] = a.rel_table[rel_bucket(d) * 16 + 4 * kvh + gq] * LOG2E; }
    if (tid < 4) bias2[tid * 132 + 129] = 0.f;
    __syncthreads();
    const int fr = lane & 15, grp = lane >> 4;
    const int gq = wave >> 1, hq = 4 * kvh + gq;
    const float sink2 = a.sinks[hq] * LOG2E;
    const float qscale = 0.125f * LOG2E;
    for (int qt = 0; qt < 4; ++qt) {
        const int i0 = 64 * (wave & 1) + 16 * qt, iq = i0 + fr;
        bf16_t* qrow = U + (size_t)(R0 + iq) * UW + C_Q + 64 * hq;
        bf16x8 qf[2];
        {
            const u32x4 w0 = *(const u32x4*)(qrow + 8 * grp), w1 = *(const u32x4*)(qrow + 32 + 8 * grp);
            float qv[16] = {bflo(w0.x), bfhi(w0.x), bflo(w0.y), bfhi(w0.y), bflo(w0.z), bfhi(w0.z), bflo(w0.w), bfhi(w0.w),
                            bflo(w1.x), bfhi(w1.x), bflo(w1.y), bfhi(w1.y), bflo(w1.z), bfhi(w1.z), bflo(w1.w), bfhi(w1.w)};
            float ss = 0.f;
#pragma unroll
            for (int i = 0; i < 16; ++i) ss += qv[i] * qv[i];
            ss += __shfl_xor(ss, 16); ss += __shfl_xor(ss, 32);
            const float rs = qscale / sqrtf(ss * (1.f / 64.f) + EPS);
            const f32x4 n0 = *(const f32x4*)(a.q_norm_w + 8 * grp), n1 = *(const f32x4*)(a.q_norm_w + 8 * grp + 4), n2 = *(const f32x4*)(a.q_norm_w + 32 + 8 * grp), n3 = *(const f32x4*)(a.q_norm_w + 32 + 8 * grp + 4);
            u32x4 p0, p1;
            p0.x = pk2(qv[0] * rs * n0.x, qv[1] * rs * n0.y); p0.y = pk2(qv[2] * rs * n0.z, qv[3] * rs * n0.w); p0.z = pk2(qv[4] * rs * n1.x, qv[5] * rs * n1.y); p0.w = pk2(qv[6] * rs * n1.z, qv[7] * rs * n1.w);
            p1.x = pk2(qv[8] * rs * n2.x, qv[9] * rs * n2.y); p1.y = pk2(qv[10] * rs * n2.z, qv[11] * rs * n2.w); p1.z = pk2(qv[12] * rs * n3.x, qv[13] * rs * n3.y); p1.w = pk2(qv[14] * rs * n3.z, qv[15] * rs * n3.w);
            qf[0] = __builtin_bit_cast(bf16x8, p0); qf[1] = __builtin_bit_cast(bf16x8, p1);
        }
        f32x4 oacc[4];
#pragma unroll
        for (int dt = 0; dt < 4; ++dt) oacc[dt] = (f32x4){0.f, 0.f, 0.f, 0.f};
        float lsum = 0.f;
#pragma unroll
        for (int kk = 0; kk < 5; ++kk) {
            const int j0 = i0 + 32 * kk;
            f32x4 s0 = (f32x4){0.f, 0.f, 0.f, 0.f}, s1 = (f32x4){0.f, 0.f, 0.f, 0.f};
#pragma unroll
            for (int ks = 0; ks < 2; ++ks) {
                const bf16x8 k0 = *(const LAS bf16x8*)(Kn + (j0 + fr) * 72 + 32 * ks + 8 * grp), k1 = *(const LAS bf16x8*)(Kn + (j0 + 16 + fr) * 72 + 32 * ks + 8 * grp);
                s0 = mfma16(k0, qf[ks], s0); s1 = mfma16(k1, qf[ks], s1);
            }
            float p[8];
#pragma unroll
            for (int r = 0; r < 4; ++r) {
                const int ja = j0 + 4 * grp + r, jb = ja + 16; const int da = iq - ja + 128, db = da - 16;
                const bool va = (da >= 0) && (da <= 128) && (blk > 0 || ja >= 128), vb = (db >= 0) && (db <= 128) && (blk > 0 || jb >= 128);
                const float ea = __builtin_amdgcn_exp2f(s0[r] + bias2[gq * 132 + (va ? da : 0)] - m2), eb = __builtin_amdgcn_exp2f(s1[r] + bias2[gq * 132 + (vb ? db : 0)] - m2);
                p[r] = va ? ea : 0.f; p[4 + r] = vb ? eb : 0.f;
            }
#pragma unroll
            for (int r = 0; r < 8; ++r) lsum += p[r];
            u32x4 pw; pw.x = pk2(p[0], p[1]); pw.y = pk2(p[2], p[3]); pw.z = pk2(p[4], p[5]); pw.w = pk2(p[6], p[7]);
            const bf16x8 pf = __builtin_bit_cast(bf16x8, pw);
#pragma unroll
            for (int dt = 0; dt < 4; ++dt) {
                const u32x2 lo = *(const LAS u32x2*)(Vt + (16 * dt + fr) * 280 + j0 + 4 * grp), hi = *(const LAS u32x2*)(Vt + (16 * dt + fr) * 280 + j0 + 16 + 4 * grp);
                u32x4 aw; aw.x = lo.x; aw.y = lo.y; aw.z = hi.x; aw.w = hi.y;
                oacc[dt] = mfma16(__builtin_bit_cast(bf16x8, aw), pf, oacc[dt]);
            }
        }
        lsum += __shfl_xor(lsum, 16); lsum += __shfl_xor(lsum, 32);
        const float rl = 1.0f / (lsum + __builtin_amdgcn_exp2f(sink2 - m2));
        const bf16_t* zrow = U + (size_t)(R0 + iq) * UW + C_ZA + 64 * hq + 4 * grp;
#pragma unroll
        for (int dt = 0; dt < 4; ++dt) {
            const u32x2 zz = *(const u32x2*)(zrow + 16 * dt);
            u32x2 o; o.x = pk2(oacc[dt][0] * rl * silu_f(bflo(zz.x)), oacc[dt][1] * rl * silu_f(bfhi(zz.x))); o.y = pk2(oacc[dt][2] * rl * silu_f(bflo(zz.y)), oacc[dt][3] * rl * silu_f(bfhi(zz.y)));
            *(u32x2*)(qrow + 16 * dt + 4 * grp) = o;
        }
    }
}
__device__ __forceinline__ float attn_shift(const Args& a, int lane) {
    float wq = fabsf(a.q_norm_w[lane]), wk = fabsf(a.k_norm_w[lane]);
    float rb = 0.f;
    for (int i = lane; i < 512; i += 64) rb = fmaxf(rb, fabsf(a.rel_table[i]));
    if (lane < 16) rb = fmaxf(rb, fabsf(a.sinks[lane]));
#pragma unroll
    for (int o = 1; o < 64; o <<= 1) { wq = fmaxf(wq, __shfl_xor(wq, o)); wk = fmaxf(wk, __shfl_xor(wk, o)); rb = fmaxf(rb, __shfl_xor(rb, o)); }
    return (8.0f * wq * wk + rb) * LOG2E;
}

__device__ __forceinline__ void samp_ssm_item(const Args& a, LAS unsigned char* lds, int item, int tid, int wave, int lane) {
    const int b = item >> 1, g = item & 1;
    const int Rs = MP + 4 * b;
    bf16_t* U = (bf16_t*)(a.ws + WS_U); const float* DT = (const float*)(a.ws + WS_DT);
    LAS float* xs = (LAS float*)lds;
    LAS float* Bs = xs + 2048;
    LAS float* Cs = Bs + 512;
    LAS float* gy = Cs + 512;
    LAS float* dts = gy + 2048;
    LAS float* avs = dts + 32;
    LAS float* rstd_s = avs + 32;
    __syncthreads();
    for (int cc = tid; cc < 768; cc += NT) {
        int ch; LAS float* dst;
        if (cc < 512) { ch = 512 * g + cc; dst = xs + cc; } else if (cc < 640) { ch = 1024 + 128 * g + (cc - 512); dst = Bs + (cc - 512); } else { ch = 1280 + 128 * g + (cc - 640); dst = Cs + (cc - 640); }
        const int stride = (cc < 512) ? 512 : 128;
        const float w0 = a.conv_w[ch], w1 = a.conv_w[CONVD + ch], w2 = a.conv_w[2 * CONVD + ch], w3 = a.conv_w[3 * CONVD + ch], cb = a.conv_b[ch];
        const float* sc = a.state_conv + (size_t)b * 3 * CONVD + ch;
        float f[7]; f[0] = sc[0]; f[1] = sc[CONVD]; f[2] = sc[2 * CONVD];
#pragma unroll
        for (int t = 0; t < 4; ++t) f[3 + t] = bf2f(U[(size_t)(Rs + t) * UW + C_X + ch]);
#pragma unroll
        for (int t = 0; t < 4; ++t) dst[t * stride] = silu_f(cb + w0 * f[t] + w1 * f[t + 1] + w2 * f[t + 2] + w3 * f[t + 3]);
    }
    if (tid < 32) { const int e = tid >> 2, t = tid & 3, h = 8 * g + e; const float d = softplus_f(DT[(size_t)(Rs + t) * 16 + h] + a.dt_bias[h]); dts[tid] = d; avs[tid] = d * (-expf(a.a_log[h])); }
    __syncthreads();
    const int p = tid >> 3, nq = tid & 7;
    for (int e = 0; e < 8; ++e) {
        const int h = 8 * g + e;
        const float* sp = a.state_ssm + ((size_t)(b * 16 + h) * 64 + p) * 128 + 4 * nq;
        f32x4 S[4];
#pragma unroll
        for (int i = 0; i < 4; ++i) S[i] = *(const f32x4*)(sp + 32 * i);
        float yv[4];
#pragma unroll
        for (int t = 0; t < 4; ++t) {
            const float dA = __expf(avs[e * 4 + t]); const float coef = dts[e * 4 + t] * xs[t * 512 + 64 * e + p];
            float acc = 0.f;
#pragma unroll
            for (int i = 0; i < 4; ++i) { const f32x4 Bv = *(const LAS f32x4*)(Bs + t * 128 + 4 * nq + 32 * i), Cv = *(const LAS f32x4*)(Cs + t * 128 + 4 * nq + 32 * i);
                S[i] = S[i] * dA + coef * Bv; acc += (Cv.x * S[i].x + Cv.y * S[i].y) + (Cv.z * S[i].z + Cv.w * S[i].w); }
            acc += __shfl_xor(acc, 1); acc += __shfl_xor(acc, 2); acc += __shfl_xor(acc, 4);
            yv[t] = acc;
        }
        float* op = a.out + O_SS + ((size_t)(b * 16 + h) * 64 + p) * 128 + 4 * nq;
#pragma unroll
        for (int i = 0; i < 4; ++i) *(f32x4*)(op + 32 * i) = S[i];
        if (nq < 4) { const int t = nq; const float xv = xs[t * 512 + 64 * e + p];
            const float yt = (nq == 0) ? yv[0] : (nq == 1) ? yv[1] : (nq == 2) ? yv[2] : yv[3];
            const float y = yt + a.d_skip[h] * xv; const float z = bf2f(U[(size_t)(Rs + t) * UW + C_Z + 64 * h + p]);
            gy[t * 512 + 64 * e + p] = y * silu_f(z); }
    }
    __syncthreads();
    if (wave < 4) { float s = 0.f;
#pragma unroll
        for (int i = 0; i < 8; ++i) { const float v = gy[wave * 512 + lane + 64 * i]; s += v * v; }
        s = wave_sum(s); if (lane == 0) rstd_s[wave] = 1.0f / sqrtf(s * (1.f / 512.f) + EPS); }
    __syncthreads();
    for (int i = tid; i < 2048; i += NT) { const int t = i >> 9, ch = i & 511;
        U[(size_t)(Rs + t) * UW + C_Z + 512 * g + ch] = (bf16_t)f2bf(gy[i] * rstd_s[t] * a.ssm_norm_w[512 * g + ch]); }
}

__device__ __forceinline__ void samp_attn_item(const Args& a, LAS unsigned char* lds, int item, int tid, int wave, int lane) {
    const int b = item >> 2, kvh = item & 3;
    const int Rs = MP + 4 * b;
    bf16_t* U = (bf16_t*)(a.ws + WS_U);
    LAS float* Ks = (LAS float*)lds;
    LAS float* Vs = Ks + 132 * 65;
    LAS float* qs = Vs + 132 * 64;
    LAS float* sc = qs + 1024;
    __syncthreads();
    {
        const int w = tid >> 2, qd = tid & 3;
        const float* kp = a.cache_k + ((size_t)(b * 128 + w) * 4 + kvh) * 64 + 16 * qd; const float* vp = a.cache_v + ((size_t)(b * 128 + w) * 4 + kvh) * 64 + 16 * qd;
        f32x4 kv[4], vv[4];
#pragma unroll
        for (int i = 0; i < 4; ++i) { kv[i] = *(const f32x4*)(kp + 4 * i); vv[i] = *(const f32x4*)(vp + 4 * i); }
#pragma unroll
        for (int i = 0; i < 4; ++i) { LAS float* kd = Ks + w * 65 + 16 * qd + 4 * i; kd[0] = kv[i].x; kd[1] = kv[i].y; kd[2] = kv[i].z; kd[3] = kv[i].w; *(LAS f32x4*)(Vs + w * 64 + 16 * qd + 4 * i) = vv[i]; }
        if (w >= 4) { float* ko = a.out + O_KS + ((size_t)(b * 128 + (w - 4)) * 4 + kvh) * 64 + 16 * qd; float* vo = a.out + O_VS + ((size_t)(b * 128 + (w - 4)) * 4 + kvh) * 64 + 16 * qd;
#pragma unroll
            for (int i = 0; i < 4; ++i) { *(f32x4*)(ko + 4 * i) = kv[i]; *(f32x4*)(vo + 4 * i) = vv[i]; } }
    }
    if (wave < 4) {
        const int t = wave;
        const float kx = bf2f(U[(size_t)(Rs + t) * UW + C_K + 64 * kvh + lane]); const float vx = bf2f(U[(size_t)(Rs + t) * UW + C_V + 64 * kvh + lane]);
        const float ss = wave_sum(kx * kx); const float kn = kx / sqrtf(ss * (1.f / 64.f) + EPS) * a.k_norm_w[lane];
        Ks[(128 + t) * 65 + lane] = kn; Vs[(128 + t) * 64 + lane] = vx;
        a.out[O_KS + ((size_t)(b * 128 + 124 + t) * 4 + kvh) * 64 + lane] = kn; a.out[O_VS + ((size_t)(b * 128 + 124 + t) * 4 + kvh) * 64 + lane] = vx;
    }
#pragma unroll
    for (int i = 0; i < 2; ++i) {
        const int qi = 2 * wave + i, gq = qi >> 2, t = qi & 3, hq = 4 * kvh + gq;
        const float qx = bf2f(U[(size_t)(Rs + t) * UW + C_Q + 64 * hq + lane]);
        const float ss = wave_sum(qx * qx);
        qs[qi * 64 + lane] = qx / sqrtf(ss * (1.f / 64.f) + EPS) * a.q_norm_w[lane] * 0.125f;
    }
    __syncthreads();
    for (int idx = tid; idx < 16 * 132; idx += NT) {
        const int qi = idx / 132, j = idx % 132, t = qi & 3, hq = 4 * kvh + (qi >> 2);
        float s = 0.f;
#pragma unroll 8
        for (int d = 0; d < 64; ++d) s += qs[qi * 64 + d] * Ks[j * 65 + d];
        const int dist = t + 128 - j; const bool valid = (dist >= 0) && (dist <= 128);
        sc[qi * 136 + j] = valid ? s + a.rel_table[rel_bucket(valid ? dist : 0) * 16 + hq] : -INFINITY;
    }
    __syncthreads();
#pragma unroll
    for (int i = 0; i < 2; ++i) {
        const int qi = 2 * wave + i, hq = 4 * kvh + (qi >> 2);
        const float sk = a.sinks[hq];
        const float v0 = sc[qi * 136 + lane], v1 = sc[qi * 136 + 64 + lane], v2 = (lane < 4) ? sc[qi * 136 + 128 + lane] : -INFINITY;
        float m = fmaxf(fmaxf(v0, v1), fmaxf(v2, sk));
#pragma unroll
        for (int o = 1; o < 64; o <<= 1) m = fmaxf(m, __shfl_xor(m, o));
        const float e0 = __expf(v0 - m), e1 = __expf(v1 - m), e2 = (lane < 4) ? __expf(v2 - m) : 0.f;
        const float den = wave_sum(e0 + e1 + e2) + __expf(sk - m); const float rd = 1.0f / den;
        sc[qi * 136 + lane] = e0 * rd; sc[qi * 136 + 64 + lane] = e1 * rd; if (lane < 4) sc[qi * 136 + 128 + lane] = e2 * rd;
    }
    __syncthreads();
#pragma unroll
    for (int i = 0; i < 2; ++i) {
        const int d = tid & 63, qi = (tid >> 6) + 8 * i, t = qi & 3, hq = 4 * kvh + (qi >> 2);
        float o = 0.f;
#pragma unroll 4
        for (int j = 0; j < 132; ++j) o += sc[qi * 136 + j] * Vs[j * 64 + d];
        const float z = bf2f(U[(size_t)(Rs + t) * UW + C_ZA + 64 * hq + d]);
        U[(size_t)(Rs + t) * UW + C_Q + 64 * hq + d] = (bf16_t)f2bf(o * silu_f(z));
    }
}

__device__ __forceinline__ void conv_out_item(const Args& a, int item, int tid) {
    const bf16_t* U = (const bf16_t*)(a.ws + WS_U);
    for (int i = tid; i < 3 * CONVD; i += NT) {
        const int r = i / CONVD, ch = i % CONVD;
        if (item < NB) a.out[O_CP + (size_t)item * 3 * CONVD + i] = bf2f(U[(size_t)(item * SEQ + SEQ - 3 + r) * UW + C_X + ch]);
        else { const int b = item - NB; a.out[O_CS + (size_t)b * 3 * CONVD + i] = bf2f(U[(size_t)(MP + 4 * b + 1 + r) * UW + C_X + ch]); }
    }
}

__global__ void __launch_bounds__(NT, 2) mk_fwd(Args args) {
    extern __shared__ __attribute__((aligned(16))) unsigned char lds_raw[];
    LAS unsigned char* lds = (LAS unsigned char*)lds_raw;
    volatile LAS unsigned* MISC = (volatile LAS unsigned*)(lds + MISC_OFF);
    const int tid = threadIdx.x, lane = tid & 63, wave = __builtin_amdgcn_readfirstlane(tid >> 6);
    const int G = gridDim.x; const int bx = blockIdx.x; const int vcu = (G % 8 == 0) ? (bx % 8) * (G / 8) + bx / 8 : bx;
    gu32* ctl = (gu32*)(args.ws + WS_CTL);
    for (int u = tid; u < (LDS_BYTES - RING_BYTES) / 4; u += NT) ((LAS unsigned*)(lds + RING_BYTES))[u] = 0u;
    __syncthreads();
    XcdBarrier bar; bar.bar = (unsigned*)(ctl + CW_BAR); bar.x = 0; bar.st = nullptr;
    if (MK_N_LAUNCHES == 1) bar = xcd_barrier_post((unsigned*)(ctl + CW_BAR), MISC + 8);
    const int lo = args.ph_lo, hi = args.ph_hi;
#define IN(k) (lo <= (k) && (k) < hi)
#define GRID_BAR() do { if (MK_N_LAUNCHES == 1) xcd_barrier(bar); } while (0)

#ifndef SKIP_P0
    if (IN(0)) { p0_prologue(args, lds, vcu, G, wave, lane); GRID_BAR(); }
#endif

#ifndef SKIP_P1
    if (IN(1)) {
        pg8::Gemm g{(const bf16_t*)(args.ws + WS_H), (const bf16_t*)(args.ws + WS_WIN), MT, NINP, DM, DM, 1 << 20, 0};
        pg8::StaticOrder S; S.init(MT, NINP, G, bx);
        pg8::EpiU E{(bf16_t*)(args.ws + WS_U), (float*)(args.ws + WS_DT)};
        pg8::gemm_phase<pg8::EpiU, pg8::StaticOrder, true>(lds, g, S, E);
        GRID_BAR();
    }
#endif

#ifndef SKIP_P2
    if (IN(2)) {
        const float m2 = attn_shift(args, lane);
        for (int it = bx; it < 256; it += G) ssd_state_item(args, lds, it, tid, wave, lane);
        for (int it = bx; it < 512; it += G) attn_unit(args, lds, it, tid, wave, lane, m2);
        for (int it = bx; it < 256; it += G) samp_ssm_item(args, lds, it, tid, wave, lane);
        for (int it = bx; it < 512; it += G) samp_attn_item(args, lds, it, tid, wave, lane);
        for (int it = bx; it < NB + DB; it += G) conv_out_item(args, it, tid);
        GRID_BAR();
    }
#endif

#ifndef SKIP_P3
    if (IN(3)) { ssd_scan(args, bx * NT + tid, G * NT); GRID_BAR(); }
#endif

#ifndef SKIP_P4
    if (IN(4)) {
        for (int it = bx; it < 256; it += G) ssd_out_item(args, lds, it, tid, wave, lane);
        GRID_BAR();
    }
#endif

#ifndef SKIP_P5
    if (IN(5)) {
        pg8::Gemm g{(const bf16_t*)(args.ws + WS_U), (const bf16_t*)(args.ws + WS_WOUT), MT, DM, 2048, UW, 16, (size_t)(C_Q - 1024) * 2};
        pg8::StaticOrder S; S.init(MT, DM, G, bx);
        pg8::EpiOut E{args.x_prompt, args.x_sample, args.out};
        pg8::gemm_phase<pg8::EpiOut, pg8::StaticOrder, true>(lds, g, S, E);
    }
#endif
#undef IN
#undef GRID_BAR
}

extern "C" void kernel_launch(void* const* d_in, const int* in_sizes, int n_in, void* d_out, int out_size, void* d_ws, size_t ws_size, hipStream_t stream) {
    static int grid = 0;
    if (grid == 0) {
        if (n_in != 19 || (size_t)out_size != O_END || ws_size < WS_END) { fprintf(stderr, "kernel_launch: unexpected shapes (n_in %d, out %d, ws %zu)\n", n_in, out_size, ws_size); grid = -1; return; }
        int dev = 0, cus = 0;
        if (hipGetDevice(&dev) != hipSuccess || hipDeviceGetAttribute(&cus, hipDeviceAttributeMultiprocessorCount, dev) != hipSuccess) { grid = -1; return; }
        if (hipFuncSetAttribute((const void*)mk_fwd, hipFuncAttributeMaxDynamicSharedMemorySize, LDS_BYTES) != hipSuccess) { fprintf(stderr, "kernel_launch: hipFuncSetAttribute failed\n"); grid = -1; return; }
        int per_cu = 0;
        if (hipOccupancyMaxActiveBlocksPerMultiprocessor(&per_cu, (const void*)mk_fwd, NT, LDS_BYTES) != hipSuccess || per_cu < 1) fprintf(stderr, "kernel_launch: occupancy query reports %d blocks per CU\n", per_cu);
        (void)hipGetLastError();
        grid = cus;
    }
    if (grid < 0) return;
    (void)hipMemsetAsync((char*)d_ws + WS_CTL, 0, CTL_ZERO_BYTES, stream);
    Args a{};
    const float** ap = (const float**)&a;
    for (int i = 0; i < 19; ++i) ap[i] = (const float*)d_in[i];
    a.out = (float*)d_out; a.ws = (unsigned char*)d_ws;
    if (MK_N_LAUNCHES == 1) { a.ph_lo = 0; a.ph_hi = 6; hipLaunchKernelGGL(mk_fwd, dim3(grid), dim3(NT), LDS_BYTES, stream, a); }
    else for (int ph = 0; ph < 6; ++ph) { a.ph_lo = ph; a.ph_hi = ph + 1; hipLaunchKernelGGL(mk_fwd, dim3(grid), dim3(NT), LDS_BYTES, stream, a); }
}
```

```cpp
#include <hip/hip_runtime.h>
#include <cstdio>
#include <cstdint>

#ifndef MK_N_LAUNCHES
#define MK_N_LAUNCHES 1
#endif

#ifndef MK_DUP
#define MK_DUP (-1)
#endif
#define LAS __attribute__((address_space(3)))
#define GAS __attribute__((address_space(1)))
typedef unsigned short bf16_t;
typedef short bf16x8 __attribute__((ext_vector_type(8)));
typedef short bf16x4 __attribute__((ext_vector_type(4)));
typedef float f32x4 __attribute__((ext_vector_type(4)));
typedef float f32x2 __attribute__((ext_vector_type(2)));
typedef unsigned u32x4 __attribute__((ext_vector_type(4)));
typedef unsigned u32x2 __attribute__((ext_vector_type(2)));

constexpr int DM = 1024, SEQ = 8192, NB = 2, MP = NB * SEQ;
constexpr int DB = 128, DL = 4, MS = DB * DL, MT = MP + MS;
constexpr int NIN = 5136, NINP = 5376;
constexpr int UW = 5120;
constexpr int C_Z = 0, C_X = 1024, C_B = 2048, C_C = 2304, C_Q = 2560, C_K = 3584, C_V = 3840, C_ZA = 4096;
constexpr int CONVD = 1536;
constexpr float EPS = 1e-6f;
constexpr float LOG2E = 1.4426950408889634f;

constexpr size_t MiB = 1u << 20;
constexpr size_t WS_CTL = 0, CTL_ZERO_BYTES = 1 * MiB;
constexpr size_t WS_WIN = 1 * MiB;
constexpr size_t WS_WOUT = 12 * MiB;
constexpr size_t WS_DT = 16 * MiB;
constexpr size_t WS_DEC = 17 * MiB + 512 * 1024;
constexpr size_t WS_U = 18 * MiB;
constexpr size_t WS_H = 183 * MiB;
constexpr size_t WS_ST = 183 * MiB;
constexpr size_t WS_END = 247 * MiB;
constexpr int CW_BAR = 4096;

constexpr size_t O_YP = 0, O_YS = 16777216, O_KP = 17301504, O_VP = 17367040, O_SP = 17432576, O_CP = 17694720,
                 O_KS = 17703936, O_VS = 21898240, O_SS = 26092544, O_CS = 42869760, O_END = 43459584;

__device__ __forceinline__ unsigned f2bf(float f) { unsigned u = __builtin_bit_cast(unsigned, f); return (u + 0x7fffu + ((u >> 16) & 1u)) >> 16; }
__device__ __forceinline__ unsigned pk2(float lo, float hi) { return f2bf(lo) | (f2bf(hi) << 16); }
__device__ __forceinline__ float bf2f(unsigned v) { return __builtin_bit_cast(float, v << 16); }
__device__ __forceinline__ float bflo(unsigned w) { return __builtin_bit_cast(float, w << 16); }
__device__ __forceinline__ float bfhi(unsigned w) { return __builtin_bit_cast(float, w & 0xffff0000u); }
__device__ __forceinline__ float silu_f(float x) { return x * __builtin_amdgcn_rcpf(1.0f + __expf(-x)); }
__device__ __forceinline__ float softplus_f(float x) { return fmaxf(x, 0.f) + log1pf(__expf(-fabsf(x))); }
__device__ __forceinline__ float wave_sum(float v) {
#pragma unroll
    for (int o = 1; o < 64; o <<= 1) v += __shfl_xor(v, o);
    return v;
}
__device__ __forceinline__ f32x4 mfma16(bf16x8 a, bf16x8 b, f32x4 c) { return __builtin_amdgcn_mfma_f32_16x16x32_bf16(a, b, c, 0, 0, 0); }
#define LDS_WAIT() asm volatile("s_waitcnt lgkmcnt(0)" ::: "memory")
#define VM_WAIT() asm volatile("s_waitcnt vmcnt(0)" ::: "memory")

namespace pg8 {
constexpr int BM = 256, BK = 64, HALF = 128, HTB = HALF * BK * 2, STAGE_BYTES = 8 * HTB, NXCD = 8, WGM = 8;
__host__ __device__ __forceinline__ int lds_byte(int r, int c) { const int st = (r >> 4) * 2 + (c >> 5), rr = r & 15, cc = c & 31, ob = rr * 64 + cc * 2; return st * 1024 + (ob ^ (((ob >> 9) & 1) << 5)); }
__host__ __device__ __forceinline__ void stage_rc(int b, int& R, int& C) { const int st = b / 1024, sb = b % 1024, swz = sb ^ (((sb >> 9) & 1) << 5); R = (st >> 1) * 16 + swz / 64; C = (st & 1) * 32 + (swz % 64) / 2; }
__host__ __device__ __forceinline__ int perm32(int rho) { const int n = rho >> 4, i = rho & 15; return 8 * (i >> 2) + 4 * n + (i & 3); }

struct Unit { int pm, pn; };
struct Gemm { const bf16_t* A; const bf16_t* Bt; int M, N, K, lda, kseg; size_t segskip; };

struct StaticOrder {
    int nM, nN, nwg, G, c;
    __host__ __device__ void init(int M, int N, int G_, int c_) { nM = M / BM; nN = N / BM; nwg = nM * nN; G = G_; c = c_; }
    __host__ __device__ bool next(int i, Unit& u) const {
        const long L = (long)i * G + c; if (L >= nwg) return false;
        int wgid = (int)L; { const int q = nwg / NXCD, r = nwg % NXCD, xcd = wgid % NXCD, off = wgid / NXCD; wgid = (xcd < r ? xcd * (q + 1) : r * (q + 1) + (xcd - r) * q) + off; }
        const int nig = WGM * nN, gid = wgid / nig, fm = gid * WGM, gsz = (nM - fm) < WGM ? (nM - fm) : WGM;
        u.pm = fm + ((wgid % nig) % gsz); u.pn = (wgid % nig) / gsz; return true;
    }
};

__device__ __forceinline__ unsigned cvt_pk_bf16(float lo, float hi) { unsigned r; asm volatile("v_cvt_pk_bf16_f32 %0, %1, %2" : "=v"(r) : "v"(lo), "v"(hi)); return r; }

struct EpiU {
    static constexpr bool PERM = true;
    bf16_t* U; float* DT;
    __device__ __forceinline__ void operator()(const f32x4 (&acc)[2][2][4][2], const Unit& u, int wr, int wc, int fr, int fq) const {
        const int row0 = u.pm * BM + wr * 64 + fr;
        if (u.pn < 20) {
            const int col0 = u.pn * BM + wc * 32 + 8 * fq;
#pragma unroll
            for (int ai = 0; ai < 2; ++ai)
#pragma unroll
                for (int m = 0; m < 4; ++m) { bf16_t* rowp = U + (size_t)(row0 + ai * HALF + m * 16) * UW + col0;
#pragma unroll
                    for (int bj = 0; bj < 2; ++bj) { const f32x4 v0 = acc[ai][bj][m][0], v1 = acc[ai][bj][m][1];
                        u32x4 w; w.x = cvt_pk_bf16(v0[0], v0[1]); w.y = cvt_pk_bf16(v0[2], v0[3]); w.z = cvt_pk_bf16(v1[0], v1[1]); w.w = cvt_pk_bf16(v1[2], v1[3]);
                        *(u32x4*)(rowp + bj * HALF) = w; } }
        } else if (wc == 0 && fq < 2) {
#pragma unroll
            for (int ai = 0; ai < 2; ++ai)
#pragma unroll
                for (int m = 0; m < 4; ++m) { float* rowp = DT + (size_t)(row0 + ai * HALF + m * 16) * 16 + 8 * fq;
                    *(f32x4*)(rowp) = acc[ai][0][m][0]; *(f32x4*)(rowp + 4) = acc[ai][0][m][1]; }
        }
    }
};
struct EpiOut {
    static constexpr bool PERM = false;
    const float* xp; const float* xs; float* out;
    __device__ __forceinline__ void operator()(const f32x4 (&acc)[2][2][4][2], const Unit& u, int wr, int wc, int fr, int fq) const {
        const int col0 = u.pn * BM + wc * 32 + 4 * fq;
#pragma unroll
        for (int ai = 0; ai < 2; ++ai)
#pragma unroll
            for (int m = 0; m < 4; ++m) { const int row = u.pm * BM + ai * HALF + wr * 64 + m * 16 + fr;
                const float* xb = (row < MP) ? xp + (size_t)row * DM : xs + (size_t)(row - MP) * DM; float* ob = out + (size_t)row * DM;
#pragma unroll
                for (int bj = 0; bj < 2; ++bj)
#pragma unroll
                    for (int n = 0; n < 2; ++n) { const int c = col0 + bj * HALF + n * 16; const f32x4 xv = *(const f32x4*)(xb + c); *(f32x4*)(ob + c) = xv + acc[ai][bj][m][n]; } }
    }
};

template <class Epi, class Sched, bool ALIGN_EPI>
__device__ __forceinline__ void gemm_phase(LAS unsigned char* lds, const Gemm g, const Sched& S, const Epi& E) {
    const int tid = threadIdx.x, wid = __builtin_amdgcn_readfirstlane(tid >> 6), lane = tid & 63, wr = wid >> 2, wc = wid & 3, fr = lane & 15, fq = lane >> 4;
    const int K = g.K, nt = K / BK, lda = g.lda, kseg = g.kseg;
    unsigned voffA[2], voffB[2];
#pragma unroll
    for (int i = 0; i < 2; ++i) { int R, C; stage_rc(tid * 16 + i * 8192, R, C); const int Rb = Epi::PERM ? ((R & ~31) + perm32(R & 31)) : R;
        voffA[i] = (unsigned)(R * lda + C) * 2u; voffB[i] = (unsigned)(Rb * K + C) * 2u; }
    const size_t kstep = (size_t)(BK * 2);
    const size_t hstepA = (size_t)HALF * lda * 2, tstepA = 2 * hstepA;
    const size_t hstepB = (size_t)HALF * K * 2, tstepB = 2 * hstepB;
    const size_t segskip = g.segskip;
#define KOFFA(t) ((size_t)(t) * kstep + (((t) >= kseg) ? segskip : (size_t)0))
    const unsigned ldsw = (unsigned)wid * 1024u;
    const int aoff = lds_byte(wr * 64 + fr, fq * 8), boff = lds_byte(wc * 32 + fr, fq * 8);
#define PG8_SA(b, h) (((b) * 2 + (h)) * HTB)
#define PG8_SB(b, h) ((4 + (b) * 2 + (h)) * HTB)
#define PG8_STAGE(bufoff, gbase, voff) do { _Pragma("unroll") for (int _i = 0; _i < 2; ++_i) \
        __builtin_amdgcn_global_load_lds((const unsigned*)((const char*)(gbase) + (voff)[_i]), (LAS unsigned*)(lds + (bufoff) + ldsw + _i * 8192), 16, 0, 0); } while (0)
#define PG8_LDA(dst, b, h) do { _Pragma("unroll") for (int m = 0; m < 4; ++m) _Pragma("unroll") for (int k = 0; k < 2; ++k) dst[m][k] = *(const LAS bf16x8*)(lds + PG8_SA(b, h) + aoff + m * 2048 + k * 1024); } while (0)
#define PG8_LDB(dst, b, h) do { _Pragma("unroll") for (int n = 0; n < 2; ++n) _Pragma("unroll") for (int k = 0; k < 2; ++k) dst[n][k] = *(const LAS bf16x8*)(lds + PG8_SB(b, h) + boff + n * 2048 + k * 1024); } while (0)
#define PG8_MMA(ai, bj, At, Bt) do { __builtin_amdgcn_s_setprio(1); _Pragma("unroll") for (int m = 0; m < 4; ++m) _Pragma("unroll") for (int n = 0; n < 2; ++n) _Pragma("unroll") for (int k = 0; k < 2; ++k) \
        acc[ai][bj][m][n] = __builtin_amdgcn_mfma_f32_16x16x32_bf16(Bt[n][k], At[m][k], acc[ai][bj][m][n], 0, 0, 0); __builtin_amdgcn_s_setprio(0); } while (0)
#define PG8_WAIT_V(n) asm volatile("s_waitcnt vmcnt(" #n ")" ::: "memory")
#define PG8_WAIT_L(n) asm volatile("s_waitcnt lgkmcnt(" #n ")" ::: "memory")
#define PG8_BAR __builtin_amdgcn_s_barrier()
#define PG8_SCHED __builtin_amdgcn_sched_barrier(0)
    Unit cur, nxt; int ui = 0;
    if (!S.next(0, cur)) return;
    f32x4 acc[2][2][4][2];
#pragma unroll
    for (int a = 0; a < 2; ++a)
#pragma unroll
        for (int b = 0; b < 2; ++b)
#pragma unroll
            for (int m = 0; m < 4; ++m)
#pragma unroll
                for (int n = 0; n < 2; ++n) acc[a][b][m][n] = (f32x4){0.f, 0.f, 0.f, 0.f};
    bf16x8 At[4][2], B0[2][2], B1[2][2];
    const char* cA = (const char*)g.A + (size_t)cur.pm * tstepA; const char* cB = (const char*)g.Bt + (size_t)cur.pn * tstepB;
    PG8_STAGE(PG8_SB(0, 0), cB, voffB); PG8_STAGE(PG8_SB(0, 1), cB + hstepB, voffB); PG8_STAGE(PG8_SA(0, 0), cA, voffA); PG8_STAGE(PG8_SA(0, 1), cA + hstepA, voffA);
    if (wr == 1) PG8_BAR;
    PG8_WAIT_V(2); PG8_BAR;
    PG8_STAGE(PG8_SB(1, 0), cB + kstep, voffB); PG8_STAGE(PG8_SA(1, 0), cA + KOFFA(1), voffA); PG8_STAGE(PG8_SB(1, 1), cB + hstepB + kstep, voffB);
    PG8_WAIT_V(6); PG8_BAR;
    for (;;) {
        const bool has_next = S.next(ui + 1, nxt);
        const char* nA = has_next ? (const char*)g.A + (size_t)nxt.pm * tstepA : cA; const char* nB = has_next ? (const char*)g.Bt + (size_t)nxt.pn * tstepB : cB;
        for (int t = 0; t < nt; t += 2) {
            const bool last = (t == nt - 2);
            const char* a1 = cA + KOFFA(t + 1);
            const char* a2 = last ? nA : cA + KOFFA(t + 2); const char* b2 = last ? nB : cB + (size_t)(t + 2) * kstep;
            const char* a3 = last ? nA + KOFFA(1) : cA + KOFFA(t + 3); const char* b3 = b2 + kstep;
            PG8_LDB(B0, 0, 0); PG8_LDB(B1, 0, 1); PG8_SCHED; PG8_LDA(At, 0, 0); PG8_STAGE(PG8_SA(1, 1), a1 + hstepA, voffA);
            PG8_WAIT_V(8); PG8_WAIT_L(0); PG8_BAR; PG8_MMA(0, 0, At, B0); PG8_MMA(0, 1, At, B1); PG8_BAR; PG8_SCHED;
            PG8_LDA(At, 0, 1); PG8_STAGE(PG8_SB(0, 0), b2, voffB); PG8_STAGE(PG8_SB(0, 1), b2 + hstepB, voffB); PG8_STAGE(PG8_SA(0, 0), a2, voffA);
            PG8_WAIT_V(8); PG8_WAIT_L(0); PG8_BAR; PG8_MMA(1, 0, At, B0); PG8_MMA(1, 1, At, B1); PG8_BAR; PG8_SCHED;
            PG8_LDB(B0, 1, 0); PG8_LDB(B1, 1, 1); PG8_SCHED; PG8_LDA(At, 1, 0); PG8_STAGE(PG8_SA(0, 1), a2 + hstepA, voffA);
            PG8_WAIT_V(8); PG8_WAIT_L(0); PG8_BAR; PG8_MMA(0, 0, At, B0); PG8_MMA(0, 1, At, B1); PG8_BAR; PG8_SCHED;
            PG8_LDA(At, 1, 1); PG8_STAGE(PG8_SB(1, 0), b3, voffB); PG8_STAGE(PG8_SB(1, 1), b3 + hstepB, voffB); PG8_STAGE(PG8_SA(1, 0), a3, voffA);
            PG8_WAIT_V(8); PG8_WAIT_L(0); PG8_BAR; PG8_MMA(1, 0, At, B0); PG8_MMA(1, 1, At, B1); PG8_BAR; PG8_SCHED;
        }
        if constexpr (ALIGN_EPI) { if (wr == 0) PG8_BAR; }
        E(acc, cur, wr, wc, fr, fq);
        if (!has_next) break;
#pragma unroll
        for (int a = 0; a < 2; ++a)
#pragma unroll
            for (int b = 0; b < 2; ++b)
#pragma unroll
                for (int m = 0; m < 4; ++m)
#pragma unroll
                    for (int n = 0; n < 2; ++n) acc[a][b][m][n] = (f32x4){0.f, 0.f, 0.f, 0.f};
        cur = nxt; cA = nA; cB = nB; ++ui;
        if constexpr (ALIGN_EPI) { if (wr == 1) PG8_BAR; }
    }
    PG8_WAIT_V(0);
    if constexpr (!ALIGN_EPI) { if (wr == 0) PG8_BAR; }
    PG8_BAR;
#undef KOFFA
#undef PG8_SA
#undef PG8_SB
#undef PG8_STAGE
#undef PG8_LDA
#undef PG8_LDB
#undef PG8_MMA
#undef PG8_WAIT_V
#undef PG8_WAIT_L
#undef PG8_BAR
#undef PG8_SCHED
}
}

typedef GAS unsigned gu32;
#define RLX_AGENT __ATOMIC_RELAXED, __HIP_MEMORY_SCOPE_AGENT
#define XB_TMO      128
#define XB_XCNT(j)  (256  + 64 * (j))
#define XB_XSUB(j)  (1280 + 64 * (j))
#define XB_XGEN(j)  (2304 + 64 * (j))
#define XB_TOP      3328
#define XB_TOPGEN   3392
#define XCD_BAR_WORDS 3456
#define XB_SPIN_CAP (1u << 18)
__device__ __forceinline__ unsigned xb_ld(unsigned* p)              { return __hip_atomic_load(p, __ATOMIC_RELAXED, __HIP_MEMORY_SCOPE_AGENT); }
__device__ __forceinline__ unsigned xb_add(unsigned* p, unsigned v) { return __hip_atomic_fetch_add(p, v, __ATOMIC_RELAXED, __HIP_MEMORY_SCOPE_AGENT); }
__device__ __forceinline__ unsigned xb_xcc_id() { return (unsigned)__builtin_amdgcn_s_getreg((3 << 11) | 20) & 0xFu; }
#define XB_SPIN(cond, bar) do { unsigned _sp = 0; while (cond) { __builtin_amdgcn_s_sleep(1); \
    if ((++_sp & 255u) == 0u) { if (xb_ld(&(bar)[XB_TMO])) break; if (_sp > XB_SPIN_CAP) { atomicAdd(&(bar)[XB_TMO], 1u); break; } } } } while (0)
struct XcdBarrier { unsigned* bar; unsigned x; volatile LAS unsigned* st; };
__device__ __forceinline__ XcdBarrier xcd_barrier_post(unsigned* bar, volatile LAS unsigned* st) {
    XcdBarrier b; b.bar = bar; b.x = xb_xcc_id(); b.st = st;
    if (threadIdx.x == 0) (void)xb_add(&bar[XB_XCNT(b.x)], 1u);
    return b;
}
__device__ __forceinline__ void xcd_barrier_complete(unsigned* bar, unsigned x, unsigned& nloc, unsigned& nx) {
    const unsigned G = gridDim.x * gridDim.y * gridDim.z;
    unsigned sum, cnt, mine, sp = 0u;
    for (;;) {
        sum = 0u; cnt = 0u; mine = 0u;
#pragma unroll
        for (unsigned j = 0; j < 16; ++j) { const unsigned c = xb_ld(&bar[XB_XCNT(j)]); sum += c; cnt += (c > 0u) ? 1u : 0u; mine = (j == x) ? c : mine; }
        if (sum == G) break;
        __builtin_amdgcn_s_sleep(1);
        if ((++sp & 255u) == 0u) { if (xb_ld(&bar[XB_TMO])) break; if (sp > XB_SPIN_CAP) { atomicAdd(&bar[XB_TMO], 1u); break; } }
    }
    nloc = mine > 0u ? mine : 1u; nx = cnt > 0u ? cnt : 1u;
}
__device__ __forceinline__ void xcd_barrier(const XcdBarrier& b) {
    asm volatile("s_waitcnt vmcnt(0)" ::: "memory");
    __syncthreads();
    if (threadIdx.x == 0) {
        unsigned* bar = b.bar;
        __builtin_amdgcn_s_waitcnt(0);
        unsigned nloc = b.st[0], nx = b.st[1];
        if (nloc == 0u) { xcd_barrier_complete(bar, b.x, nloc, nx); b.st[0] = nloc; b.st[1] = nx; }
        const unsigned old = xb_add(&bar[XB_XSUB(b.x)], 1u);
        const unsigned gen = old / nloc;
        if (old + 1u == (gen + 1u) * nloc) {
            __builtin_amdgcn_fence(__ATOMIC_RELEASE, "agent");
            asm volatile("s_waitcnt vmcnt(0)" ::: "memory");
            const unsigned og = xb_add(&bar[XB_TOP], 1u);
            const unsigned tg = og / nx;
            if (og + 1u == (tg + 1u) * nx) xb_add(&bar[XB_TOPGEN], 1u);
            else XB_SPIN(xb_ld(&bar[XB_TOPGEN]) == tg, bar);
            __builtin_amdgcn_fence(__ATOMIC_ACQUIRE, "agent");
            xb_add(&bar[XB_XGEN(b.x)], 1u);
            asm volatile("s_waitcnt vmcnt(0)" ::: "memory");
        } else {
            XB_SPIN(xb_ld(&bar[XB_XGEN(b.x)]) == gen, bar);
            __builtin_amdgcn_fence(__ATOMIC_ACQUIRE, "agent");
            asm volatile("s_waitcnt vmcnt(0)" ::: "memory");
        }
    }
    __syncthreads();
}

struct Args {
    const float *x_prompt, *x_sample, *cache_k, *cache_v, *state_ssm, *state_conv, *norm_w, *w_in, *conv_w, *conv_b,
                *dt_bias, *a_log, *d_skip, *ssm_norm_w, *q_norm_w, *k_norm_w, *sinks, *rel_table, *w_out;
    float* out; unsigned char* ws; int ph_lo, ph_hi, sub, dry;
};
constexpr int NWAVES = 8, NT = 512;
constexpr int RING_BYTES = 131072, MISC_OFF = RING_BYTES + 320, LDS_BYTES = 147456;

template <bool REMAP>
__device__ __forceinline__ void p0_transpose_item(const float* W, int K, int N, bf16_t* WT, LAS float* scr, int item, int lane) {
    const int nblk = (N + 31) / 32, kb = item / nblk, nb = item % nblk, k0 = 64 * kb, n0 = 32 * nb;
    const bool nok = (n0 + (lane & 31)) < N;
#pragma unroll 8
    for (int i = 0; i < 32; ++i) { const int kk = 2 * i + (lane >> 5); scr[kk * 33 + (lane & 31)] = nok ? W[(size_t)(k0 + kk) * N + n0 + (lane & 31)] : 0.f; }
    LDS_WAIT(); asm volatile("" ::: "memory");
    const int c = lane & 7;
#pragma unroll
    for (int j = 0; j < 4; ++j) { const int n = (lane >> 3) + 8 * j; const LAS float* s = scr + (8 * c) * 33 + n;
        u32x4 o; o.x = pk2(s[0 * 33], s[1 * 33]); o.y = pk2(s[2 * 33], s[3 * 33]); o.z = pk2(s[4 * 33], s[5 * 33]); o.w = pk2(s[6 * 33], s[7 * 33]);
        int ng = n0 + n;
        if (ng < N) { if (REMAP) ng = (ng < 2560) ? ng : (ng < 2576 ? ng + 2560 : ng - 16);
            *(u32x4*)(WT + (size_t)ng * K + k0 + 8 * c) = o; } }
    LDS_WAIT(); asm volatile("" ::: "memory");
}
__device__ __forceinline__ void p0_prologue(const Args& a, LAS unsigned char* lds, int vcu, int G, int wave, int lane) {
    LAS float* scr = (LAS float*)(lds + wave * 16384);
    bf16_t* WinT = (bf16_t*)(a.ws + WS_WIN); bf16_t* WoutT = (bf16_t*)(a.ws + WS_WOUT); bf16_t* H = (bf16_t*)(a.ws + WS_H);
    const int gw = vcu * NWAVES + wave, NGW = G * NWAVES;
    constexpr int I_IN = (DM / 64) * ((NIN + 31) / 32), I_OUT = (2048 / 64) * (DM / 32);
    for (int it = gw; it < I_IN + I_OUT; it += NGW) {
        if (it < I_IN) p0_transpose_item<true>(a.w_in, DM, NIN, WinT, scr, it, lane);
        else p0_transpose_item<false>(a.w_out, 2048, DM, WoutT, scr, it - I_IN, lane);
    }
    for (int r = gw; r < NINP - NIN; r += NGW) { u32x4* p = (u32x4*)(WinT + (size_t)(NIN + r) * DM); p[lane] = (u32x4){0u, 0u, 0u, 0u}; p[lane + 64] = (u32x4){0u, 0u, 0u, 0u}; }
    f32x4 nw[4];
#pragma unroll
    for (int j = 0; j < 4; ++j) nw[j] = ((const f32x4*)a.norm_w)[lane + 64 * j];
    for (int m = gw; m < MT; m += NGW) {
        const float* xrow = (m < MP) ? a.x_prompt + (size_t)m * DM : a.x_sample + (size_t)(m - MP) * DM;
        const f32x4* xr = (const f32x4*)xrow + lane;
        f32x4 v[4]; float s = 0.f;
#pragma unroll
        for (int j = 0; j < 4; ++j) { v[j] = xr[64 * j]; s += (v[j].x * v[j].x + v[j].y * v[j].y) + (v[j].z * v[j].z + v[j].w * v[j].w); }
        const float rstd = 1.0f / sqrtf(wave_sum(s) * (1.f / DM) + EPS);
        unsigned long long* o8 = (unsigned long long*)(H + (size_t)m * DM) + lane;
#pragma unroll
        for (int j = 0; j < 4; ++j) { const f32x4 h = v[j] * rstd * nw[j]; o8[64 * j] = (unsigned long long)pk2(h.x, h.y) | ((unsigned long long)pk2(h.z, h.w) << 32); }
    }
}

__device__ __forceinline__ float ssd_dt_scan(const float* DT, int R0, int h, int e, int lane, const float* dt_bias, const float* a_log, LAS float* dtv, LAS float* acum, float& d0o, float& d1o, float& c0o, float& c1o) {
    const float bias = dt_bias[h]; const float A = -expf(a_log[h]);
    const int l0 = 2 * lane;
    const float d0 = softplus_f(DT[(size_t)(R0 + l0) * 16 + h] + bias), d1 = softplus_f(DT[(size_t)(R0 + l0 + 1) * 16 + h] + bias);
    const float a0 = d0 * A, a1 = d1 * A; float s = a0 + a1;
#pragma unroll
    for (int o = 1; o < 64; o <<= 1) { const float t = __shfl_up(s, o); if (lane >= o) s += t; }
    const float excl = s - (a0 + a1);
    const float c0 = excl + a0, c1 = excl + a0 + a1;
    dtv[e * 128 + l0] = d0; dtv[e * 128 + l0 + 1] = d1; acum[e * 128 + l0] = c0; acum[e * 128 + l0 + 1] = c1;
    d0o = d0; d1o = d1; c0o = c0; c1o = c1;
    return __shfl(s, 63);
}

__device__ __forceinline__ void ssd_state_item(const Args& a, LAS unsigned char* lds, int item, int tid, int wave, int lane) {
    const int b = item >> 7, c = (item >> 1) & 63, g = item & 1;
    const int R0 = b * SEQ + c * 128;
    const bf16_t* U = (const bf16_t*)(a.ws + WS_U); const float* DT = (const float*)(a.ws + WS_DT);
    float* ST = (float*)(a.ws + WS_ST); float* DEC = (float*)(a.ws + WS_DEC);
    LAS bf16_t* Bt = (LAS bf16_t*)lds;
    LAS bf16_t* Xt = (LAS bf16_t*)(lds + 34816);
    LAS float* dtv = (LAS float*)(lds + 52224); LAS float* acum = dtv + 1024; LAS float* wv = acum + 1024;
    {
        float d0, d1, c0, c1; const int h = 8 * g + wave;
        const float aend = ssd_dt_scan(DT, R0, h, wave, lane, a.dt_bias, a.a_log, dtv, acum, d0, d1, c0, c1);
        wv[wave * 128 + 2 * lane] = d0 * __expf(aend - c0); wv[wave * 128 + 2 * lane + 1] = d1 * __expf(aend - c1);
        if (lane == 0) DEC[(b * 64 + c) * 16 + h] = __expf(aend);
    }
    {
        const int n = tid & 127, q = tid >> 7, ch = 1024 + 128 * g + n; const int col = C_X + ch;
        const float w0 = a.conv_w[ch], w1 = a.conv_w[CONVD + ch], w2 = a.conv_w[2 * CONVD + ch], w3 = a.conv_w[3 * CONVD + ch], cb = a.conv_b[ch];
        const int lb = 32 * q; const bool has_prev = (c > 0) || (lb > 0);
        const bf16_t* up = U + (size_t)(R0 + lb) * UW + col;
        float u0 = has_prev ? bf2f(up[-3 * UW]) : 0.f, u1 = has_prev ? bf2f(up[-2 * UW]) : 0.f, u2 = has_prev ? bf2f(up[-1 * UW]) : 0.f;
#pragma unroll 4
        for (int i = 0; i < 32; i += 2) {
            const float u3 = bf2f(up[(size_t)i * UW]), u4 = bf2f(up[(size_t)(i + 1) * UW]);
            const float v0 = silu_f(cb + w0 * u0 + w1 * u1 + w2 * u2 + w3 * u3), v1 = silu_f(cb + w0 * u1 + w1 * u2 + w2 * u3 + w3 * u4);
            *(LAS unsigned*)(Bt + n * 136 + lb + i) = pk2(v0, v1);
            u0 = u2; u1 = u3; u2 = u4;
        }
    }
    const int fr = lane & 15, grp = lane >> 4;
    for (int e = 0; e < 8; ++e) {
        const int h = 8 * g + e;
        {
            const int p = tid & 63, o = tid >> 6, ch = 64 * h + p; const int col = C_X + ch;
            const float w0 = a.conv_w[ch], w1 = a.conv_w[CONVD + ch], w2 = a.conv_w[2 * CONVD + ch], w3 = a.conv_w[3 * CONVD + ch], cb = a.conv_b[ch];
            const int lb = 16 * o; const bool has_prev = (c > 0) || (lb > 0);
            const bf16_t* up = U + (size_t)(R0 + lb) * UW + col;
            float u0 = has_prev ? bf2f(up[-3 * UW]) : 0.f, u1 = has_prev ? bf2f(up[-2 * UW]) : 0.f, u2 = has_prev ? bf2f(up[-1 * UW]) : 0.f;
            __syncthreads();
#pragma unroll 4
            for (int i = 0; i < 16; i += 2) {
                const float u3 = bf2f(up[(size_t)i * UW]), u4 = bf2f(up[(size_t)(i + 1) * UW]);
                const float v0 = silu_f(cb + w0 * u0 + w1 * u1 + w2 * u2 + w3 * u3) * wv[e * 128 + lb + i], v1 = silu_f(cb + w0 * u1 + w1 * u2 + w2 * u3 + w3 * u4) * wv[e * 128 + lb + i + 1];
                *(LAS unsigned*)(Xt + p * 136 + lb + i) = pk2(v0, v1);
                u0 = u2; u1 = u3; u2 = u4;
            }
        }
        __syncthreads();
        f32x4 acc[4];
#pragma unroll
        for (int pt = 0; pt < 4; ++pt) acc[pt] = (f32x4){0.f, 0.f, 0.f, 0.f};
#pragma unroll
        for (int ks = 0; ks < 4; ++ks) {
            const bf16x8 af = *(const LAS bf16x8*)(Bt + (16 * wave + fr) * 136 + 32 * ks + 8 * grp);
#pragma unroll
            for (int pt = 0; pt < 4; ++pt) { const bf16x8 bfr = *(const LAS bf16x8*)(Xt + (16 * pt + fr) * 136 + 32 * ks + 8 * grp); acc[pt] = mfma16(af, bfr, acc[pt]); }
        }
        float* stp = ST + ((size_t)((b * 64 + c) * 16 + h) * 64) * 128 + 16 * wave + 4 * grp;
#pragma unroll
        for (int pt = 0; pt < 4; ++pt) *(f32x4*)(stp + (size_t)(16 * pt + fr) * 128) = acc[pt];
    }
    __syncthreads();
}

__device__ __forceinline__ void ssd_scan(const Args& a, int gtid, int gthreads, const bool dry) {
    float* ST = (float*)(a.ws + WS_ST); const float* DEC = (const float*)(a.ws + WS_DEC);
    for (int el = gtid; el < NB * 16 * 4096; el += gthreads) {
        const int q = el & 4095, bh = el >> 12, b = bh >> 4, h = bh & 15;
        f32x2 carry = (f32x2){0.f, 0.f};
        float* p = ST + ((size_t)(b * 64) * 16 + h) * 8192 + 2 * q;
        const float* dp = DEC + (b * 64) * 16 + h;
#pragma unroll 8
        for (int c = 0; c < 64; ++c) {
            const f32x2 v = *(const f32x2*)(p + (size_t)c * 16 * 8192); const float d = dp[c * 16];
            if (!dry) *(f32x2*)(p + (size_t)c * 16 * 8192) = carry; carry = carry * d + v;
        }
        if (!dry || carry.x == 12345.678f) *(f32x2*)(a.out + O_SP + (size_t)bh * 8192 + 2 * q) = carry;
    }
}

__device__ __forceinline__ void ssd_out_item(const Args& a, LAS unsigned char* lds, int item, int tid, int wave, int lane, const bool dry) {
    const int b = item >> 7, c = (item >> 1) & 63, g = item & 1;
    const int R0 = b * SEQ + c * 128;
    bf16_t* U = (bf16_t*)(a.ws + WS_U); const float* DT = (const float*)(a.ws + WS_DT); const float* ST = (const float*)(a.ws + WS_ST);
    LAS bf16_t* Cn = (LAS bf16_t*)lds;
    LAS bf16_t* Bn = (LAS bf16_t*)(lds + 34816);
    LAS bf16_t* Xt = (LAS bf16_t*)(lds + 69632);
    LAS bf16_t* St = (LAS bf16_t*)(lds + 87040);
    LAS float* dtv = (LAS float*)(lds + 104448); LAS float* acum = dtv + 1024;
    { float d0, d1, c0, c1; (void)ssd_dt_scan(DT, R0, 8 * g + wave, wave, lane, a.dt_bias, a.a_log, dtv, acum, d0, d1, c0, c1); }
    {
        const int chn = tid & 255, hf = tid >> 8, ch = 1024 + ((chn < 128) ? (128 * g + chn) : (256 + 128 * g + (chn - 128))); const int col = C_X + ch;
        LAS bf16_t* dst = (chn < 128) ? (Bn + chn) : (Cn + (chn - 128));
        const float w0 = a.conv_w[ch], w1 = a.conv_w[CONVD + ch], w2 = a.conv_w[2 * CONVD + ch], w3 = a.conv_w[3 * CONVD + ch], cb = a.conv_b[ch];
        const int lb = 64 * hf; const bool has_prev = (c > 0) || (lb > 0);
        const bf16_t* up = U + (size_t)(R0 + lb) * UW + col;
        float u0 = has_prev ? bf2f(up[-3 * UW]) : 0.f, u1 = has_prev ? bf2f(up[-2 * UW]) : 0.f, u2 = has_prev ? bf2f(up[-1 * UW]) : 0.f;
#pragma unroll 4
        for (int i = 0; i < 64; ++i) {
            const float u3 = bf2f(up[(size_t)i * UW]);
            dst[(lb + i) * 136] = (bf16_t)f2bf(silu_f(cb + w0 * u0 + w1 * u1 + w2 * u2 + w3 * u3));
            u0 = u1; u1 = u2; u2 = u3;
        }
    }
    __syncthreads();
    const int fr = lane & 15, grp = lane >> 4;
    const int l = 16 * wave + fr;
    f32x4 cb[8];
#pragma unroll
    for (int st = 0; st < 8; ++st) cb[st] = (f32x4){0.f, 0.f, 0.f, 0.f};
#pragma unroll
    for (int ks = 0; ks < 4; ++ks) {
        const bf16x8 cf = *(const LAS bf16x8*)(Cn + (16 * wave + fr) * 136 + 32 * ks + 8 * grp);
#pragma unroll
        for (int st = 0; st < 8; ++st) if (st <= wave) { const bf16x8 bfm = *(const LAS bf16x8*)(Bn + (16 * st + fr) * 136 + 32 * ks + 8 * grp); cb[st] = mfma16(bfm, cf, cb[st]); }
    }
    float ssq = 0.f;
    bf16_t* yrow = U + (size_t)(R0 + l) * UW + C_Z + 512 * g + 4 * grp;
#pragma unroll 1
    for (int e = 0; e < 8; ++e) {
        const int h = 8 * g + e;
        __syncthreads();
        {
            const int p = tid & 63, o = tid >> 6, ch = 64 * h + p; const int col = C_X + ch;
            const float w0 = a.conv_w[ch], w1 = a.conv_w[CONVD + ch], w2 = a.conv_w[2 * CONVD + ch], w3 = a.conv_w[3 * CONVD + ch], cbias = a.conv_b[ch];
            const int lb = 16 * o; const bool has_prev = (c > 0) || (lb > 0);
            const bf16_t* up = U + (size_t)(R0 + lb) * UW + col;
            float u0 = has_prev ? bf2f(up[-3 * UW]) : 0.f, u1 = has_prev ? bf2f(up[-2 * UW]) : 0.f, u2 = has_prev ? bf2f(up[-1 * UW]) : 0.f;
#pragma unroll 4
            for (int i = 0; i < 16; i += 2) {
                const float u3 = bf2f(up[(size_t)i * UW]), u4 = bf2f(up[(size_t)(i + 1) * UW]);
                const float v0 = silu_f(cbias + w0 * u0 + w1 * u1 + w2 * u2 + w3 * u3), v1 = silu_f(cbias + w0 * u1 + w1 * u2 + w2 * u3 + w3 * u4);
                *(LAS unsigned*)(Xt + p * 136 + lb + i) = pk2(v0, v1);
                u0 = u2; u1 = u3; u2 = u4;
            }
        }
        {
            const int p = tid >> 3, n0 = 16 * (tid & 7);
            const f32x4* sp = (const f32x4*)(ST + ((size_t)((b * 64 + c) * 16 + h) * 64 + p) * 128 + n0);
            const f32x4 s0 = sp[0], s1 = sp[1], s2 = sp[2], s3 = sp[3];
            u32x4 w0; w0.x = pk2(s0.x, s0.y); w0.y = pk2(s0.z, s0.w); w0.z = pk2(s1.x, s1.y); w0.w = pk2(s1.z, s1.w);
            u32x4 w1; w1.x = pk2(s2.x, s2.y); w1.y = pk2(s2.z, s2.w); w1.z = pk2(s3.x, s3.y); w1.w = pk2(s3.z, s3.w);
            *(LAS u32x4*)(St + p * 136 + n0) = w0; *(LAS u32x4*)(St + p * 136 + n0 + 8) = w1;
        }
        __syncthreads();
        f32x4 accd[4], acco[4];
#pragma unroll
        for (int pt = 0; pt < 4; ++pt) { accd[pt] = (f32x4){0.f, 0.f, 0.f, 0.f}; acco[pt] = (f32x4){0.f, 0.f, 0.f, 0.f}; }
        const float al = acum[e * 128 + l];
#pragma unroll
        for (int ks = 0; ks < 4; ++ks) if (2 * ks <= wave) {
            const int sA = 32 * ks + 4 * grp, sB = sA + 16;
            const f32x4 acA = *(const LAS f32x4*)(acum + e * 128 + sA), acB = *(const LAS f32x4*)(acum + e * 128 + sB);
            const f32x4 dtA = *(const LAS f32x4*)(dtv + e * 128 + sA), dtB = *(const LAS f32x4*)(dtv + e * 128 + sB);
            float m[8];
#pragma unroll
            for (int j = 0; j < 4; ++j) {
                const float va = cb[2 * ks][j] * dtA[j] * __expf(al - acA[j]); m[j] = (sA + j <= l) ? va : 0.f;
                const float vb = cb[2 * ks + 1][j] * dtB[j] * __expf(al - acB[j]); m[4 + j] = (sB + j <= l) ? vb : 0.f;
            }
            u32x4 mw; mw.x = pk2(m[0], m[1]); mw.y = pk2(m[2], m[3]); mw.z = pk2(m[4], m[5]); mw.w = pk2(m[6], m[7]);
            const bf16x8 mf = __builtin_bit_cast(bf16x8, mw);
#pragma unroll
            for (int pt = 0; pt < 4; ++pt) {
                const u32x2 lo = *(const LAS u32x2*)(Xt + (16 * pt + fr) * 136 + sA), hi = *(const LAS u32x2*)(Xt + (16 * pt + fr) * 136 + sB);
                u32x4 aw; aw.x = lo.x; aw.y = lo.y; aw.z = hi.x; aw.w = hi.y;
                accd[pt] = mfma16(__builtin_bit_cast(bf16x8, aw), mf, accd[pt]);
            }
        }
#pragma unroll
        for (int ks = 0; ks < 4; ++ks) {
            const bf16x8 cf = *(const LAS bf16x8*)(Cn + (16 * wave + fr) * 136 + 32 * ks + 8 * grp);
#pragma unroll
            for (int pt = 0; pt < 4; ++pt) { const bf16x8 sf = *(const LAS bf16x8*)(St + (16 * pt + fr) * 136 + 32 * ks + 8 * grp); acco[pt] = mfma16(sf, cf, acco[pt]); }
        }
        const float eal = __expf(al), dsk = a.d_skip[h];
#pragma unroll
        for (int pt = 0; pt < 4; ++pt) {
            const u32x2 zz = *(const u32x2*)(yrow + 64 * e + 16 * pt);
            const float z[4] = {bflo(zz.x), bfhi(zz.x), bflo(zz.y), bfhi(zz.y)};
            float gy[4];
#pragma unroll
            for (int r = 0; r < 4; ++r) {
                const float xv = bf2f(Xt[(16 * pt + 4 * grp + r) * 136 + l]);
                const float y = accd[pt][r] + eal * acco[pt][r] + dsk * xv;
                gy[r] = y * silu_f(z[r]); ssq += gy[r] * gy[r];
            }
            u32x2 o; o.x = pk2(gy[0], gy[1]); o.y = pk2(gy[2], gy[3]);
            if (!dry) *(u32x2*)(yrow + 64 * e + 16 * pt) = o;
        }
    }
    ssq += __shfl_xor(ssq, 16); ssq += __shfl_xor(ssq, 32);
    const float rstd = 1.0f / sqrtf(ssq * (1.f / 512.f) + EPS);
#pragma unroll 2
    for (int e = 0; e < 8; ++e)
#pragma unroll
        for (int pt = 0; pt < 4; ++pt) {
            const f32x4 nw = *(const f32x4*)(a.ssm_norm_w + 512 * g + 64 * e + 16 * pt + 4 * grp);
            const u32x2 v = *(const u32x2*)(yrow + 64 * e + 16 * pt);
            u32x2 o; o.x = pk2(bflo(v.x) * rstd * nw.x, bfhi(v.x) * rstd * nw.y); o.y = pk2(bflo(v.y) * rstd * nw.z, bfhi(v.y) * rstd * nw.w);
            if (!dry || o.x == 0x12345678u) *(u32x2*)(yrow + 64 * e + 16 * pt) = o;
        }
    __syncthreads();
}

__device__ __forceinline__ int rel_bucket(int d) {
    if (d < 16) return d;
    const int lg = 16 + (int)(logf((float)d * (1.0f / 16.0f)) * (16.0f / 2.0794415416798357f));
    return lg < 31 ? lg : 31;
}
struct AttnKV { u32x4 k[4], v[4]; };
__device__ __forceinline__ void attn_load_kv(const bf16_t* U, int unit, int tid, AttnKV& r) {
    const int b = unit >> 8, blk = (unit >> 2) & 63, kvh = unit & 3; const int R0 = b * SEQ + blk * 128;
    const int jk = tid >> 1, hf = tid & 1, jv = tid & 255, dh = tid >> 8;
    const bool zk = (blk == 0 && jk < 128), zv = (blk == 0 && jv < 128);
    const u32x4* kp = (const u32x4*)(U + (size_t)(R0 - 128 + (zk ? 128 : jk)) * UW + C_K + 64 * kvh + 32 * hf);
    const u32x4* vp = (const u32x4*)(U + (size_t)(R0 - 128 + (zv ? 128 : jv)) * UW + C_V + 64 * kvh + 32 * dh);
#pragma unroll
    for (int i = 0; i < 4; ++i) { r.k[i] = kp[i]; r.v[i] = vp[i]; }
}
__device__ __forceinline__ void attn_phase(const Args& a, LAS unsigned char* lds, int bx, int G, int tid, int wave, int lane, float m2, const bool dry) {
    bf16_t* U = (bf16_t*)(a.ws + WS_U);
    LAS bf16_t* Kn = (LAS bf16_t*)lds;
    LAS bf16_t* Vt = (LAS bf16_t*)(lds + 41472);
    LAS float* bias2 = (LAS float*)(lds + 77312);
    int unit = bx; if (unit >= 512) return;
    AttnKV kv; attn_load_kv(U, unit, tid, kv);
    __syncthreads();
    for (int i = tid; i < 16 * 129; i += NT) { const int hh = i / 129, d = i % 129; bias2[hh * 132 + d] = a.rel_table[rel_bucket(d) * 16 + hh] * LOG2E; }
    if (tid < 288) *(LAS u32x4*)(Kn + 256 * 72 + tid * 8) = (u32x4){0u, 0u, 0u, 0u};
    for (int i = tid; i < 64 * 12; i += NT) { const int d0 = i / 12, cc = i % 12; *(LAS unsigned*)(Vt + d0 * 280 + 256 + 2 * cc) = 0u; }
    const int fr = lane & 15, grp = lane >> 4;
    const float qscale = 0.125f * LOG2E;
    while (unit < 512) {
        const int b = unit >> 8, blk = (unit >> 2) & 63, kvh = unit & 3;
        const int R0 = b * SEQ + blk * 128;
        const int gq = wave >> 1, hq = 4 * kvh + gq;
        u32x4 qraw[4][2]; u32x2 zraw[4][4];
#pragma unroll
        for (int qt = 0; qt < 4; ++qt) {
            const int iq = 64 * (wave & 1) + 16 * qt + fr;
            const bf16_t* qrow = U + (size_t)(R0 + iq) * UW + C_Q + 64 * hq;
            qraw[qt][0] = *(const u32x4*)(qrow + 8 * grp); qraw[qt][1] = *(const u32x4*)(qrow + 32 + 8 * grp);
        }
#pragma unroll
        for (int qt = 0; qt < 4; ++qt) {
            const int iq = 64 * (wave & 1) + 16 * qt + fr;
            const bf16_t* zrow = U + (size_t)(R0 + iq) * UW + C_ZA + 64 * hq + 4 * grp;
#pragma unroll
            for (int dt = 0; dt < 4; ++dt) zraw[qt][dt] = *(const u32x2*)(zrow + 16 * dt);
        }
        {
            const int j = tid >> 1, hf = tid & 1;
            const bool zero = (blk == 0 && j < 128);
            f32x4 kf[8];
#pragma unroll
            for (int i = 0; i < 4; ++i) { const u32x4 w = kv.k[i]; kf[2 * i] = (f32x4){bflo(w.x), bfhi(w.x), bflo(w.y), bfhi(w.y)}; kf[2 * i + 1] = (f32x4){bflo(w.z), bfhi(w.z), bflo(w.w), bfhi(w.w)}; }
            float ss = 0.f;
#pragma unroll
            for (int i = 0; i < 8; ++i) ss += (kf[i].x * kf[i].x + kf[i].y * kf[i].y) + (kf[i].z * kf[i].z + kf[i].w * kf[i].w);
            ss += __shfl_xor(ss, 1);
            const float rstd = zero ? 0.f : 1.0f / sqrtf(ss * (1.f / 64.f) + EPS);
#pragma unroll
            for (int i = 0; i < 8; ++i) { const f32x4 w = *(const f32x4*)(a.k_norm_w + 32 * hf + 4 * i); kf[i] = kf[i] * rstd * w; }
#pragma unroll
            for (int i = 0; i < 4; ++i) { u32x4 w; w.x = pk2(kf[2 * i].x, kf[2 * i].y); w.y = pk2(kf[2 * i].z, kf[2 * i].w); w.z = pk2(kf[2 * i + 1].x, kf[2 * i + 1].y); w.w = pk2(kf[2 * i + 1].z, kf[2 * i + 1].w);
                *(LAS u32x4*)(Kn + j * 72 + 32 * hf + 8 * i) = w; }
            if (blk == 63 && j >= 128 && !dry) { float* o = a.out + O_KP + ((size_t)(b * 128 + (j - 128)) * 4 + kvh) * 64 + 32 * hf;
#pragma unroll
                for (int i = 0; i < 8; ++i) *(f32x4*)(o + 4 * i) = kf[i]; }
        }
        {
            const int j = tid & 255, dh = tid >> 8;
            const bool zero = (blk == 0 && j < 128);
            float* o = a.out + O_VP + ((size_t)(b * 128 + (j - 128)) * 4 + kvh) * 64 + 32 * dh;
            const bool wout = (blk == 63 && j >= 128 && !dry);
#pragma unroll
            for (int i = 0; i < 4; ++i) {
                u32x4 w = kv.v[i]; if (zero) w = (u32x4){0u, 0u, 0u, 0u};
                LAS bf16_t* d = Vt + (32 * dh + 8 * i) * 280 + j;
                d[0] = (bf16_t)(w.x & 0xffffu); d[280] = (bf16_t)(w.x >> 16); d[2 * 280] = (bf16_t)(w.y & 0xffffu); d[3 * 280] = (bf16_t)(w.y >> 16);
                d[4 * 280] = (bf16_t)(w.z & 0xffffu); d[5 * 280] = (bf16_t)(w.z >> 16); d[6 * 280] = (bf16_t)(w.w & 0xffffu); d[7 * 280] = (bf16_t)(w.w >> 16);
                if (wout) { *(f32x4*)(o + 8 * i) = (f32x4){bflo(w.x), bfhi(w.x), bflo(w.y), bfhi(w.y)}; *(f32x4*)(o + 8 * i + 4) = (f32x4){bflo(w.z), bfhi(w.z), bflo(w.w), bfhi(w.w)}; }
            }
        }
        const int nxt = unit + G;
        if (nxt < 512) attn_load_kv(U, nxt, tid, kv);
        __syncthreads();
        const float sink2 = a.sinks[hq] * LOG2E;
#pragma unroll
        for (int qt = 0; qt < 4; ++qt) {
            const int i0 = 64 * (wave & 1) + 16 * qt, iq = i0 + fr;
            bf16_t* qrow = U + (size_t)(R0 + iq) * UW + C_Q + 64 * hq;
            bf16x8 qf[2];
            {
                const u32x4 w0 = qraw[qt][0], w1 = qraw[qt][1];
                float qv[16] = {bflo(w0.x), bfhi(w0.x), bflo(w0.y), bfhi(w0.y), bflo(w0.z), bfhi(w0.z), bflo(w0.w), bfhi(w0.w),
                                bflo(w1.x), bfhi(w1.x), bflo(w1.y), bfhi(w1.y), bflo(w1.z), bfhi(w1.z), bflo(w1.w), bfhi(w1.w)};
                float ss = 0.f;
#pragma unroll
                for (int i = 0; i < 16; ++i) ss += qv[i] * qv[i];
                ss += __shfl_xor(ss, 16); ss += __shfl_xor(ss, 32);
                const float rs = qscale / sqrtf(ss * (1.f / 64.f) + EPS);
                const f32x4 n0 = *(const f32x4*)(a.q_norm_w + 8 * grp), n1 = *(const f32x4*)(a.q_norm_w + 8 * grp + 4), n2 = *(const f32x4*)(a.q_norm_w + 32 + 8 * grp), n3 = *(const f32x4*)(a.q_norm_w + 32 + 8 * grp + 4);
                u32x4 p0, p1;
                p0.x = pk2(qv[0] * rs * n0.x, qv[1] * rs * n0.y); p0.y = pk2(qv[2] * rs * n0.z, qv[3] * rs * n0.w); p0.z = pk2(qv[4] * rs * n1.x, qv[5] * rs * n1.y); p0.w = pk2(qv[6] * rs * n1.z, qv[7] * rs * n1.w);
                p1.x = pk2(qv[8] * rs * n2.x, qv[9] * rs * n2.y); p1.y = pk2(qv[10] * rs * n2.z, qv[11] * rs * n2.w); p1.z = pk2(qv[12] * rs * n3.x, qv[13] * rs * n3.y); p1.w = pk2(qv[14] * rs * n3.z, qv[15] * rs * n3.w);
                qf[0] = __builtin_bit_cast(bf16x8, p0); qf[1] = __builtin_bit_cast(bf16x8, p1);
            }
            f32x4 oacc[4];
#pragma unroll
            for (int dt = 0; dt < 4; ++dt) oacc[dt] = (f32x4){0.f, 0.f, 0.f, 0.f};
            float lsum = 0.f;
#pragma unroll 1
            for (int kk = 0; kk < 5; ++kk) {
                const int j0 = i0 + 32 * kk;
                f32x4 s0 = (f32x4){0.f, 0.f, 0.f, 0.f}, s1 = (f32x4){0.f, 0.f, 0.f, 0.f};
#pragma unroll
                for (int ks = 0; ks < 2; ++ks) {
                    const bf16x8 k0 = *(const LAS bf16x8*)(Kn + (j0 + fr) * 72 + 32 * ks + 8 * grp), k1 = *(const LAS bf16x8*)(Kn + (j0 + 16 + fr) * 72 + 32 * ks + 8 * grp);
                    s0 = mfma16(k0, qf[ks], s0); s1 = mfma16(k1, qf[ks], s1);
                }
                float p[8];
#pragma unroll
                for (int r = 0; r < 4; ++r) {
                    const int ja = j0 + 4 * grp + r, jb = ja + 16; const int da = iq - ja + 128, db = da - 16;
                    const bool va = (da >= 0) && (da <= 128) && (blk > 0 || ja >= 128), vb = (db >= 0) && (db <= 128) && (blk > 0 || jb >= 128);
                    const float ea = __builtin_amdgcn_exp2f(s0[r] + bias2[hq * 132 + (va ? da : 0)] - m2), eb = __builtin_amdgcn_exp2f(s1[r] + bias2[hq * 132 + (vb ? db : 0)] - m2);
                    p[r] = va ? ea : 0.f; p[4 + r] = vb ? eb : 0.f;
                }
#pragma unroll
                for (int r = 0; r < 8; ++r) lsum += p[r];
                u32x4 pw; pw.x = pk2(p[0], p[1]); pw.y = pk2(p[2], p[3]); pw.z = pk2(p[4], p[5]); pw.w = pk2(p[6], p[7]);
                const bf16x8 pf = __builtin_bit_cast(bf16x8, pw);
#pragma unroll
                for (int dt = 0; dt < 4; ++dt) {
                    const u32x2 lo = *(const LAS u32x2*)(Vt + (16 * dt + fr) * 280 + j0 + 4 * grp), hi = *(const LAS u32x2*)(Vt + (16 * dt + fr) * 280 + j0 + 16 + 4 * grp);
                    u32x4 aw; aw.x = lo.x; aw.y = lo.y; aw.z = hi.x; aw.w = hi.y;
                    oacc[dt] = mfma16(__builtin_bit_cast(bf16x8, aw), pf, oacc[dt]);
                }
            }
            lsum += __shfl_xor(lsum, 16); lsum += __shfl_xor(lsum, 32);
            const float rl = 1.0f / (lsum + __builtin_amdgcn_exp2f(sink2 - m2));
#pragma unroll
            for (int dt = 0; dt < 4; ++dt) {
                const u32x2 zz = zraw[qt][dt];
                u32x2 o; o.x = pk2(oacc[dt][0] * rl * silu_f(bflo(zz.x)), oacc[dt][1] * rl * silu_f(bfhi(zz.x))); o.y = pk2(oacc[dt][2] * rl * silu_f(bflo(zz.y)), oacc[dt][3] * rl * silu_f(bfhi(zz.y)));
                if (!dry || o.x == 0x12345678u) *(u32x2*)(qrow + 16 * dt + 4 * grp) = o;
            }
        }
        unit = nxt;
        __syncthreads();
    }
}
__device__ __forceinline__ float attn_shift(const Args& a, int lane) {
    float wq = fabsf(a.q_norm_w[lane]), wk = fabsf(a.k_norm_w[lane]);
    float rb = 0.f;
    for (int i = lane; i < 512; i += 64) rb = fmaxf(rb, fabsf(a.rel_table[i]));
    if (lane < 16) rb = fmaxf(rb, fabsf(a.sinks[lane]));
#pragma unroll
    for (int o = 1; o < 64; o <<= 1) { wq = fmaxf(wq, __shfl_xor(wq, o)); wk = fmaxf(wk, __shfl_xor(wk, o)); rb = fmaxf(rb, __shfl_xor(rb, o)); }
    return (8.0f * wq * wk + rb) * LOG2E;
}

__device__ __forceinline__ void samp_ssm_item(const Args& a, LAS unsigned char* lds, int item, int tid, int wave, int lane, const bool dry) {
    const int b = item >> 1, g = item & 1;
    const int Rs = MP + 4 * b;
    bf16_t* U = (bf16_t*)(a.ws + WS_U); const float* DT = (const float*)(a.ws + WS_DT);
    LAS float* xs = (LAS float*)lds;
    LAS float* Bs = xs + 2048;
    LAS float* Cs = Bs + 512;
    LAS float* gy = Cs + 512;
    LAS float* dts = gy + 2048;
    LAS float* avs = dts + 32;
    LAS float* rstd_s = avs + 32;
    __syncthreads();
    for (int cc = tid; cc < 768; cc += NT) {
        int ch; LAS float* dst;
        if (cc < 512) { ch = 512 * g + cc; dst = xs + cc; } else if (cc < 640) { ch = 1024 + 128 * g + (cc - 512); dst = Bs + (cc - 512); } else { ch = 1280 + 128 * g + (cc - 640); dst = Cs + (cc - 640); }
        const int stride = (cc < 512) ? 512 : 128;
        const float w0 = a.conv_w[ch], w1 = a.conv_w[CONVD + ch], w2 = a.conv_w[2 * CONVD + ch], w3 = a.conv_w[3 * CONVD + ch], cb = a.conv_b[ch];
        const float* sc = a.state_conv + (size_t)b * 3 * CONVD + ch;
        float f[7]; f[0] = sc[0]; f[1] = sc[CONVD]; f[2] = sc[2 * CONVD];
#pragma unroll
        for (int t = 0; t < 4; ++t) f[3 + t] = bf2f(U[(size_t)(Rs + t) * UW + C_X + ch]);
#pragma unroll
        for (int t = 0; t < 4; ++t) dst[t * stride] = silu_f(cb + w0 * f[t] + w1 * f[t + 1] + w2 * f[t + 2] + w3 * f[t + 3]);
    }
    if (tid < 32) { const int e = tid >> 2, t = tid & 3, h = 8 * g + e; const float d = softplus_f(DT[(size_t)(Rs + t) * 16 + h] + a.dt_bias[h]); dts[tid] = d; avs[tid] = d * (-expf(a.a_log[h])); }
    __syncthreads();
    const int p = tid >> 3, nq = tid & 7;
    f32x4 Sn[4];
    { const float* sp0 = a.state_ssm + ((size_t)(b * 16 + 8 * g) * 64 + p) * 128 + 4 * nq;
#pragma unroll
      for (int i = 0; i < 4; ++i) Sn[i] = *(const f32x4*)(sp0 + 32 * i); }
#pragma unroll 1
    for (int e = 0; e < 8; ++e) {
        const int h = 8 * g + e;
        f32x4 S[4];
#pragma unroll
        for (int i = 0; i < 4; ++i) S[i] = Sn[i];
        if (e < 7) { const float* sp = a.state_ssm + ((size_t)(b * 16 + h + 1) * 64 + p) * 128 + 4 * nq;
#pragma unroll
            for (int i = 0; i < 4; ++i) Sn[i] = *(const f32x4*)(sp + 32 * i); }
        float yv[4];
#pragma unroll
        for (int t = 0; t < 4; ++t) {
            const float dA = __expf(avs[e * 4 + t]); const float coef = dts[e * 4 + t] * xs[t * 512 + 64 * e + p];
            float acc = 0.f;
#pragma unroll
            for (int i = 0; i < 4; ++i) { const f32x4 Bv = *(const LAS f32x4*)(Bs + t * 128 + 4 * nq + 32 * i), Cv = *(const LAS f32x4*)(Cs + t * 128 + 4 * nq + 32 * i);
                S[i] = S[i] * dA + coef * Bv; acc += (Cv.x * S[i].x + Cv.y * S[i].y) + (Cv.z * S[i].z + Cv.w * S[i].w); }
            acc += __shfl_xor(acc, 1); acc += __shfl_xor(acc, 2); acc += __shfl_xor(acc, 4);
            yv[t] = acc;
        }
        float* op = a.out + O_SS + ((size_t)(b * 16 + h) * 64 + p) * 128 + 4 * nq;
#pragma unroll
        for (int i = 0; i < 4; ++i) if (!dry || S[i].x == 12345.678f) *(f32x4*)(op + 32 * i) = S[i];
        if (nq < 4) { const int t = nq; const float xv = xs[t * 512 + 64 * e + p];
            const float yt = (nq == 0) ? yv[0] : (nq == 1) ? yv[1] : (nq == 2) ? yv[2] : yv[3];
            const float y = yt + a.d_skip[h] * xv; const float z = bf2f(U[(size_t)(Rs + t) * UW + C_Z + 64 * h + p]);
            gy[t * 512 + 64 * e + p] = y * silu_f(z); }
    }
    __syncthreads();
    if (wave < 4) { float s = 0.f;
#pragma unroll
        for (int i = 0; i < 8; ++i) { const float v = gy[wave * 512 + lane + 64 * i]; s += v * v; }
        s = wave_sum(s); if (lane == 0) rstd_s[wave] = 1.0f / sqrtf(s * (1.f / 512.f) + EPS); }
    __syncthreads();
    for (int i = tid; i < 2048; i += NT) { const int t = i >> 9, ch = i & 511;
        const unsigned ov = f2bf(gy[i] * rstd_s[t] * a.ssm_norm_w[512 * g + ch]); if (!dry || ov == 0x12345u) U[(size_t)(Rs + t) * UW + C_Z + 512 * g + ch] = (bf16_t)ov; }
}

__device__ __forceinline__ void samp_attn_item(const Args& a, LAS unsigned char* lds, int item, int tid, int wave, int lane, const bool dry) {
    const int b = item >> 2, kvh = item & 3;
    const int Rs = MP + 4 * b;
    bf16_t* U = (bf16_t*)(a.ws + WS_U);
    LAS float* Ks = (LAS float*)lds;
    LAS float* Vs = Ks + 132 * 65;
    LAS float* qs = Vs + 132 * 64;
    LAS float* sc = qs + 1024;
    __syncthreads();
    {
        const int w = tid >> 2, qd = tid & 3;
        const float* kp = a.cache_k + ((size_t)(b * 128 + w) * 4 + kvh) * 64 + 16 * qd; const float* vp = a.cache_v + ((size_t)(b * 128 + w) * 4 + kvh) * 64 + 16 * qd;
        f32x4 kv[4], vv[4];
#pragma unroll
        for (int i = 0; i < 4; ++i) { kv[i] = *(const f32x4*)(kp + 4 * i); vv[i] = *(const f32x4*)(vp + 4 * i); }
#pragma unroll
        for (int i = 0; i < 4; ++i) { LAS float* kd = Ks + w * 65 + 16 * qd + 4 * i; kd[0] = kv[i].x; kd[1] = kv[i].y; kd[2] = kv[i].z; kd[3] = kv[i].w; *(LAS f32x4*)(Vs + w * 64 + 16 * qd + 4 * i) = vv[i]; }
        if (w >= 4 && !dry) { float* ko = a.out + O_KS + ((size_t)(b * 128 + (w - 4)) * 4 + kvh) * 64 + 16 * qd; float* vo = a.out + O_VS + ((size_t)(b * 128 + (w - 4)) * 4 + kvh) * 64 + 16 * qd;
#pragma unroll
            for (int i = 0; i < 4; ++i) { *(f32x4*)(ko + 4 * i) = kv[i]; *(f32x4*)(vo + 4 * i) = vv[i]; } }
    }
    if (wave < 4) {
        const int t = wave;
        const float kx = bf2f(U[(size_t)(Rs + t) * UW + C_K + 64 * kvh + lane]); const float vx = bf2f(U[(size_t)(Rs + t) * UW + C_V + 64 * kvh + lane]);
        const float ss = wave_sum(kx * kx); const float kn = kx / sqrtf(ss * (1.f / 64.f) + EPS) * a.k_norm_w[lane];
        Ks[(128 + t) * 65 + lane] = kn; Vs[(128 + t) * 64 + lane] = vx;
        if (!dry) { a.out[O_KS + ((size_t)(b * 128 + 124 + t) * 4 + kvh) * 64 + lane] = kn; a.out[O_VS + ((size_t)(b * 128 + 124 + t) * 4 + kvh) * 64 + lane] = vx; }
    }
#pragma unroll
    for (int i = 0; i < 2; ++i) {
        const int qi = 2 * wave + i, gq = qi >> 2, t = qi & 3, hq = 4 * kvh + gq;
        const float qx = bf2f(U[(size_t)(Rs + t) * UW + C_Q + 64 * hq + lane]);
        const float ss = wave_sum(qx * qx);
        qs[qi * 64 + lane] = qx / sqrtf(ss * (1.f / 64.f) + EPS) * a.q_norm_w[lane] * 0.125f;
    }
    __syncthreads();
    for (int idx = tid; idx < 16 * 132; idx += NT) {
        const int qi = idx / 132, j = idx % 132, t = qi & 3, hq = 4 * kvh + (qi >> 2);
        float s = 0.f;
#pragma unroll 8
        for (int d = 0; d < 64; ++d) s += qs[qi * 64 + d] * Ks[j * 65 + d];
        const int dist = t + 128 - j; const bool valid = (dist >= 0) && (dist <= 128);
        sc[qi * 136 + j] = valid ? s + a.rel_table[rel_bucket(valid ? dist : 0) * 16 + hq] : -INFINITY;
    }
    __syncthreads();
#pragma unroll
    for (int i = 0; i < 2; ++i) {
        const int qi = 2 * wave + i, hq = 4 * kvh + (qi >> 2);
        const float sk = a.sinks[hq];
        const float v0 = sc[qi * 136 + lane], v1 = sc[qi * 136 + 64 + lane], v2 = (lane < 4) ? sc[qi * 136 + 128 + lane] : -INFINITY;
        float m = fmaxf(fmaxf(v0, v1), fmaxf(v2, sk));
#pragma unroll
        for (int o = 1; o < 64; o <<= 1) m = fmaxf(m, __shfl_xor(m, o));
        const float e0 = __expf(v0 - m), e1 = __expf(v1 - m), e2 = (lane < 4) ? __expf(v2 - m) : 0.f;
        const float den = wave_sum(e0 + e1 + e2) + __expf(sk - m); const float rd = 1.0f / den;
        sc[qi * 136 + lane] = e0 * rd; sc[qi * 136 + 64 + lane] = e1 * rd; if (lane < 4) sc[qi * 136 + 128 + lane] = e2 * rd;
    }
    __syncthreads();
#pragma unroll
    for (int i = 0; i < 2; ++i) {
        const int d = tid & 63, qi = (tid >> 6) + 8 * i, t = qi & 3, hq = 4 * kvh + (qi >> 2);
        float o = 0.f;
#pragma unroll 4
        for (int j = 0; j < 132; ++j) o += sc[qi * 136 + j] * Vs[j * 64 + d];
        const float z = bf2f(U[(size_t)(Rs + t) * UW + C_ZA + 64 * hq + d]);
        const unsigned ov = f2bf(o * silu_f(z)); if (!dry || ov == 0x12345u) U[(size_t)(Rs + t) * UW + C_Q + 64 * hq + d] = (bf16_t)ov;
    }
}

__device__ __forceinline__ void conv_out_item(const Args& a, int item, int tid) {
    const bf16_t* U = (const bf16_t*)(a.ws + WS_U);
    for (int i = tid; i < 3 * CONVD; i += NT) {
        const int r = i / CONVD, ch = i % CONVD;
        if (item < NB) a.out[O_CP + (size_t)item * 3 * CONVD + i] = bf2f(U[(size_t)(item * SEQ + SEQ - 3 + r) * UW + C_X + ch]);
        else { const int b = item - NB; a.out[O_CS + (size_t)b * 3 * CONVD + i] = bf2f(U[(size_t)(MP + 4 * b + 1 + r) * UW + C_X + ch]); }
    }
}

__device__ __forceinline__ void samp_outproj_tile(const Args& a, LAS unsigned char* lds, int it, int wave, int lane) {
    const bf16_t* U = (const bf16_t*)(a.ws + WS_U); const bf16_t* Wt = (const bf16_t*)(a.ws + WS_WOUT);
    const int r0 = 16 * (it >> 3), c0 = 128 * (it & 7);
    const int fr = lane & 15, grp = lane >> 4, kh = wave >> 2, cw = c0 + 32 * (wave & 3);
    const bf16_t* tp = U + (size_t)(MP + r0 + fr) * UW + (kh ? C_Q : C_Z) + 8 * grp;
    const bf16_t* w0 = Wt + (size_t)(cw + fr) * 2048 + 1024 * kh + 8 * grp; const bf16_t* w1 = w0 + (size_t)16 * 2048;
    f32x4 acc0 = (f32x4){0.f, 0.f, 0.f, 0.f}, acc1 = (f32x4){0.f, 0.f, 0.f, 0.f};
#pragma unroll 8
    for (int ks = 0; ks < 32; ++ks) {
        const bf16x8 tf = *(const bf16x8*)(tp + 32 * ks), a0 = *(const bf16x8*)(w0 + 32 * ks), a1 = *(const bf16x8*)(w1 + 32 * ks);
        acc0 = mfma16(a0, tf, acc0); acc1 = mfma16(a1, tf, acc1);
    }
    LAS f32x4* red = (LAS f32x4*)lds;
    __syncthreads();
    if (kh) { red[((wave & 3) * 2 + 0) * 64 + lane] = acc0; red[((wave & 3) * 2 + 1) * 64 + lane] = acc1; }
    __syncthreads();
    if (!kh) {
        acc0 += red[(wave * 2 + 0) * 64 + lane]; acc1 += red[(wave * 2 + 1) * 64 + lane];
        const size_t o = (size_t)(r0 + fr) * DM + cw + 4 * grp;
        *(f32x4*)(a.out + O_YS + o) = *(const f32x4*)(a.x_sample + o) + acc0;
        *(f32x4*)(a.out + O_YS + o + 16) = *(const f32x4*)(a.x_sample + o + 16) + acc1;
    }
}

__global__ void __launch_bounds__(NT, 2) mk_fwd(Args args) {
    extern __shared__ __attribute__((aligned(16))) unsigned char lds_raw[];
    LAS unsigned char* lds = (LAS unsigned char*)lds_raw;
    volatile LAS unsigned* MISC = (volatile LAS unsigned*)(lds + MISC_OFF);
    const int tid = threadIdx.x, lane = tid & 63, wave = __builtin_amdgcn_readfirstlane(tid >> 6);
    const int G = gridDim.x; const int bx = blockIdx.x; const int vcu = (G % 8 == 0) ? (bx % 8) * (G / 8) + bx / 8 : bx;
    gu32* ctl = (gu32*)(args.ws + WS_CTL);
    for (int u = tid; u < (LDS_BYTES - RING_BYTES) / 4; u += NT) ((LAS unsigned*)(lds + RING_BYTES))[u] = 0u;
    __syncthreads();
    XcdBarrier bar; bar.bar = (unsigned*)(ctl + CW_BAR); bar.x = 0; bar.st = nullptr;
    if (MK_N_LAUNCHES == 1) bar = xcd_barrier_post((unsigned*)(ctl + CW_BAR), MISC + 8);
    const int lo = args.ph_lo, hi = args.ph_hi;
#define IN(k) (lo <= (k) && (k) < hi)
#define GRID_BAR() do { if (MK_N_LAUNCHES == 1) xcd_barrier(bar); } while (0)

    const bool dry = (args.dry != 0);
    if (IN(0)) { p0_prologue(args, lds, vcu, G, wave, lane); GRID_BAR(); }

    if (IN(1)) {
        pg8::Gemm g{(const bf16_t*)(args.ws + WS_H), (const bf16_t*)(args.ws + WS_WIN), MT, NINP, DM, DM, 1 << 20, 0};
        pg8::StaticOrder S; S.init(MT, NINP, G, bx);
        pg8::EpiU E{(bf16_t*)(args.ws + WS_U), (float*)(args.ws + WS_DT)};
        pg8::gemm_phase<pg8::EpiU, pg8::StaticOrder, true>(lds, g, S, E);
        GRID_BAR();
    }

    if (IN(2)) {
        const float m2 = attn_shift(args, lane);
        const int sub = args.sub;
        if (sub & 1) for (int it = bx; it < 256; it += G) ssd_state_item(args, lds, it, tid, wave, lane);
        if (sub & 2) attn_phase(args, lds, bx, G, tid, wave, lane, m2, dry);
        if (sub & 4) for (int it = bx; it < 256; it += G) samp_ssm_item(args, lds, it, tid, wave, lane, dry);
        if (sub & 8) for (int it = bx; it < 512; it += G) samp_attn_item(args, lds, it, tid, wave, lane, dry);
        if (sub & 16) for (int it = bx; it < NB + DB; it += G) conv_out_item(args, it, tid);
        GRID_BAR();
    }

    if (IN(3)) { ssd_scan(args, bx * NT + tid, G * NT, dry); GRID_BAR(); }

    if (IN(4)) {
        for (int it = bx; it < 256; it += G) ssd_out_item(args, lds, it, tid, wave, lane, dry);
        GRID_BAR();
    }

    if (IN(5)) {
        pg8::Gemm g{(const bf16_t*)(args.ws + WS_U), (const bf16_t*)(args.ws + WS_WOUT), MP, DM, 2048, UW, 16, (size_t)(C_Q - 1024) * 2};
        for (int it = bx; it < 256; it += G) samp_outproj_tile(args, lds, it, wave, lane);
        __syncthreads();
        pg8::StaticOrder S; S.init(MP, DM, G, bx);
        pg8::EpiOut E{args.x_prompt, args.x_sample, args.out};
        pg8::gemm_phase<pg8::EpiOut, pg8::StaticOrder, true>(lds, g, S, E);
    }
#undef IN
#undef GRID_BAR
}

extern "C" void kernel_launch(void* const* d_in, const int* in_sizes, int n_in, void* d_out, int out_size, void* d_ws, size_t ws_size, hipStream_t stream) {
    static int grid = 0;
    if (grid == 0) {
        if (n_in != 19 || (size_t)out_size != O_END || ws_size < WS_END) { fprintf(stderr, "kernel_launch: unexpected shapes (n_in %d, out %d, ws %zu)\n", n_in, out_size, ws_size); grid = -1; return; }
        int dev = 0, cus = 0;
        if (hipGetDevice(&dev) != hipSuccess || hipDeviceGetAttribute(&cus, hipDeviceAttributeMultiprocessorCount, dev) != hipSuccess) { grid = -1; return; }
        if (hipFuncSetAttribute((const void*)mk_fwd, hipFuncAttributeMaxDynamicSharedMemorySize, LDS_BYTES) != hipSuccess) { fprintf(stderr, "kernel_launch: hipFuncSetAttribute failed\n"); grid = -1; return; }
        int per_cu = 0;
        if (hipOccupancyMaxActiveBlocksPerMultiprocessor(&per_cu, (const void*)mk_fwd, NT, LDS_BYTES) != hipSuccess || per_cu < 1) fprintf(stderr, "kernel_launch: occupancy query reports %d blocks per CU\n", per_cu);
        (void)hipGetLastError();
        grid = cus;
    }
    if (grid < 0) return;
    (void)hipMemsetAsync((char*)d_ws + WS_CTL, 0, CTL_ZERO_BYTES, stream);
    Args a{};
    const float** ap = (const float**)&a;
    for (int i = 0; i < 19; ++i) ap[i] = (const float*)d_in[i];
    a.out = (float*)d_out; a.ws = (unsigned char*)d_ws;
    a.sub = 31; a.dry = 0;
    if (MK_N_LAUNCHES == 1) { a.ph_lo = 0; a.ph_hi = 6; hipLaunchKernelGGL(mk_fwd, dim3(grid), dim3(NT), LDS_BYTES, stream, a); }
    else for (int ph = 0; ph < 6; ++ph) {
        a.ph_lo = ph; a.ph_hi = ph + 1; a.sub = 31; a.dry = 0;
        hipLaunchKernelGGL(mk_fwd, dim3(grid), dim3(NT), LDS_BYTES, stream, a);
        if (MK_DUP == ph) { a.dry = 1; hipLaunchKernelGGL(mk_fwd, dim3(grid), dim3(NT), LDS_BYTES, stream, a); }
        if (ph == 2 && MK_DUP >= 20 && MK_DUP < 24) { a.sub = 1 << (MK_DUP - 20); a.dry = 1; hipLaunchKernelGGL(mk_fwd, dim3(grid), dim3(NT), LDS_BYTES, stream, a); }
    }
}
```

```cpp
#include <hip/hip_runtime.h>
#include <cstdio>
#include <cstdint>

#ifndef MK_N_LAUNCHES
#define MK_N_LAUNCHES 1
#endif

#ifndef MK_AMP
#define MK_AMP (-1)
#endif
#ifndef MK_ABL
#define MK_ABL 0
#endif
#ifndef MK_DUP
#define MK_DUP (-1)
#endif
#define LAS __attribute__((address_space(3)))
#define GAS __attribute__((address_space(1)))
typedef unsigned short bf16_t;
typedef short bf16x8 __attribute__((ext_vector_type(8)));
typedef short bf16x4 __attribute__((ext_vector_type(4)));
typedef float f32x4 __attribute__((ext_vector_type(4)));
typedef float f32x2 __attribute__((ext_vector_type(2)));
typedef unsigned u32x4 __attribute__((ext_vector_type(4)));
typedef unsigned u32x2 __attribute__((ext_vector_type(2)));

constexpr int DM = 1024, SEQ = 8192, NB = 2, MP = NB * SEQ;
constexpr int DB = 128, DL = 4, MS = DB * DL, MT = MP + MS;
constexpr int NIN = 5136, NINP = 5376;
constexpr int UW = 5120;
constexpr int C_Z = 0, C_X = 1024, C_B = 2048, C_C = 2304, C_Q = 2560, C_K = 3584, C_V = 3840, C_ZA = 4096;
constexpr int CONVD = 1536;
constexpr float EPS = 1e-6f;
constexpr float LOG2E = 1.4426950408889634f;

constexpr size_t MiB = 1u << 20;
constexpr size_t WS_CTL = 0, CTL_ZERO_BYTES = 32768;
constexpr size_t WS_WIN = 1 * MiB;
constexpr size_t WS_WOUT = 12 * MiB;
constexpr size_t WS_DT = 16 * MiB;
constexpr size_t WS_DEC = 17 * MiB + 512 * 1024;
constexpr size_t WS_U = 18 * MiB;
constexpr size_t WS_H = 183 * MiB;
constexpr size_t WS_ST = 183 * MiB;
constexpr size_t WS_HALO = 247 * MiB;
constexpr size_t WS_DTA = 249 * MiB;
constexpr size_t WS_END = 251 * MiB;
constexpr int CW_BAR = 4096;

constexpr size_t O_YP = 0, O_YS = 16777216, O_KP = 17301504, O_VP = 17367040, O_SP = 17432576, O_CP = 17694720,
                 O_KS = 17703936, O_VS = 21898240, O_SS = 26092544, O_CS = 42869760, O_END = 43459584;

typedef __bf16 hwbf16x2 __attribute__((ext_vector_type(2)));
__device__ __forceinline__ unsigned pk2(float lo, float hi) { const f32x2 v = {lo, hi}; return __builtin_bit_cast(unsigned, __builtin_convertvector(v, hwbf16x2)); }
__device__ __forceinline__ unsigned f2bf(float f) { return pk2(f, 0.f) & 0xffffu; }
__device__ __forceinline__ float bf2f(unsigned v) { return __builtin_bit_cast(float, v << 16); }
__device__ __forceinline__ float bflo(unsigned w) { return __builtin_bit_cast(float, w << 16); }
__device__ __forceinline__ float bfhi(unsigned w) { return __builtin_bit_cast(float, w & 0xffff0000u); }
__device__ __forceinline__ float silu_f(float x) { return x * __builtin_amdgcn_rcpf(1.0f + __expf(-x)); }
__device__ __forceinline__ float softplus_f(float x) { return fmaxf(x, 0.f) + log1pf(__expf(-fabsf(x))); }
__device__ __forceinline__ float wave_sum(float v) {
#pragma unroll
    for (int o = 1; o < 64; o <<= 1) v += __shfl_xor(v, o);
    return v;
}
__device__ __forceinline__ f32x4 mfma16(bf16x8 a, bf16x8 b, f32x4 c) { return __builtin_amdgcn_mfma_f32_16x16x32_bf16(a, b, c, 0, 0, 0); }
#define LDS_WAIT() asm volatile("s_waitcnt lgkmcnt(0)" ::: "memory")
#define VM_WAIT() asm volatile("s_waitcnt vmcnt(0)" ::: "memory")

namespace pg8 {
constexpr int BM = 256, BK = 64, HALF = 128, HTB = HALF * BK * 2, STAGE_BYTES = 8 * HTB, NXCD = 8, WGM = 8;
__host__ __device__ __forceinline__ int lds_byte(int r, int c) { const int st = (r >> 4) * 2 + (c >> 5), rr = r & 15, cc = c & 31, ob = rr * 64 + cc * 2; return st * 1024 + (ob ^ (((ob >> 9) & 1) << 5)); }
__host__ __device__ __forceinline__ void stage_rc(int b, int& R, int& C) { const int st = b / 1024, sb = b % 1024, swz = sb ^ (((sb >> 9) & 1) << 5); R = (st >> 1) * 16 + swz / 64; C = (st & 1) * 32 + (swz % 64) / 2; }
__host__ __device__ __forceinline__ int perm32(int rho) { const int n = rho >> 4, i = rho & 15; return 8 * (i >> 2) + 4 * n + (i & 3); }

struct Unit { int pm, pn, half; };
struct Gemm { const bf16_t* A; const bf16_t* Bt; int M, N, K, lda, kseg; size_t segskip; };

struct StaticOrder {
    int nM, nN, nwg, G, c;
    __host__ __device__ void init(int M, int N, int G_, int c_) { nM = M / BM; nN = N / BM; nwg = nM * nN; G = G_; c = c_; }
    __host__ __device__ bool next(int i, Unit& u) const {
        long L = (long)i * G + c; u.half = 0;
        const int nfull = (nwg / G) * G, rem = nwg - nfull;
        if (L >= nfull && 2 * rem <= G && rem > 0) { const long L2 = L - nfull; if (L2 >= 2 * rem) return false; u.half = 1 + (int)(L2 & 1); L = nfull + (L2 >> 1); }
        if (L >= nwg) return false;
        int wgid = (int)L; { const int q = nwg / NXCD, r = nwg % NXCD, xcd = wgid % NXCD, off = wgid / NXCD; wgid = (xcd < r ? xcd * (q + 1) : r * (q + 1) + (xcd - r) * q) + off; }
        const int nig = WGM * nN, gid = wgid / nig, fm = gid * WGM, gsz = (nM - fm) < WGM ? (nM - fm) : WGM;
        u.pm = fm + ((wgid % nig) % gsz); u.pn = (wgid % nig) / gsz; return true;
    }
};

__device__ __forceinline__ unsigned cvt_pk_bf16(float lo, float hi) { unsigned r; asm volatile("v_cvt_pk_bf16_f32 %0, %1, %2" : "=v"(r) : "v"(lo), "v"(hi)); return r; }

struct EpiU {
    static constexpr bool PERM = true;
    bf16_t* U; float* DT; bf16_t* HALO;
    __device__ __forceinline__ void operator()(const f32x4 (&acc)[2][2][4][2], const Unit& u, int wr, int wc, int fr, int fq) const {
        const int row0 = u.pm * BM + wr * 64 + fr;
        const int cshift = (u.half == 2) ? HALF : 0, nbj = u.half ? 1 : 2;
        if (u.pn < 20) {
            const bool halo = (u.pn >= 4) && (u.pn < 10) && (u.pm < MP / BM) && (wr == 1) && (fr >= 13);
            const int col0 = u.pn * BM + wc * 32 + 8 * fq + cshift;
#pragma unroll
            for (int ai = 0; ai < 2; ++ai)
#pragma unroll
                for (int m = 0; m < 4; ++m) { bf16_t* rowp = U + (size_t)(row0 + ai * HALF + m * 16) * UW + col0;
#pragma unroll
                    for (int bj = 0; bj < 2; ++bj) if (bj < nbj) { const f32x4 v0 = acc[ai][bj][m][0], v1 = acc[ai][bj][m][1];
                        u32x4 w; w.x = cvt_pk_bf16(v0[0], v0[1]); w.y = cvt_pk_bf16(v0[2], v0[3]); w.z = cvt_pk_bf16(v1[0], v1[1]); w.w = cvt_pk_bf16(v1[2], v1[3]);
                        *(u32x4*)(rowp + bj * HALF) = w;
                        if (m == 3 && halo) *(u32x4*)(HALO + (size_t)((u.pm * 2 + ai) * 3 + (fr - 13)) * CONVD + (col0 - C_X) + bj * HALF) = w; } }
        } else if (wc == 0 && fq < 2 && u.half != 2) {
#pragma unroll
            for (int ai = 0; ai < 2; ++ai)
#pragma unroll
                for (int m = 0; m < 4; ++m) { float* rowp = DT + (size_t)(row0 + ai * HALF + m * 16) * 16 + 8 * fq;
                    *(f32x4*)(rowp) = acc[ai][0][m][0]; *(f32x4*)(rowp + 4) = acc[ai][0][m][1]; }
        }
    }
};
struct EpiOut {
    static constexpr bool PERM = false;
    const float* xp; const float* xs; float* out;
    __device__ __forceinline__ void operator()(const f32x4 (&acc)[2][2][4][2], const Unit& u, int wr, int wc, int fr, int fq) const {
        const int col0 = u.pn * BM + wc * 32 + 4 * fq + ((u.half == 2) ? HALF : 0); const int nbj = u.half ? 1 : 2;
#pragma unroll
        for (int ai = 0; ai < 2; ++ai)
#pragma unroll
            for (int m = 0; m < 4; ++m) { const int row = u.pm * BM + ai * HALF + wr * 64 + m * 16 + fr;
                const float* xb = (row < MP) ? xp + (size_t)row * DM : xs + (size_t)(row - MP) * DM; float* ob = out + (size_t)row * DM;
#pragma unroll
                for (int bj = 0; bj < 2; ++bj)
#pragma unroll
                    for (int n = 0; n < 2; ++n) if (bj < nbj) { const int c = col0 + bj * HALF + n * 16; const f32x4 xv = __builtin_nontemporal_load((const f32x4*)(xb + c)); __builtin_nontemporal_store(xv + acc[ai][bj][m][n], (f32x4*)(ob + c)); } }
    }
};

template <class Epi, class Sched, bool ALIGN_EPI>
__device__ __forceinline__ void gemm_phase(LAS unsigned char* lds, const Gemm g, const Sched& S, const Epi& E) {
    const int tid = threadIdx.x, wid = __builtin_amdgcn_readfirstlane(tid >> 6), lane = tid & 63, wr = wid >> 2, wc = wid & 3, fr = lane & 15, fq = lane >> 4;
    const int K = g.K, nt = K / BK, lda = g.lda, kseg = g.kseg;
    unsigned voffA[2], voffB[2];
#pragma unroll
    for (int i = 0; i < 2; ++i) { int R, C; stage_rc(tid * 16 + i * 8192, R, C); const int Rb = Epi::PERM ? ((R & ~31) + perm32(R & 31)) : R;
        voffA[i] = (unsigned)(R * lda + C) * 2u; voffB[i] = (unsigned)(Rb * K + C) * 2u; }
    const size_t kstep = (size_t)(BK * 2);
    const size_t hstepA = (size_t)HALF * lda * 2, tstepA = 2 * hstepA;
    const size_t hstepB = (size_t)HALF * K * 2, tstepB = 2 * hstepB;
    const size_t segskip = g.segskip;
#define KOFFA(t) ((size_t)(t) * kstep + (((t) >= kseg) ? segskip : (size_t)0))
    const unsigned ldsw = (unsigned)wid * 1024u;
    const int aoff = lds_byte(wr * 64 + fr, fq * 8), boff = lds_byte(wc * 32 + fr, fq * 8);
#define PG8_SA(b, h) (((b) * 2 + (h)) * HTB)
#define PG8_SB(b, h) ((4 + (b) * 2 + (h)) * HTB)
#define PG8_STAGE(bufoff, gbase, voff) do { _Pragma("unroll") for (int _i = 0; _i < 2; ++_i) \
        __builtin_amdgcn_global_load_lds((const unsigned*)((const char*)(gbase) + (voff)[_i]), (LAS unsigned*)(lds + (bufoff) + ldsw + _i * 8192), 16, 0, 0); } while (0)
#define PG8_LDA(dst, b, h) do { _Pragma("unroll") for (int m = 0; m < 4; ++m) _Pragma("unroll") for (int k = 0; k < 2; ++k) dst[m][k] = *(const LAS bf16x8*)(lds + PG8_SA(b, h) + aoff + m * 2048 + k * 1024); } while (0)
#define PG8_LDB(dst, b, h) do { _Pragma("unroll") for (int n = 0; n < 2; ++n) _Pragma("unroll") for (int k = 0; k < 2; ++k) dst[n][k] = *(const LAS bf16x8*)(lds + PG8_SB(b, h) + boff + n * 2048 + k * 1024); } while (0)
#define PG8_MMA(ai, bj, At, Bt) do { __builtin_amdgcn_s_setprio(1); _Pragma("unroll") for (int m = 0; m < 4; ++m) _Pragma("unroll") for (int n = 0; n < 2; ++n) _Pragma("unroll") for (int k = 0; k < 2; ++k) \
        acc[ai][bj][m][n] = __builtin_amdgcn_mfma_f32_16x16x32_bf16(Bt[n][k], At[m][k], acc[ai][bj][m][n], 0, 0, 0); __builtin_amdgcn_s_setprio(0); } while (0)
#define PG8_WAIT_V(n) asm volatile("s_waitcnt vmcnt(" #n ")" ::: "memory")
#define PG8_WAIT_L(n) asm volatile("s_waitcnt lgkmcnt(" #n ")" ::: "memory")
#define PG8_BAR __builtin_amdgcn_s_barrier()
#define PG8_SCHED __builtin_amdgcn_sched_barrier(0)
    Unit cur, nxt; int ui = 0;
    if (!S.next(0, cur)) return;
    f32x4 acc[2][2][4][2];
#pragma unroll
    for (int a = 0; a < 2; ++a)
#pragma unroll
        for (int b = 0; b < 2; ++b)
#pragma unroll
            for (int m = 0; m < 4; ++m)
#pragma unroll
                for (int n = 0; n < 2; ++n) acc[a][b][m][n] = (f32x4){0.f, 0.f, 0.f, 0.f};
    bf16x8 At[4][2], B0[2][2], B1[2][2];
    const char* cA = (const char*)g.A + (size_t)cur.pm * tstepA; const char* cB = (const char*)g.Bt + (size_t)cur.pn * tstepB + ((cur.half == 2) ? hstepB : (size_t)0);
    PG8_STAGE(PG8_SB(0, 0), cB, voffB); PG8_STAGE(PG8_SB(0, 1), cB + hstepB, voffB); PG8_STAGE(PG8_SA(0, 0), cA, voffA); PG8_STAGE(PG8_SA(0, 1), cA + hstepA, voffA);
    if (wr == 1) PG8_BAR;
    PG8_WAIT_V(2); PG8_BAR;
    PG8_STAGE(PG8_SB(1, 0), cB + kstep, voffB); PG8_STAGE(PG8_SA(1, 0), cA + KOFFA(1), voffA); PG8_STAGE(PG8_SB(1, 1), cB + hstepB + kstep, voffB);
    PG8_WAIT_V(6); PG8_BAR;
    for (;;) {
        const bool has_next = S.next(ui + 1, nxt);
        const char* nA = has_next ? (const char*)g.A + (size_t)nxt.pm * tstepA : cA; const char* nB = has_next ? (const char*)g.Bt + (size_t)nxt.pn * tstepB + ((nxt.half == 2) ? hstepB : (size_t)0) : cB;
        const bool full = (cur.half == 0);
        for (int t = 0; t < nt; t += 2) {
            const bool last = (t == nt - 2);
            const char* a1 = cA + KOFFA(t + 1);
            const char* a2 = last ? nA : cA + KOFFA(t + 2); const char* b2 = last ? nB : cB + (size_t)(t + 2) * kstep;
            const char* a3 = last ? nA + KOFFA(1) : cA + KOFFA(t + 3); const char* b3 = b2 + kstep;
            PG8_LDB(B0, 0, 0); if (full) PG8_LDB(B1, 0, 1); PG8_SCHED; PG8_LDA(At, 0, 0); PG8_STAGE(PG8_SA(1, 1), a1 + hstepA, voffA);
            PG8_WAIT_V(8); PG8_WAIT_L(0); PG8_BAR; PG8_MMA(0, 0, At, B0); if (full) PG8_MMA(0, 1, At, B1); PG8_BAR; PG8_SCHED;
            PG8_LDA(At, 0, 1); PG8_STAGE(PG8_SB(0, 0), b2, voffB); PG8_STAGE(PG8_SB(0, 1), b2 + hstepB, voffB); PG8_STAGE(PG8_SA(0, 0), a2, voffA);
            PG8_WAIT_V(8); PG8_WAIT_L(0); PG8_BAR; PG8_MMA(1, 0, At, B0); if (full) PG8_MMA(1, 1, At, B1); PG8_BAR; PG8_SCHED;
            PG8_LDB(B0, 1, 0); if (full) PG8_LDB(B1, 1, 1); PG8_SCHED; PG8_LDA(At, 1, 0); PG8_STAGE(PG8_SA(0, 1), a2 + hstepA, voffA);
            PG8_WAIT_V(8); PG8_WAIT_L(0); PG8_BAR; PG8_MMA(0, 0, At, B0); if (full) PG8_MMA(0, 1, At, B1); PG8_BAR; PG8_SCHED;
            PG8_LDA(At, 1, 1); PG8_STAGE(PG8_SB(1, 0), b3, voffB); PG8_STAGE(PG8_SB(1, 1), b3 + hstepB, voffB); PG8_STAGE(PG8_SA(1, 0), a3, voffA);
            PG8_WAIT_V(8); PG8_WAIT_L(0); PG8_BAR; PG8_MMA(1, 0, At, B0); if (full) PG8_MMA(1, 1, At, B1); PG8_BAR; PG8_SCHED;
        }
        if constexpr (ALIGN_EPI) { if (wr == 0) PG8_BAR; }
        E(acc, cur, wr, wc, fr, fq);
        if (!has_next) break;
#pragma unroll
        for (int a = 0; a < 2; ++a)
#pragma unroll
            for (int b = 0; b < 2; ++b)
#pragma unroll
                for (int m = 0; m < 4; ++m)
#pragma unroll
                    for (int n = 0; n < 2; ++n) acc[a][b][m][n] = (f32x4){0.f, 0.f, 0.f, 0.f};
        cur = nxt; cA = nA; cB = nB; ++ui;
        if constexpr (ALIGN_EPI) { if (wr == 1) PG8_BAR; }
    }
    PG8_WAIT_V(0);
    if constexpr (!ALIGN_EPI) { if (wr == 0) PG8_BAR; }
    PG8_BAR;
#undef KOFFA
#undef PG8_SA
#undef PG8_SB
#undef PG8_STAGE
#undef PG8_LDA
#undef PG8_LDB
#undef PG8_MMA
#undef PG8_WAIT_V
#undef PG8_WAIT_L
#undef PG8_BAR
#undef PG8_SCHED
}
}

typedef GAS unsigned gu32;
#define RLX_AGENT __ATOMIC_RELAXED, __HIP_MEMORY_SCOPE_AGENT
#define XB_TMO      128
#define XB_XCNT(j)  (256  + 64 * (j))
#define XB_XSUB(j)  (1280 + 64 * (j))
#define XB_XGEN(j)  (2304 + 64 * (j))
#define XB_TOP      3328
#define XB_TOPGEN   3392
#define XCD_BAR_WORDS 3456
#define XB_SPIN_CAP (1u << 18)
__device__ __forceinline__ unsigned xb_ld(unsigned* p)              { return __hip_atomic_load(p, __ATOMIC_RELAXED, __HIP_MEMORY_SCOPE_AGENT); }
__device__ __forceinline__ unsigned xb_add(unsigned* p, unsigned v) { return __hip_atomic_fetch_add(p, v, __ATOMIC_RELAXED, __HIP_MEMORY_SCOPE_AGENT); }
__device__ __forceinline__ unsigned xb_xcc_id() { return (unsigned)__builtin_amdgcn_s_getreg((3 << 11) | 20) & 0xFu; }
#define XB_SPIN(cond, bar) do { unsigned _sp = 0; while (cond) { __builtin_amdgcn_s_sleep(1); \
    if ((++_sp & 255u) == 0u) { if (xb_ld(&(bar)[XB_TMO])) break; if (_sp > XB_SPIN_CAP) { atomicAdd(&(bar)[XB_TMO], 1u); break; } } } } while (0)
struct XcdBarrier { unsigned* bar; unsigned x; volatile LAS unsigned* st; };
__device__ __forceinline__ XcdBarrier xcd_barrier_post(unsigned* bar, volatile LAS unsigned* st) {
    XcdBarrier b; b.bar = bar; b.x = xb_xcc_id(); b.st = st;
    if (threadIdx.x == 0) (void)xb_add(&bar[XB_XCNT(b.x)], 1u);
    return b;
}
__device__ __forceinline__ void xcd_barrier_complete(unsigned* bar, unsigned x, unsigned& nloc, unsigned& nx) {
    const unsigned G = gridDim.x * gridDim.y * gridDim.z;
    unsigned sum, cnt, mine, sp = 0u;
    for (;;) {
        sum = 0u; cnt = 0u; mine = 0u;
#pragma unroll
        for (unsigned j = 0; j < 16; ++j) { const unsigned c = xb_ld(&bar[XB_XCNT(j)]); sum += c; cnt += (c > 0u) ? 1u : 0u; mine = (j == x) ? c : mine; }
        if (sum == G) break;
        __builtin_amdgcn_s_sleep(1);
        if ((++sp & 255u) == 0u) { if (xb_ld(&bar[XB_TMO])) break; if (sp > XB_SPIN_CAP) { atomicAdd(&bar[XB_TMO], 1u); break; } }
    }
    nloc = mine > 0u ? mine : 1u; nx = cnt > 0u ? cnt : 1u;
}
__device__ __forceinline__ void xcd_barrier(const XcdBarrier& b) {
    asm volatile("s_waitcnt vmcnt(0)" ::: "memory");
    __syncthreads();
    if (threadIdx.x == 0) {
        unsigned* bar = b.bar;
        __builtin_amdgcn_s_waitcnt(0);
        unsigned nloc = b.st[0], nx = b.st[1];
        if (nloc == 0u) { xcd_barrier_complete(bar, b.x, nloc, nx); b.st[0] = nloc; b.st[1] = nx; }
        const unsigned old = xb_add(&bar[XB_XSUB(b.x)], 1u);
        const unsigned gen = old / nloc;
        if (old + 1u == (gen + 1u) * nloc) {
            __builtin_amdgcn_fence(__ATOMIC_RELEASE, "agent");
            asm volatile("s_waitcnt vmcnt(0)" ::: "memory");
            const unsigned og = xb_add(&bar[XB_TOP], 1u);
            const unsigned tg = og / nx;
            if (og + 1u == (tg + 1u) * nx) xb_add(&bar[XB_TOPGEN], 1u);
            else XB_SPIN(xb_ld(&bar[XB_TOPGEN]) == tg, bar);
            __builtin_amdgcn_fence(__ATOMIC_ACQUIRE, "agent");
            xb_add(&bar[XB_XGEN(b.x)], 1u);
            asm volatile("s_waitcnt vmcnt(0)" ::: "memory");
        } else {
            XB_SPIN(xb_ld(&bar[XB_XGEN(b.x)]) == gen, bar);
            __builtin_amdgcn_fence(__ATOMIC_ACQUIRE, "agent");
            asm volatile("s_waitcnt vmcnt(0)" ::: "memory");
        }
    }
    __syncthreads();
}

struct Args {
    const float *x_prompt, *x_sample, *cache_k, *cache_v, *state_ssm, *state_conv, *norm_w, *w_in, *conv_w, *conv_b,
                *dt_bias, *a_log, *d_skip, *ssm_norm_w, *q_norm_w, *k_norm_w, *sinks, *rel_table, *w_out;
    float* out; unsigned char* ws; int ph_lo, ph_hi, sub, dry;
};
constexpr int NWAVES = 8, NT = 512;
constexpr int RING_BYTES = 131072, LDS_BYTES = 147456, MISC_OFF = LDS_BYTES - 512;

template <bool REMAP>
__device__ __forceinline__ void p0_transpose_item(const float* W, int K, int N, bf16_t* WT, LAS bf16_t* scr, int item, int lane) {
    const int nblk = (N + 63) / 64, kb = item / nblk, nb = item % nblk, k0 = 64 * kb, n0 = 64 * nb;
    const bool nok = (n0 + lane) < N;
    const float* wp = W + (size_t)k0 * N + n0 + (nok ? lane : 0);
    float v[64];
#pragma unroll
    for (int kk = 0; kk < 64; ++kk) v[kk] = __builtin_nontemporal_load(wp + (size_t)kk * N);
#pragma unroll
    for (int kk = 0; kk < 64; kk += 2) *(LAS unsigned*)(scr + lane * 68 + kk) = pk2(v[kk], v[kk + 1]);
    LDS_WAIT(); asm volatile("" ::: "memory");
    const int c = lane & 7;
#pragma unroll
    for (int j = 0; j < 8; ++j) { const int n = (lane >> 3) + 8 * j;
        const u32x2 lo = *(const LAS u32x2*)(scr + n * 68 + 8 * c), hi = *(const LAS u32x2*)(scr + n * 68 + 8 * c + 4);
        u32x4 o; o.x = lo.x; o.y = lo.y; o.z = hi.x; o.w = hi.y;
        int ng = n0 + n;
        if (ng < N) { if (REMAP) ng = (ng < 2560) ? ng : (ng < 2576 ? ng + 2560 : ng - 16);
            *(u32x4*)(WT + (size_t)ng * K + k0 + 8 * c) = o; } }
    LDS_WAIT(); asm volatile("" ::: "memory");
}
__device__ __forceinline__ void p0_prologue(const Args& a, LAS unsigned char* lds, int vcu, int G, int wave, int lane, unsigned long long& amp_d) {
    unsigned long long amp_t = 0ull;
#define AMPB(k) do { if (MK_AMP == (k)) amp_t = __builtin_amdgcn_s_memrealtime(); } while (0)
#define AMPE(k) do { if (MK_AMP == (k)) { __syncthreads(); amp_d += __builtin_amdgcn_s_memrealtime() - amp_t; } } while (0)
    AMPB(100);
    LAS bf16_t* scr = (LAS bf16_t*)(lds + wave * 16384);
    bf16_t* WinT = (bf16_t*)(a.ws + WS_WIN); bf16_t* WoutT = (bf16_t*)(a.ws + WS_WOUT); bf16_t* H = (bf16_t*)(a.ws + WS_H);
    const int gw = vcu * NWAVES + wave, NGW = G * NWAVES;
    constexpr int I_IN = (DM / 64) * ((NIN + 63) / 64), I_OUT = (2048 / 64) * (DM / 64);
    for (int it = gw; it < I_IN + I_OUT; it += NGW) {
        if (it < I_IN) p0_transpose_item<true>(a.w_in, DM, NIN, WinT, scr, it, lane);
        else p0_transpose_item<false>(a.w_out, 2048, DM, WoutT, scr, it - I_IN, lane);
    }
    AMPE(100); AMPB(101);
    for (int r = gw; r < NINP - NIN; r += NGW) { u32x4* p = (u32x4*)(WinT + (size_t)(NIN + r) * DM); p[lane] = (u32x4){0u, 0u, 0u, 0u}; p[lane + 64] = (u32x4){0u, 0u, 0u, 0u}; }
    f32x4 nw[4];
#pragma unroll
    for (int j = 0; j < 4; ++j) nw[j] = ((const f32x4*)a.norm_w)[lane + 64 * j];
    f32x4 vn[4][4];
#define P0_LOAD(dst, mb) do { _Pragma("unroll") for (int r = 0; r < 4; ++r) { const int m = (mb) + r * NGW; \
        if (m < MT) { const float* xrow = (m < MP) ? a.x_prompt + (size_t)m * DM : a.x_sample + (size_t)(m - MP) * DM; const f32x4* xr = (const f32x4*)xrow + lane; \
            _Pragma("unroll") for (int j = 0; j < 4; ++j) dst[r][j] = __builtin_nontemporal_load(xr + 64 * j); } } } while (0)
    P0_LOAD(vn, gw);
    for (int m0 = gw; m0 < MT; m0 += 4 * NGW) {
        f32x4 v[4][4];
#pragma unroll
        for (int r = 0; r < 4; ++r)
#pragma unroll
            for (int j = 0; j < 4; ++j) v[r][j] = vn[r][j];
        if (m0 + 4 * NGW < MT) P0_LOAD(vn, m0 + 4 * NGW);
#pragma unroll
        for (int r = 0; r < 4; ++r) { const int m = m0 + r * NGW;
            if (m < MT) { float s = 0.f;
#pragma unroll
                for (int j = 0; j < 4; ++j) s += (v[r][j].x * v[r][j].x + v[r][j].y * v[r][j].y) + (v[r][j].z * v[r][j].z + v[r][j].w * v[r][j].w);
                const float rstd = __builtin_amdgcn_rsqf(wave_sum(s) * (1.f / DM) + EPS);
                unsigned long long* o8 = (unsigned long long*)(H + (size_t)m * DM) + lane;
#pragma unroll
                for (int j = 0; j < 4; ++j) { const f32x4 h = v[r][j] * rstd * nw[j]; o8[64 * j] = (unsigned long long)pk2(h.x, h.y) | ((unsigned long long)pk2(h.z, h.w) << 32); } } }
    }
#undef P0_LOAD
    AMPE(101);
#undef AMPB
#undef AMPE
}

__device__ __forceinline__ float ssd_dt_scan(const float* DT, int R0, int h, int e, int lane, const float* dt_bias, const float* a_log, LAS float* dtv, LAS float* acum, float& d0o, float& d1o, float& c0o, float& c1o) {
    const float bias = dt_bias[h]; const float A = -expf(a_log[h]);
    const int l0 = 2 * lane;
    const float d0 = softplus_f(DT[(size_t)(R0 + l0) * 16 + h] + bias), d1 = softplus_f(DT[(size_t)(R0 + l0 + 1) * 16 + h] + bias);
    const float a0 = d0 * A, a1 = d1 * A; float s = a0 + a1;
#pragma unroll
    for (int o = 1; o < 64; o <<= 1) { const float t = __shfl_up(s, o); if (lane >= o) s += t; }
    const float excl = s - (a0 + a1);
    const float c0 = excl + a0, c1 = excl + a0 + a1;
    dtv[e * 128 + l0] = d0; dtv[e * 128 + l0 + 1] = d1; acum[e * 128 + l0] = c0; acum[e * 128 + l0 + 1] = c1;
    d0o = d0; d1o = d1; c0o = c0; c1o = c1;
    return __shfl(s, 63);
}

typedef short v4i16_t __attribute__((ext_vector_type(4)));
__device__ __forceinline__ u32x2 lds_tr16(const LAS bf16_t* p) { return __builtin_bit_cast(u32x2, __builtin_amdgcn_ds_read_tr16_b64_v4i16((LAS v4i16_t*)p)); }
struct ConvRaw { u32x4 r[5]; };
__device__ __forceinline__ void conv_load(const bf16_t* U, const bf16_t* HALO, int R0, int gc, int c, int chb, int tid, ConvRaw& o) {
    const int q = tid & 7, r = tid >> 3;
#pragma unroll
    for (int i = 0; i < 5; ++i) {
        const int rr = 2 * r - 3 + i;
        u32x4 v = (u32x4){0u, 0u, 0u, 0u};
        if (rr >= 0) v = *(const u32x4*)(U + (size_t)(R0 + rr) * UW + C_X + chb + 8 * q);
        else if (c > 0) v = *(const u32x4*)(HALO + (size_t)((gc - 1) * 3 + 3 + rr) * CONVD + chb + 8 * q);
        o.r[i] = v;
    }
}
__device__ __forceinline__ void conv_apply(const ConvRaw& in, const LAS float* cw, int lc, float (&o0)[8], float (&o1)[8]) {
    float x[5][8];
#pragma unroll
    for (int i = 0; i < 5; ++i) { const u32x4 v = in.r[i]; x[i][0] = bflo(v.x); x[i][1] = bfhi(v.x); x[i][2] = bflo(v.y); x[i][3] = bfhi(v.y); x[i][4] = bflo(v.z); x[i][5] = bfhi(v.z); x[i][6] = bflo(v.w); x[i][7] = bfhi(v.w); }
    float w[5][8];
#pragma unroll
    for (int t = 0; t < 5; ++t) { const f32x4 a0 = *(const LAS f32x4*)(cw + t * 768 + lc), a1 = *(const LAS f32x4*)(cw + t * 768 + lc + 4);
        w[t][0] = a0.x; w[t][1] = a0.y; w[t][2] = a0.z; w[t][3] = a0.w; w[t][4] = a1.x; w[t][5] = a1.y; w[t][6] = a1.z; w[t][7] = a1.w; }
#pragma unroll
    for (int i = 0; i < 8; ++i) {
        o0[i] = silu_f(w[4][i] + w[0][i] * x[0][i] + w[1][i] * x[1][i] + w[2][i] * x[2][i] + w[3][i] * x[3][i]);
        o1[i] = silu_f(w[4][i] + w[0][i] * x[1][i] + w[1][i] * x[2][i] + w[2][i] * x[3][i] + w[3][i] * x[4][i]);
    }
}
__device__ __forceinline__ u32x4 pack8(const float (&v)[8]) { u32x4 w; w.x = pk2(v[0], v[1]); w.y = pk2(v[2], v[3]); w.z = pk2(v[4], v[5]); w.w = pk2(v[6], v[7]); return w; }

__device__ __forceinline__ void ssd_state_item(const Args& a, LAS unsigned char* lds, int item, int tid, int wave, int lane, const bool dry = false) {
    const int b = item >> 7, c = (item >> 1) & 63, g = item & 1, gc = b * 64 + c;
    const int R0 = b * SEQ + c * 128;
    bf16_t* U = (bf16_t*)(a.ws + WS_U); const float* DT = (const float*)(a.ws + WS_DT); const bf16_t* HALO = (const bf16_t*)(a.ws + WS_HALO);
    bf16_t* ST = (bf16_t*)(a.ws + WS_ST); float* DEC = (float*)(a.ws + WS_DEC);
    LAS bf16_t* Bn = (LAS bf16_t*)lds;
    LAS bf16_t* Xw0 = (LAS bf16_t*)(lds + 34816);
    LAS float* dtv = (LAS float*)(lds + 71680); LAS float* acum = dtv + 1024; LAS float* wv = acum + 1024;
    LAS float* cw = (LAS float*)(lds + 83968);
    auto blk_chb = [&](int k) -> int { return (k < 2) ? (1024 + 128 * g + 64 * k) : (k < 4) ? (1280 + 128 * g + 64 * (k - 2)) : (512 * g + 64 * (k - 4)); };
    auto blk_lc = [&](int k) -> int { return (k < 2) ? (512 + 64 * k) : (k < 4) ? (640 + 64 * (k - 2)) : (64 * (k - 4)); };
    ConvRaw raw, raw2; conv_load(U, HALO, R0, gc, c, blk_chb(0), tid, raw); conv_load(U, HALO, R0, gc, c, blk_chb(1), tid, raw2);
    for (int i = tid; i < 5 * 768; i += NT) { const int t = i / 768, lc = i % 768; const int ch = (lc < 512) ? (512 * g + lc) : (lc < 640) ? (1024 + 128 * g + (lc - 512)) : (1280 + 128 * g + (lc - 640));
        cw[i] = (t < 4) ? a.conv_w[t * CONVD + ch] : a.conv_b[ch]; }
    {
        float d0, d1, c0, c1; const int h = 8 * g + wave;
        const float aend = ssd_dt_scan(DT, R0, h, wave, lane, a.dt_bias, a.a_log, dtv, acum, d0, d1, c0, c1);
        wv[wave * 128 + 2 * lane] = d0 * __expf(aend - c0); wv[wave * 128 + 2 * lane + 1] = d1 * __expf(aend - c1);
        if (lane == 0 && !dry) DEC[gc * 16 + h] = __expf(aend);
    }
    __syncthreads();
    if (!dry) ((f32x4*)(a.ws + WS_DTA))[(size_t)item * 512 + tid] = ((const LAS f32x4*)dtv)[tid];
    const int fr = lane & 15, grp = lane >> 4, q = tid & 7, r = tid >> 3;
#pragma unroll 1
    for (int k = 0; k < 12; ++k) {
        ConvRaw cur = raw; raw = raw2;
        if (k + 2 < 12) conv_load(U, HALO, R0, gc, c, blk_chb(k + 2), tid, raw2);
        float o0[8], o1[8];
        if (dry && MK_ABL == 22) {
#pragma unroll
            for (int i = 0; i < 8; ++i) { o0[i] = bflo(cur.r[0].x) + i; o1[i] = bfhi(cur.r[4].w) + i; } }
        else conv_apply(cur, cw, blk_lc(k) + 8 * q, o0, o1);
        const u32x4 p0 = pack8(o0), p1 = pack8(o1);
        __syncthreads();
        bf16_t* up = U + (size_t)(R0 + 2 * r) * UW + C_X + blk_chb(k) + 8 * q;
        if (!dry || p0.x == 0x12345678u) { *(u32x4*)up = p0; *(u32x4*)(up + UW) = p1; }
        if (k < 2) { *(LAS u32x4*)(Bn + (2 * r) * 136 + 64 * k + 8 * q) = p0; *(LAS u32x4*)(Bn + (2 * r + 1) * 136 + 64 * k + 8 * q) = p1; }
        if (k >= 4) {
            const int e = k - 4, h = 8 * g + e;
            LAS bf16_t* Xw = Xw0 + (e & 1) * (128 * 72);
            const float w0 = wv[e * 128 + 2 * r], w1 = wv[e * 128 + 2 * r + 1];
#pragma unroll
            for (int i = 0; i < 8; ++i) { o0[i] *= w0; o1[i] *= w1; }
            *(LAS u32x4*)(Xw + (2 * r) * 72 + 8 * q) = pack8(o0); *(LAS u32x4*)(Xw + (2 * r + 1) * 72 + 8 * q) = pack8(o1);
            __syncthreads();
            if (dry && MK_ABL == 21) continue;
            f32x4 acc[4];
#pragma unroll
            for (int pt = 0; pt < 4; ++pt) acc[pt] = (f32x4){0.f, 0.f, 0.f, 0.f};
#pragma unroll
            for (int ks = 0; ks < 4; ++ks) {
                const int l0 = 32 * ks + 8 * grp + (fr >> 2);
                const u32x2 a0 = lds_tr16(Bn + l0 * 136 + 16 * wave + 4 * (fr & 3)), a1 = lds_tr16(Bn + (l0 + 4) * 136 + 16 * wave + 4 * (fr & 3));
                u32x2 b0[4], b1[4];
#pragma unroll
                for (int pt = 0; pt < 4; ++pt) { b0[pt] = lds_tr16(Xw + l0 * 72 + 16 * pt + 4 * (fr & 3)); b1[pt] = lds_tr16(Xw + (l0 + 4) * 72 + 16 * pt + 4 * (fr & 3)); }
                __builtin_amdgcn_sched_barrier(0);
                u32x4 aw; aw.x = a0.x; aw.y = a0.y; aw.z = a1.x; aw.w = a1.y;
#pragma unroll
                for (int pt = 0; pt < 4; ++pt) {
                    u32x4 bw; bw.x = b0[pt].x; bw.y = b0[pt].y; bw.z = b1[pt].x; bw.w = b1[pt].y;
                    acc[pt] = mfma16(__builtin_bit_cast(bf16x8, aw), __builtin_bit_cast(bf16x8, bw), acc[pt]);
                }
            }
            bf16_t* stp = ST + ((size_t)(gc * 16 + h) * 64) * 128 + 16 * wave + 4 * grp;
#pragma unroll
            for (int pt = 0; pt < 4; ++pt) { u32x2 o; o.x = pk2(acc[pt][0], acc[pt][1]); o.y = pk2(acc[pt][2], acc[pt][3]); if (!dry || o.x == 0x12345678u) *(u32x2*)(stp + (size_t)(16 * pt + fr) * 128) = o; }
        }
    }
    __syncthreads();
}

__device__ __forceinline__ void ssd_scan(const Args& a, LAS unsigned char* lds, int bx, int G, int tid, int wave, int lane, const bool dry) {
    u32x4* ST = (u32x4*)(a.ws + WS_ST); const float* DEC = (const float*)(a.ws + WS_DEC);
    LAS float* agg = (LAS float*)lds;
    const int seg = wave >> 1, gl = (wave & 1) * 64 + lane;
    for (int blk = bx; blk < NB * 16 * 8; blk += G) {
        const int bh = blk >> 3, b = bh >> 4, h = bh & 15, g8 = (blk & 7) * 128 + gl;
        u32x4* p = ST + ((size_t)(b * 64 + 16 * seg) * 16 + h) * 1024 + g8;
        const float* dp = DEC + (b * 64) * 16 + h;
        u32x4 v[16]; float d[16];
#pragma unroll
        for (int c = 0; c < 16; ++c) v[c] = p[(size_t)c * 16 * 1024];
        float pr[4];
#pragma unroll
        for (int s4 = 0; s4 < 4; ++s4) { float q = 1.f;
#pragma unroll
            for (int c = 0; c < 16; ++c) { const float dd = dp[(16 * s4 + c) * 16]; q *= dd; if (s4 == seg) d[c] = dd; }
            pr[s4] = q; }
        float cr[8];
#pragma unroll
        for (int i = 0; i < 8; ++i) cr[i] = 0.f;
#pragma unroll
        for (int c = 0; c < 16; ++c) { const u32x4 w = v[c]; const float f[8] = {bflo(w.x), bfhi(w.x), bflo(w.y), bfhi(w.y), bflo(w.z), bfhi(w.z), bflo(w.w), bfhi(w.w)};
#pragma unroll
            for (int i = 0; i < 8; ++i) cr[i] = cr[i] * d[c] + f[i]; }
        __syncthreads();
        *(LAS f32x4*)(agg + (seg * 128 + gl) * 8) = (f32x4){cr[0], cr[1], cr[2], cr[3]}; *(LAS f32x4*)(agg + (seg * 128 + gl) * 8 + 4) = (f32x4){cr[4], cr[5], cr[6], cr[7]};
        __syncthreads();
        float cin[8];
#pragma unroll
        for (int i = 0; i < 8; ++i) cin[i] = 0.f;
#pragma unroll
        for (int s4 = 0; s4 < 3; ++s4) if (s4 < seg) { const f32x4 a0 = *(const LAS f32x4*)(agg + (s4 * 128 + gl) * 8), a1 = *(const LAS f32x4*)(agg + (s4 * 128 + gl) * 8 + 4);
            const float av[8] = {a0.x, a0.y, a0.z, a0.w, a1.x, a1.y, a1.z, a1.w};
#pragma unroll
            for (int i = 0; i < 8; ++i) cin[i] = cin[i] * pr[s4] + av[i]; }
#pragma unroll
        for (int c = 0; c < 16; ++c) { const u32x4 w = v[c]; const float f[8] = {bflo(w.x), bfhi(w.x), bflo(w.y), bfhi(w.y), bflo(w.z), bfhi(w.z), bflo(w.w), bfhi(w.w)};
            u32x4 o; o.x = pk2(cin[0], cin[1]); o.y = pk2(cin[2], cin[3]); o.z = pk2(cin[4], cin[5]); o.w = pk2(cin[6], cin[7]);
            if (!dry) p[(size_t)c * 16 * 1024] = o;
#pragma unroll
            for (int i = 0; i < 8; ++i) cin[i] = cin[i] * d[c] + f[i]; }
        if (seg == 3 && (!dry || cin[0] == 12345.678f)) { float* o = a.out + O_SP + (size_t)bh * 8192 + 8 * g8;
            *(f32x4*)o = (f32x4){cin[0], cin[1], cin[2], cin[3]}; *(f32x4*)(o + 4) = (f32x4){cin[4], cin[5], cin[6], cin[7]}; }
    }
}

struct HeadRegs { u32x4 x[2], s[2]; u32x2 z[4]; };
__device__ __forceinline__ void ssd_out_load(const bf16_t* U, const bf16_t* ST, int R0, int gc, int h, int tid, int l, int grp, HeadRegs& o) {
#pragma unroll
    for (int i = 0; i < 2; ++i) { const int ci = tid + NT * i;
        o.x[i] = *(const u32x4*)(U + (size_t)(R0 + (ci >> 3)) * UW + C_X + 64 * h + 8 * (ci & 7));
        o.s[i] = *(const u32x4*)(ST + ((size_t)(gc * 16 + h) * 64 + (ci >> 4)) * 128 + 8 * (ci & 15)); }
    const bf16_t* zrow = U + (size_t)(R0 + l) * UW + C_Z + 64 * h + 4 * grp;
#pragma unroll
    for (int pt = 0; pt < 4; ++pt) o.z[pt] = *(const u32x2*)(zrow + 16 * pt);
}
__device__ __forceinline__ void ssd_out_stage(const HeadRegs& in, LAS bf16_t* X, LAS bf16_t* St, int tid) {
#pragma unroll
    for (int i = 0; i < 2; ++i) { const int ci = tid + NT * i;
        *(LAS u32x4*)(X + (ci >> 3) * 72 + 8 * (ci & 7)) = in.x[i];
        *(LAS u32x4*)(St + (ci >> 4) * 136 + 8 * (ci & 15)) = in.s[i]; }
}
__device__ __forceinline__ void ssd_out_item(const Args& a, LAS unsigned char* lds, int item, int tid, int wave, int lane, const bool dry) {
    const int b = item >> 7, c = (item >> 1) & 63, g = item & 1, gc = b * 64 + c;
    const int R0 = b * SEQ + c * 128;
    bf16_t* U = (bf16_t*)(a.ws + WS_U); const float* DT = (const float*)(a.ws + WS_DT); const bf16_t* ST = (const bf16_t*)(a.ws + WS_ST);
    LAS bf16_t* Cn = (LAS bf16_t*)lds;
    LAS bf16_t* setA = (LAS bf16_t*)(lds + 34816);
    LAS bf16_t* setB = (LAS bf16_t*)(lds + 70656);
    LAS bf16_t* Bn = setB;
    LAS float* dtv = (LAS float*)(lds + 106496); LAS float* acum = dtv + 1024;
    const int fr = lane & 15, grp = lane >> 4;
    const int l = 16 * wave + fr;
    HeadRegs hr; ssd_out_load(U, ST, R0, gc, 8 * g, tid, l, grp, hr);
    {
        u32x4 bv[4], cv[4];
#pragma unroll
        for (int i = 0; i < 4; ++i) { const int ci = tid + NT * i; const bf16_t* rp = U + (size_t)(R0 + (ci >> 4)) * UW + 128 * g + 8 * (ci & 15); bv[i] = *(const u32x4*)(rp + C_B); cv[i] = *(const u32x4*)(rp + C_C); }
        const f32x4 dta = ((const f32x4*)(a.ws + WS_DTA))[(size_t)item * 512 + tid];
#pragma unroll
        for (int i = 0; i < 4; ++i) { const int ci = tid + NT * i; *(LAS u32x4*)(Bn + (ci >> 4) * 136 + 8 * (ci & 15)) = bv[i]; *(LAS u32x4*)(Cn + (ci >> 4) * 136 + 8 * (ci & 15)) = cv[i]; }
        ((LAS f32x4*)dtv)[tid] = dta;
    }
    ssd_out_stage(hr, setA, setA + 128 * 72, tid);
    u32x2 zc[4];
#pragma unroll
    for (int pt = 0; pt < 4; ++pt) zc[pt] = hr.z[pt];
    __syncthreads();
    f32x4 cb[8];
#pragma unroll
    for (int st = 0; st < 8; ++st) cb[st] = (f32x4){0.f, 0.f, 0.f, 0.f};
#pragma unroll
    for (int ks = 0; ks < 4; ++ks) {
        const bf16x8 cf = *(const LAS bf16x8*)(Cn + (16 * wave + fr) * 136 + 32 * ks + 8 * grp);
#pragma unroll
        for (int st = 0; st < 8; ++st) if (st <= wave) { const bf16x8 bfm = *(const LAS bf16x8*)(Bn + (16 * st + fr) * 136 + 32 * ks + 8 * grp); cb[st] = mfma16(bfm, cf, cb[st]); }
    }
    __syncthreads();
    float ssq = 0.f;
    LAS bf16_t* stg = (LAS bf16_t*)(lds + 114688) + wave * (16 * 64);
    bf16_t* yb = U + (size_t)(R0 + 16 * wave) * UW + C_Z + 512 * g;
    const int e_n = (dry && MK_ABL == 13) ? 0 : 8;
#pragma unroll 1
    for (int e = 0; e < e_n; ++e) {
        const int h = 8 * g + e;
        LAS bf16_t* X = (e & 1) ? setB : setA; LAS bf16_t* St = X + 128 * 72;
        if (e < 7) ssd_out_load(U, ST, R0, gc, h + 1, tid, l, grp, hr);
        f32x4 accd[4], acco[4];
#pragma unroll
        for (int pt = 0; pt < 4; ++pt) { accd[pt] = (f32x4){0.f, 0.f, 0.f, 0.f}; acco[pt] = (f32x4){0.f, 0.f, 0.f, 0.f}; }
        const float al = acum[e * 128 + l];
#pragma unroll
        for (int ks = 0; ks < 4; ++ks) {
            if (dry && MK_ABL == 11) break;
            const int sA = 32 * ks + 4 * grp, sB = sA + 16;
            const bool diag = (2 * ks <= wave);
            const bf16x8 cf = *(const LAS bf16x8*)(Cn + (16 * wave + fr) * 136 + 32 * ks + 8 * grp);
            bf16x8 sf[4];
#pragma unroll
            for (int pt = 0; pt < 4; ++pt) sf[pt] = *(const LAS bf16x8*)(St + (16 * pt + fr) * 136 + 32 * ks + 8 * grp);
            f32x4 acA = (f32x4){0.f, 0.f, 0.f, 0.f}, acB = acA, dtA = acA, dtB = acA; u32x2 xlo[4], xhi[4];
            if (diag) {
                acA = *(const LAS f32x4*)(acum + e * 128 + sA); acB = *(const LAS f32x4*)(acum + e * 128 + sB);
                dtA = *(const LAS f32x4*)(dtv + e * 128 + sA); dtB = *(const LAS f32x4*)(dtv + e * 128 + sB);
#pragma unroll
                for (int pt = 0; pt < 4; ++pt) { xlo[pt] = lds_tr16(X + (sA + (fr >> 2)) * 72 + 16 * pt + 4 * (fr & 3)); xhi[pt] = lds_tr16(X + (sB + (fr >> 2)) * 72 + 16 * pt + 4 * (fr & 3)); }
            }
            __builtin_amdgcn_sched_barrier(0);
            if (diag) {
                float m[8];
#pragma unroll
                for (int j = 0; j < 4; ++j) {
                    const float va = cb[2 * ks][j] * dtA[j] * __expf(al - acA[j]); m[j] = (sA + j <= l) ? va : 0.f;
                    const float vb = cb[2 * ks + 1][j] * dtB[j] * __expf(al - acB[j]); m[4 + j] = (sB + j <= l) ? vb : 0.f;
                }
                u32x4 mw; mw.x = pk2(m[0], m[1]); mw.y = pk2(m[2], m[3]); mw.z = pk2(m[4], m[5]); mw.w = pk2(m[6], m[7]);
                const bf16x8 mf = __builtin_bit_cast(bf16x8, mw);
#pragma unroll
                for (int pt = 0; pt < 4; ++pt) {
                    u32x4 aw; aw.x = xlo[pt].x; aw.y = xlo[pt].y; aw.z = xhi[pt].x; aw.w = xhi[pt].y;
                    accd[pt] = mfma16(__builtin_bit_cast(bf16x8, aw), mf, accd[pt]);
                }
            }
#pragma unroll
            for (int pt = 0; pt < 4; ++pt) acco[pt] = mfma16(sf[pt], cf, acco[pt]);
        }
        const float eal = __expf(al), dsk = a.d_skip[h];
#pragma unroll
        for (int pt = 0; pt < 4; ++pt) {
            if (dry && MK_ABL == 12) break;
            const u32x2 zz = zc[pt];
            const u32x2 xx = *(const LAS u32x2*)(X + l * 72 + 16 * pt + 4 * grp);
            const float z[4] = {bflo(zz.x), bfhi(zz.x), bflo(zz.y), bfhi(zz.y)};
            const float xv[4] = {bflo(xx.x), bfhi(xx.x), bflo(xx.y), bfhi(xx.y)};
            float gy[4];
#pragma unroll
            for (int r = 0; r < 4; ++r) {
                const float y = accd[pt][r] + eal * acco[pt][r] + dsk * xv[r];
                gy[r] = y * silu_f(z[r]); ssq += gy[r] * gy[r];
            }
            u32x2 o; o.x = pk2(gy[0], gy[1]); o.y = pk2(gy[2], gy[3]);
            *(LAS u32x2*)(stg + fr * 64 + 8 * ((2 * pt + (grp >> 1)) ^ (fr & 7)) + 4 * (grp & 1)) = o;
        }
        LDS_WAIT(); asm volatile("" ::: "memory");
#pragma unroll
        for (int i = 0; i < 2; ++i) { const int row = 8 * i + (lane >> 3), ch = lane & 7;
            const u32x4 v = *(const LAS u32x4*)(stg + row * 64 + 8 * (ch ^ (row & 7)));
            if (!dry) *(u32x4*)(yb + (size_t)row * UW + 64 * e + 8 * ch) = v; }
        if (e < 7) {
            ssd_out_stage(hr, (e & 1) ? setA : setB, ((e & 1) ? setA : setB) + 128 * 72, tid);
#pragma unroll
            for (int pt = 0; pt < 4; ++pt) zc[pt] = hr.z[pt]; }
        __syncthreads();
    }
    ssq += __shfl_xor(ssq, 16); ssq += __shfl_xor(ssq, 32);
    const float rstd = __builtin_amdgcn_rsqf(ssq * (1.f / 512.f) + EPS);
    LAS float* rsw = (LAS float*)stg;
    if (grp == 0) rsw[fr] = rstd;
    LDS_WAIT(); asm volatile("" ::: "memory");
    const float rs0 = rsw[lane >> 3], rs1 = rsw[8 + (lane >> 3)];
#pragma unroll 2
    for (int e = 0; e < 8; ++e) {
        const int ch = lane & 7;
        const f32x4 nwa = *(const f32x4*)(a.ssm_norm_w + 512 * g + 64 * e + 8 * ch), nwb = *(const f32x4*)(a.ssm_norm_w + 512 * g + 64 * e + 8 * ch + 4);
#pragma unroll
        for (int i = 0; i < 2; ++i) { const int row = 8 * i + (lane >> 3); const float rs = i ? rs1 : rs0;
            bf16_t* p = yb + (size_t)row * UW + 64 * e + 8 * ch;
            const u32x4 v = *(const u32x4*)p;
            u32x4 o; o.x = pk2(bflo(v.x) * rs * nwa.x, bfhi(v.x) * rs * nwa.y); o.y = pk2(bflo(v.y) * rs * nwa.z, bfhi(v.y) * rs * nwa.w);
            o.z = pk2(bflo(v.z) * rs * nwb.x, bfhi(v.z) * rs * nwb.y); o.w = pk2(bflo(v.w) * rs * nwb.z, bfhi(v.w) * rs * nwb.w);
            if (!dry || o.x == 0x12345678u) *(u32x4*)p = o; }
    }
    __syncthreads();
}

__device__ __forceinline__ int rel_bucket(int d) {
    if (d < 16) return d;
    const int lg = 16 + (int)(logf((float)d * (1.0f / 16.0f)) * (16.0f / 2.0794415416798357f));
    return lg < 31 ? lg : 31;
}
struct AttnKV { u32x4 k[4], v[4]; };
__device__ __forceinline__ void attn_load_kv(const bf16_t* U, int unit, int tid, AttnKV& r) {
    const int b = unit >> 8, blk = (unit >> 2) & 63, kvh = unit & 3; const int R0 = b * SEQ + blk * 128;
    const int j = tid >> 1, hf = tid & 1;
    const bool z = (blk == 0 && j < 128);
    const bf16_t* rp = U + (size_t)(R0 - 128 + (z ? 128 : j)) * UW + 64 * kvh + 32 * hf;
    const u32x4* kp = (const u32x4*)(rp + C_K); const u32x4* vp = (const u32x4*)(rp + C_V);
#pragma unroll
    for (int i = 0; i < 4; ++i) { r.k[i] = kp[i]; r.v[i] = vp[i]; }
}
typedef float f32x16 __attribute__((ext_vector_type(16)));
__device__ __forceinline__ f32x16 mfma32(bf16x8 a, bf16x8 b, f32x16 c) { return __builtin_amdgcn_mfma_f32_32x32x16_bf16(a, b, c, 0, 0, 0); }
__device__ __forceinline__ void attn_phase(const Args& a, LAS unsigned char* lds, int bx, int G, int tid, int wave, int lane, float m2, const bool dry, unsigned long long& amp_d) {
    unsigned long long amp_t = 0ull;
#define AMPB(k) do { if (MK_AMP == (k)) amp_t = __builtin_amdgcn_s_memrealtime(); } while (0)
#define AMPE(k) do { if (MK_AMP == (k)) amp_d += __builtin_amdgcn_s_memrealtime() - amp_t; } while (0)
    AMPB(210);
    bf16_t* U = (bf16_t*)(a.ws + WS_U);
    LAS bf16_t* Kn = (LAS bf16_t*)lds;
    LAS bf16_t* Vn = (LAS bf16_t*)(lds + 41472);
    LAS float* bias2 = (LAS float*)(lds + 82944);
    LAS float* qnw = (LAS float*)(lds + 95232);
    int unit = bx; if (unit >= 512) return;
    AttnKV kv; attn_load_kv(U, unit, tid, kv);
    __syncthreads();
    for (int i = tid; i < 16 * 192; i += NT) { const int hh = i / 192, t = i % 192, d = 128 - (t - 32); bias2[i] = (d >= 0 && d <= 128) ? a.rel_table[rel_bucket(d) * 16 + hh] * LOG2E - m2 : -1e30f; }
    if (tid < 288) { *(LAS u32x4*)(Kn + 256 * 72 + tid * 8) = (u32x4){0u, 0u, 0u, 0u}; *(LAS u32x4*)(Vn + 256 * 72 + tid * 8) = (u32x4){0u, 0u, 0u, 0u}; }
    if (tid < 64) qnw[tid] = a.q_norm_w[tid] * (0.125f * LOG2E);
    const int r32 = lane & 31, hh = lane >> 5;
    while (unit < 512) {
        const int b = unit >> 8, blk = (unit >> 2) & 63, kvh = unit & 3;
        const int R0 = b * SEQ + blk * 128;
        const int gq = wave >> 1, hq = 4 * kvh + gq;
        u32x4 qraw[2][4];
#pragma unroll
        for (int qt = 0; qt < 2; ++qt) {
            const bf16_t* qrow = U + (size_t)(R0 + 64 * (wave & 1) + 32 * qt + r32) * UW + C_Q + 64 * hq + 8 * hh;
#pragma unroll
            for (int ks = 0; ks < 4; ++ks) qraw[qt][ks] = *(const u32x4*)(qrow + 16 * ks);
        }
        {
            const int j = tid >> 1, hf = tid & 1;
            const bool zero = (blk == 0 && j < 128);
            f32x4 kf[8];
#pragma unroll
            for (int i = 0; i < 4; ++i) { const u32x4 w = kv.k[i]; kf[2 * i] = (f32x4){bflo(w.x), bfhi(w.x), bflo(w.y), bfhi(w.y)}; kf[2 * i + 1] = (f32x4){bflo(w.z), bfhi(w.z), bflo(w.w), bfhi(w.w)}; }
            float ss = 0.f;
#pragma unroll
            for (int i = 0; i < 8; ++i) ss += (kf[i].x * kf[i].x + kf[i].y * kf[i].y) + (kf[i].z * kf[i].z + kf[i].w * kf[i].w);
            ss += __shfl_xor(ss, 1);
            const float rstd = zero ? 0.f : __builtin_amdgcn_rsqf(ss * (1.f / 64.f) + EPS);
#pragma unroll
            for (int i = 0; i < 8; ++i) { const f32x4 w = *(const f32x4*)(a.k_norm_w + 32 * hf + 4 * i); kf[i] = kf[i] * rstd * w; }
#pragma unroll
            for (int i = 0; i < 4; ++i) { u32x4 w; w.x = pk2(kf[2 * i].x, kf[2 * i].y); w.y = pk2(kf[2 * i].z, kf[2 * i].w); w.z = pk2(kf[2 * i + 1].x, kf[2 * i + 1].y); w.w = pk2(kf[2 * i + 1].z, kf[2 * i + 1].w);
                *(LAS u32x4*)(Kn + j * 72 + 32 * hf + 8 * i) = w;
                u32x4 vw = kv.v[i]; if (zero) vw = (u32x4){0u, 0u, 0u, 0u};
                *(LAS u32x4*)(Vn + j * 72 + 32 * hf + 8 * i) = vw; }
            if (blk == 63 && j >= 128 && !dry) {
                float* ok = a.out + O_KP + ((size_t)(b * 128 + (j - 128)) * 4 + kvh) * 64 + 32 * hf; float* ov = a.out + O_VP + ((size_t)(b * 128 + (j - 128)) * 4 + kvh) * 64 + 32 * hf;
#pragma unroll
                for (int i = 0; i < 8; ++i) *(f32x4*)(ok + 4 * i) = kf[i];
#pragma unroll
                for (int i = 0; i < 4; ++i) { const u32x4 w = kv.v[i]; *(f32x4*)(ov + 8 * i) = (f32x4){bflo(w.x), bfhi(w.x), bflo(w.y), bfhi(w.y)}; *(f32x4*)(ov + 8 * i + 4) = (f32x4){bflo(w.z), bfhi(w.z), bflo(w.w), bfhi(w.w)}; }
            }
        }
        const int nxt = unit + G;
        if (nxt < 512) attn_load_kv(U, nxt, tid, kv);
        __syncthreads();
        AMPE(210); AMPB(211);
        const float sink2 = a.sinks[hq] * LOG2E;
#pragma unroll
        for (int qt = 0; qt < 2; ++qt) {
            if (dry && MK_ABL == 2) break;
            const int i0 = 64 * (wave & 1) + 32 * qt, iq = i0 + r32;
            bf16_t* qrow = U + (size_t)(R0 + iq) * UW + C_Q + 64 * hq;
            u32x2 zraw[8];
            { const bf16_t* zrow = U + (size_t)(R0 + iq) * UW + C_ZA + 64 * hq + 4 * hh;
#pragma unroll
              for (int i = 0; i < 8; ++i) zraw[i] = *(const u32x2*)(zrow + 8 * i); }
            bf16x8 qf[4];
            {
                float qv[4][8]; float ss = 0.f;
#pragma unroll
                for (int ks = 0; ks < 4; ++ks) { const u32x4 w = qraw[qt][ks];
                    qv[ks][0] = bflo(w.x); qv[ks][1] = bfhi(w.x); qv[ks][2] = bflo(w.y); qv[ks][3] = bfhi(w.y); qv[ks][4] = bflo(w.z); qv[ks][5] = bfhi(w.z); qv[ks][6] = bflo(w.w); qv[ks][7] = bfhi(w.w);
#pragma unroll
                    for (int i = 0; i < 8; ++i) ss += qv[ks][i] * qv[ks][i]; }
                ss += __shfl_xor(ss, 32);
                const float rs = __builtin_amdgcn_rsqf(ss * (1.f / 64.f) + EPS);
#pragma unroll
                for (int ks = 0; ks < 4; ++ks) { const f32x4 w0 = *(const LAS f32x4*)(qnw + 16 * ks + 8 * hh), w1 = *(const LAS f32x4*)(qnw + 16 * ks + 8 * hh + 4);
                    u32x4 p; p.x = pk2(qv[ks][0] * rs * w0.x, qv[ks][1] * rs * w0.y); p.y = pk2(qv[ks][2] * rs * w0.z, qv[ks][3] * rs * w0.w);
                    p.z = pk2(qv[ks][4] * rs * w1.x, qv[ks][5] * rs * w1.y); p.w = pk2(qv[ks][6] * rs * w1.z, qv[ks][7] * rs * w1.w);
                    qf[ks] = __builtin_bit_cast(bf16x8, p); }
            }
            f32x16 oacc[2];
#pragma unroll
            for (int dt = 0; dt < 2; ++dt)
#pragma unroll
                for (int r = 0; r < 16; ++r) oacc[dt][r] = 0.f;
            float lsum = 0.f;
            const int kk_n = (dry && MK_ABL == 1) ? 0 : 5;
#pragma unroll 1
            for (int kk = 0; kk < kk_n; ++kk) {
                const int j0 = i0 + 32 * kk;
                bf16x8 kfr[4]; u32x2 vfr[2][2][2]; float btv[16];
#pragma unroll
                for (int ks = 0; ks < 4; ++ks) kfr[ks] = *(const LAS bf16x8*)(Kn + (j0 + r32) * 72 + 16 * ks + 8 * hh);
                const LAS float* bt = bias2 + hq * 192 + (32 * kk + 4 * hh - r32 + 32);
#pragma unroll
                for (int r = 0; r < 16; ++r) btv[r] = bt[(r & 3) + 8 * (r >> 2)];
                {   const int i16 = lane & 15, dsub = ((lane >> 4) & 1) * 16;
                    const LAS bf16_t* vb = Vn + (j0 + 4 * hh + (i16 >> 2)) * 72 + dsub + 4 * (i16 & 3);
#pragma unroll
                    for (int s2 = 0; s2 < 2; ++s2)
#pragma unroll
                        for (int dt = 0; dt < 2; ++dt) { vfr[s2][dt][0] = lds_tr16(vb + (16 * s2) * 72 + 32 * dt); vfr[s2][dt][1] = lds_tr16(vb + (16 * s2 + 8) * 72 + 32 * dt); }
                }
                __builtin_amdgcn_sched_barrier(0);
                f32x16 sacc;
#pragma unroll
                for (int r = 0; r < 16; ++r) sacc[r] = 0.f;
#pragma unroll
                for (int ks = 0; ks < 4; ++ks) sacc = mfma32(kfr[ks], qf[ks], sacc);
                float p[16];
#pragma unroll
                for (int r = 0; r < 16; ++r) p[r] = __builtin_amdgcn_exp2f(sacc[r] + btv[r]);
                if (blk == 0) {
#pragma unroll
                    for (int r = 0; r < 16; ++r) if (j0 + (r & 3) + 8 * (r >> 2) + 4 * hh < 128) p[r] = 0.f;
                }
#pragma unroll
                for (int r = 0; r < 16; ++r) lsum += p[r];
                u32x4 pw0, pw1;
                pw0.x = pk2(p[0], p[1]); pw0.y = pk2(p[2], p[3]); pw0.z = pk2(p[4], p[5]); pw0.w = pk2(p[6], p[7]);
                pw1.x = pk2(p[8], p[9]); pw1.y = pk2(p[10], p[11]); pw1.z = pk2(p[12], p[13]); pw1.w = pk2(p[14], p[15]);
                const bf16x8 pf0 = __builtin_bit_cast(bf16x8, pw0), pf1 = __builtin_bit_cast(bf16x8, pw1);
#pragma unroll
                for (int dt = 0; dt < 2; ++dt) {
                    u32x4 a0; a0.x = vfr[0][dt][0].x; a0.y = vfr[0][dt][0].y; a0.z = vfr[0][dt][1].x; a0.w = vfr[0][dt][1].y;
                    u32x4 a1; a1.x = vfr[1][dt][0].x; a1.y = vfr[1][dt][0].y; a1.z = vfr[1][dt][1].x; a1.w = vfr[1][dt][1].y;
                    oacc[dt] = mfma32(__builtin_bit_cast(bf16x8, a0), pf0, oacc[dt]);
                    oacc[dt] = mfma32(__builtin_bit_cast(bf16x8, a1), pf1, oacc[dt]);
                }
            }
            lsum += __shfl_xor(lsum, 32);
            const float rl = __builtin_amdgcn_rcpf(lsum + __builtin_amdgcn_exp2f(sink2 - m2));
#pragma unroll
            for (int dt = 0; dt < 2; ++dt)
#pragma unroll
                for (int g4 = 0; g4 < 4; ++g4) {
                    const u32x2 zz = zraw[4 * dt + g4];
                    u32x2 o; o.x = pk2(oacc[dt][4 * g4] * rl * silu_f(bflo(zz.x)), oacc[dt][4 * g4 + 1] * rl * silu_f(bfhi(zz.x))); o.y = pk2(oacc[dt][4 * g4 + 2] * rl * silu_f(bflo(zz.y)), oacc[dt][4 * g4 + 3] * rl * silu_f(bfhi(zz.y)));
                    if (!dry || o.x == 0x12345678u) *(u32x2*)(qrow + 32 * dt + 8 * g4 + 4 * hh) = o;
                }
        }
        unit = nxt;
        __syncthreads();
        AMPE(211); AMPB(210);
    }
#undef AMPB
#undef AMPE
}
__device__ __forceinline__ float attn_shift(const Args& a, int lane, float& bmax2) {
    float wq = fabsf(a.q_norm_w[lane]), wk = fabsf(a.k_norm_w[lane]);
    float rb = 0.f;
    for (int i = lane; i < 512; i += 64) rb = fmaxf(rb, fabsf(a.rel_table[i]));
    if (lane < 16) rb = fmaxf(rb, fabsf(a.sinks[lane]));
#pragma unroll
    for (int o = 1; o < 64; o <<= 1) { wq = fmaxf(wq, __shfl_xor(wq, o)); wk = fmaxf(wk, __shfl_xor(wk, o)); rb = fmaxf(rb, __shfl_xor(rb, o)); }
    bmax2 = rb * LOG2E;
    return (8.0f * wq * wk + rb) * LOG2E;
}

__device__ __forceinline__ void samp_ssm_item(const Args& a, LAS unsigned char* lds, int item, int tid, int wave, int lane, const bool dry) {
    const int b = item >> 1, g = item & 1;
    const int Rs = MP + 4 * b;
    bf16_t* U = (bf16_t*)(a.ws + WS_U); const float* DT = (const float*)(a.ws + WS_DT);
    LAS float* xs = (LAS float*)lds;
    LAS float* Bs = xs + 2048;
    LAS float* Cs = Bs + 512;
    LAS float* gy = Cs + 512;
    LAS float* dts = gy + 2048;
    LAS float* avs = dts + 32;
    LAS float* rstd_s = avs + 32;
    __syncthreads();
    for (int cc = tid; cc < 768; cc += NT) {
        int ch; LAS float* dst;
        if (cc < 512) { ch = 512 * g + cc; dst = xs + cc; } else if (cc < 640) { ch = 1024 + 128 * g + (cc - 512); dst = Bs + (cc - 512); } else { ch = 1280 + 128 * g + (cc - 640); dst = Cs + (cc - 640); }
        const int stride = (cc < 512) ? 512 : 128;
        const float w0 = a.conv_w[ch], w1 = a.conv_w[CONVD + ch], w2 = a.conv_w[2 * CONVD + ch], w3 = a.conv_w[3 * CONVD + ch], cb = a.conv_b[ch];
        const float* sc = a.state_conv + (size_t)b * 3 * CONVD + ch;
        float f[7]; f[0] = sc[0]; f[1] = sc[CONVD]; f[2] = sc[2 * CONVD];
#pragma unroll
        for (int t = 0; t < 4; ++t) f[3 + t] = bf2f(U[(size_t)(Rs + t) * UW + C_X + ch]);
#pragma unroll
        for (int t = 0; t < 4; ++t) dst[t * stride] = silu_f(cb + w0 * f[t] + w1 * f[t + 1] + w2 * f[t + 2] + w3 * f[t + 3]);
    }
    if (tid < 32) { const int e = tid >> 2, t = tid & 3, h = 8 * g + e; const float d = softplus_f(DT[(size_t)(Rs + t) * 16 + h] + a.dt_bias[h]); dts[tid] = d; avs[tid] = d * (-expf(a.a_log[h])); }
    __syncthreads();
    const int p = tid >> 3, nq = tid & 7;
    f32x4 Sn[4];
    { const float* sp0 = a.state_ssm + ((size_t)(b * 16 + 8 * g) * 64 + p) * 128 + 4 * nq;
#pragma unroll
      for (int i = 0; i < 4; ++i) Sn[i] = __builtin_nontemporal_load((const f32x4*)(sp0 + 32 * i)); }
#pragma unroll 1
    for (int e = 0; e < 8; ++e) {
        const int h = 8 * g + e;
        f32x4 S[4];
#pragma unroll
        for (int i = 0; i < 4; ++i) S[i] = Sn[i];
        if (e < 7) { const float* sp = a.state_ssm + ((size_t)(b * 16 + h + 1) * 64 + p) * 128 + 4 * nq;
#pragma unroll
            for (int i = 0; i < 4; ++i) Sn[i] = __builtin_nontemporal_load((const f32x4*)(sp + 32 * i)); }
        float yv[4];
#pragma unroll
        for (int t = 0; t < 4; ++t) {
            const float dA = __expf(avs[e * 4 + t]); const float coef = dts[e * 4 + t] * xs[t * 512 + 64 * e + p];
            float acc = 0.f;
#pragma unroll
            for (int i = 0; i < 4; ++i) { const f32x4 Bv = *(const LAS f32x4*)(Bs + t * 128 + 4 * nq + 32 * i), Cv = *(const LAS f32x4*)(Cs + t * 128 + 4 * nq + 32 * i);
                S[i] = S[i] * dA + coef * Bv; acc += (Cv.x * S[i].x + Cv.y * S[i].y) + (Cv.z * S[i].z + Cv.w * S[i].w); }
            acc += __shfl_xor(acc, 1); acc += __shfl_xor(acc, 2); acc += __shfl_xor(acc, 4);
            yv[t] = acc;
        }
        float* op = a.out + O_SS + ((size_t)(b * 16 + h) * 64 + p) * 128 + 4 * nq;
#pragma unroll
        for (int i = 0; i < 4; ++i) if (!dry || S[i].x == 12345.678f) __builtin_nontemporal_store(S[i], (f32x4*)(op + 32 * i));
        if (nq < 4) { const int t = nq; const float xv = xs[t * 512 + 64 * e + p];
            const float yt = (nq == 0) ? yv[0] : (nq == 1) ? yv[1] : (nq == 2) ? yv[2] : yv[3];
            const float y = yt + a.d_skip[h] * xv; const float z = bf2f(U[(size_t)(Rs + t) * UW + C_Z + 64 * h + p]);
            gy[t * 512 + 64 * e + p] = y * silu_f(z); }
    }
    __syncthreads();
    if (wave < 4) { float s = 0.f;
#pragma unroll
        for (int i = 0; i < 8; ++i) { const float v = gy[wave * 512 + lane + 64 * i]; s += v * v; }
        s = wave_sum(s); if (lane == 0) rstd_s[wave] = __builtin_amdgcn_rsqf(s * (1.f / 512.f) + EPS); }
    __syncthreads();
    for (int i = tid; i < 2048; i += NT) { const int t = i >> 9, ch = i & 511;
        const unsigned ov = f2bf(gy[i] * rstd_s[t] * a.ssm_norm_w[512 * g + ch]); if (!dry || ov == 0x12345u) U[(size_t)(Rs + t) * UW + C_Z + 512 * g + ch] = (bf16_t)ov; }
}

struct SampAttnRegs { f32x4 k[4], v[4]; unsigned kx, vx, q0, q1; };
__device__ __forceinline__ void samp_attn_load(const Args& a, const bf16_t* U, int item, int tid, int wave, int lane, SampAttnRegs& r) {
    const int b = item >> 2, kvh = item & 3, Rs = MP + 4 * b;
    const int w = tid >> 2, qd = tid & 3;
    const float* kp = a.cache_k + ((size_t)(b * 128 + w) * 4 + kvh) * 64 + 16 * qd; const float* vp = a.cache_v + ((size_t)(b * 128 + w) * 4 + kvh) * 64 + 16 * qd;
#pragma unroll
    for (int i = 0; i < 4; ++i) { r.k[i] = __builtin_nontemporal_load((const f32x4*)(kp + 4 * i)); r.v[i] = __builtin_nontemporal_load((const f32x4*)(vp + 4 * i)); }
    const int t = wave & 3;
    r.kx = U[(size_t)(Rs + t) * UW + C_K + 64 * kvh + lane]; r.vx = U[(size_t)(Rs + t) * UW + C_V + 64 * kvh + lane];
    { const int qi = 2 * wave, gq = qi >> 2, tt = qi & 3; r.q0 = U[(size_t)(Rs + tt) * UW + C_Q + 64 * (4 * kvh + gq) + lane]; }
    { const int qi = 2 * wave + 1, gq = qi >> 2, tt = qi & 3; r.q1 = U[(size_t)(Rs + tt) * UW + C_Q + 64 * (4 * kvh + gq) + lane]; }
}
__device__ __forceinline__ void samp_attn_phase(const Args& a, LAS unsigned char* lds, int bx, int G, int tid, int wave, int lane, const bool dry, float bmax2) {
    bf16_t* U = (bf16_t*)(a.ws + WS_U);
    LAS bf16_t* Kn = (LAS bf16_t*)lds;
    LAS bf16_t* Vn = (LAS bf16_t*)(lds + 23040);
    LAS float* tb = (LAS float*)(lds + 46080);
    LAS f32x4* redo = (LAS f32x4*)(lds + 49152);
    LAS float* redl = (LAS float*)(lds + 69632);
    LAS unsigned* kmx = (LAS unsigned*)(lds + 70912);
    int item = bx; if (item >= 512) return;
    SampAttnRegs rg; samp_attn_load(a, U, item, tid, wave, lane, rg);
    __syncthreads();
    for (int i = tid; i < 28 * 72 / 8; i += NT) { *(LAS u32x4*)(Kn + 132 * 72 + 8 * i) = (u32x4){0u, 0u, 0u, 0u}; *(LAS u32x4*)(Vn + 132 * 72 + 8 * i) = (u32x4){0u, 0u, 0u, 0u}; }
    const int fr = lane & 15, grp = lane >> 4;
    while (item < 512) {
        const int b = item >> 2, kvh = item & 3;
        const int Rs = MP + 4 * b;
        if (tid == 0) kmx[0] = 0u;
        for (int i = tid; i < 4 * 168; i += NT) { const int gq = i / 168, u = (i % 168) - 3, d = 128 - u; tb[i] = (d >= 0 && d <= 128) ? a.rel_table[rel_bucket(d) * 16 + 4 * kvh + gq] * LOG2E : -1e30f; }
        __syncthreads();
        float k2 = 0.f;
        {
            const int w = tid >> 2, qd = tid & 3;
#pragma unroll
            for (int i = 0; i < 4; ++i) k2 += (rg.k[i].x * rg.k[i].x + rg.k[i].y * rg.k[i].y) + (rg.k[i].z * rg.k[i].z + rg.k[i].w * rg.k[i].w);
            u32x4 k0, k1, v0, v1;
            k0.x = pk2(rg.k[0].x, rg.k[0].y); k0.y = pk2(rg.k[0].z, rg.k[0].w); k0.z = pk2(rg.k[1].x, rg.k[1].y); k0.w = pk2(rg.k[1].z, rg.k[1].w);
            k1.x = pk2(rg.k[2].x, rg.k[2].y); k1.y = pk2(rg.k[2].z, rg.k[2].w); k1.z = pk2(rg.k[3].x, rg.k[3].y); k1.w = pk2(rg.k[3].z, rg.k[3].w);
            v0.x = pk2(rg.v[0].x, rg.v[0].y); v0.y = pk2(rg.v[0].z, rg.v[0].w); v0.z = pk2(rg.v[1].x, rg.v[1].y); v0.w = pk2(rg.v[1].z, rg.v[1].w);
            v1.x = pk2(rg.v[2].x, rg.v[2].y); v1.y = pk2(rg.v[2].z, rg.v[2].w); v1.z = pk2(rg.v[3].x, rg.v[3].y); v1.w = pk2(rg.v[3].z, rg.v[3].w);
            *(LAS u32x4*)(Kn + w * 72 + 16 * qd) = k0; *(LAS u32x4*)(Kn + w * 72 + 16 * qd + 8) = k1;
            *(LAS u32x4*)(Vn + w * 72 + 16 * qd) = v0; *(LAS u32x4*)(Vn + w * 72 + 16 * qd + 8) = v1;
            k2 += __shfl_xor(k2, 1); k2 += __shfl_xor(k2, 2);
        }
        if (wave < 4) {
            const int t = wave;
            const float kx = bf2f(rg.kx), vx = bf2f(rg.vx);
            const float ss = wave_sum(kx * kx); const float kn = kx * __builtin_amdgcn_rsqf(ss * (1.f / 64.f) + EPS) * a.k_norm_w[lane];
            Kn[(128 + t) * 72 + lane] = (bf16_t)f2bf(kn); Vn[(128 + t) * 72 + lane] = (bf16_t)rg.vx;
            k2 = fmaxf(k2, wave_sum(kn * kn));
            if (!dry) { a.out[O_KS + ((size_t)(b * 128 + 124 + t) * 4 + kvh) * 64 + lane] = kn; a.out[O_VS + ((size_t)(b * 128 + 124 + t) * 4 + kvh) * 64 + lane] = vx; }
        }
#pragma unroll
        for (int o = 1; o < 64; o <<= 1) k2 = fmaxf(k2, __shfl_xor(k2, o));
        if (lane == 0) (void)__hip_atomic_fetch_max(kmx, __builtin_bit_cast(unsigned, k2), __ATOMIC_RELAXED, __HIP_MEMORY_SCOPE_WORKGROUP);
        bf16x8 qf[2]; float qn2 = 0.f;
        const int tq = fr & 3, hq = 4 * kvh + (fr >> 2);
        if (wave < 5) {
            const bf16_t* qrow = U + (size_t)(Rs + tq) * UW + C_Q + 64 * hq + 8 * grp;
            const u32x4 w0 = *(const u32x4*)(qrow), w1 = *(const u32x4*)(qrow + 32);
            float qv[16] = {bflo(w0.x), bfhi(w0.x), bflo(w0.y), bfhi(w0.y), bflo(w0.z), bfhi(w0.z), bflo(w0.w), bfhi(w0.w),
                            bflo(w1.x), bfhi(w1.x), bflo(w1.y), bfhi(w1.y), bflo(w1.z), bfhi(w1.z), bflo(w1.w), bfhi(w1.w)};
            float ss = 0.f;
#pragma unroll
            for (int i = 0; i < 16; ++i) ss += qv[i] * qv[i];
            ss += __shfl_xor(ss, 16); ss += __shfl_xor(ss, 32);
            const float rs = (0.125f * LOG2E) * __builtin_amdgcn_rsqf(ss * (1.f / 64.f) + EPS);
#pragma unroll
            for (int i = 0; i < 16; ++i) { qv[i] *= rs * a.q_norm_w[(i < 8 ? 0 : 32) + 8 * grp + (i & 7)]; qn2 += qv[i] * qv[i]; }
            qn2 += __shfl_xor(qn2, 16); qn2 += __shfl_xor(qn2, 32);
            u32x4 p0, p1;
            p0.x = pk2(qv[0], qv[1]); p0.y = pk2(qv[2], qv[3]); p0.z = pk2(qv[4], qv[5]); p0.w = pk2(qv[6], qv[7]);
            p1.x = pk2(qv[8], qv[9]); p1.y = pk2(qv[10], qv[11]); p1.z = pk2(qv[12], qv[13]); p1.w = pk2(qv[14], qv[15]);
            qf[0] = __builtin_bit_cast(bf16x8, p0); qf[1] = __builtin_bit_cast(bf16x8, p1);
        }
        const int nxt = item + G;
        if (nxt < 512) samp_attn_load(a, U, nxt, tid, wave, lane, rg);
        __syncthreads();
        const float mq = sqrtf(qn2 * __builtin_bit_cast(float, kmx[0])) + bmax2;
        if (wave < 5) {
            const int j0 = 32 * wave;
            bf16x8 kfr[2][2]; u32x2 vlo[4], vhi[4]; float btv[8];
#pragma unroll
            for (int ks = 0; ks < 2; ++ks) { kfr[0][ks] = *(const LAS bf16x8*)(Kn + (j0 + fr) * 72 + 32 * ks + 8 * grp); kfr[1][ks] = *(const LAS bf16x8*)(Kn + (j0 + 16 + fr) * 72 + 32 * ks + 8 * grp); }
            const LAS float* bt = tb + (fr >> 2) * 168 + (j0 + 4 * grp - tq + 3);
#pragma unroll
            for (int r = 0; r < 4; ++r) { btv[r] = bt[r]; btv[4 + r] = bt[16 + r]; }
#pragma unroll
            for (int dt = 0; dt < 4; ++dt) { vlo[dt] = lds_tr16(Vn + (j0 + 4 * grp + (fr >> 2)) * 72 + 16 * dt + 4 * (fr & 3)); vhi[dt] = lds_tr16(Vn + (j0 + 16 + 4 * grp + (fr >> 2)) * 72 + 16 * dt + 4 * (fr & 3)); }
            __builtin_amdgcn_sched_barrier(0);
            f32x4 s0 = (f32x4){0.f, 0.f, 0.f, 0.f}, s1 = (f32x4){0.f, 0.f, 0.f, 0.f};
#pragma unroll
            for (int ks = 0; ks < 2; ++ks) { s0 = mfma16(kfr[0][ks], qf[ks], s0); s1 = mfma16(kfr[1][ks], qf[ks], s1); }
            float p[8]; float lsum = 0.f;
#pragma unroll
            for (int r = 0; r < 4; ++r) { p[r] = __builtin_amdgcn_exp2f(s0[r] + btv[r] - mq); p[4 + r] = __builtin_amdgcn_exp2f(s1[r] + btv[4 + r] - mq); }
#pragma unroll
            for (int r = 0; r < 8; ++r) lsum += p[r];
            u32x4 pw; pw.x = pk2(p[0], p[1]); pw.y = pk2(p[2], p[3]); pw.z = pk2(p[4], p[5]); pw.w = pk2(p[6], p[7]);
            const bf16x8 pf = __builtin_bit_cast(bf16x8, pw);
#pragma unroll
            for (int dt = 0; dt < 4; ++dt) {
                u32x4 aw; aw.x = vlo[dt].x; aw.y = vlo[dt].y; aw.z = vhi[dt].x; aw.w = vhi[dt].y;
                redo[(wave * 4 + dt) * 64 + lane] = mfma16(__builtin_bit_cast(bf16x8, aw), pf, (f32x4){0.f, 0.f, 0.f, 0.f});
            }
            redl[wave * 64 + lane] = lsum;
        }
        __syncthreads();
        if (wave < 4) {
            const int dt = wave;
            f32x4 o = redo[(0 * 4 + dt) * 64 + lane]; float l = redl[lane];
#pragma unroll
            for (int k5 = 1; k5 < 5; ++k5) { o += redo[(k5 * 4 + dt) * 64 + lane]; l += redl[k5 * 64 + lane]; }
            l += __shfl_xor(l, 16); l += __shfl_xor(l, 32);
            const float rl = __builtin_amdgcn_rcpf(l + __builtin_amdgcn_exp2f(a.sinks[hq] * LOG2E - mq));
            const u32x2 zz = *(const u32x2*)(U + (size_t)(Rs + tq) * UW + C_ZA + 64 * hq + 16 * dt + 4 * grp);
            u32x2 ov; ov.x = pk2(o[0] * rl * silu_f(bflo(zz.x)), o[1] * rl * silu_f(bfhi(zz.x))); ov.y = pk2(o[2] * rl * silu_f(bflo(zz.y)), o[3] * rl * silu_f(bfhi(zz.y)));
            if (!dry || ov.x == 0x12345678u) *(u32x2*)(U + (size_t)(Rs + tq) * UW + C_Q + 64 * hq + 16 * dt + 4 * grp) = ov;
        }
        item = nxt;
    }
}
__device__ __forceinline__ void cache_shift_copy(const Args& a, int it, int tid) {
    const int b = it >> 1; const float* src = (it & 1) ? a.cache_v : a.cache_k; float* dst = a.out + ((it & 1) ? O_VS : O_KS);
    const f32x4* s4 = (const f32x4*)(src + (size_t)(b * 128 + 4) * 256); f32x4* d4 = (f32x4*)(dst + (size_t)(b * 128) * 256);
#pragma unroll 8
    for (int i = tid; i < 124 * 64; i += NT) __builtin_nontemporal_store(__builtin_nontemporal_load(s4 + i), d4 + i);
}

__device__ __forceinline__ void conv_out_item(const Args& a, int item, int tid) {
    const bf16_t* U = (const bf16_t*)(a.ws + WS_U);
    for (int i = tid; i < 3 * CONVD; i += NT) {
        const int r = i / CONVD, ch = i % CONVD;
        if (item < NB) a.out[O_CP + (size_t)item * 3 * CONVD + i] = bf2f(((const bf16_t*)(a.ws + WS_HALO))[(size_t)((item * 64 + 63) * 3 + r) * CONVD + ch]);
        else { const int b = item - NB; a.out[O_CS + (size_t)b * 3 * CONVD + i] = bf2f(U[(size_t)(MP + 4 * b + 1 + r) * UW + C_X + ch]); }
    }
}

__device__ __forceinline__ void samp_outproj_tile(const Args& a, LAS unsigned char* lds, int it, int tid, int wave, int lane) {
    const bf16_t* U = (const bf16_t*)(a.ws + WS_U); const bf16_t* Wt = (const bf16_t*)(a.ws + WS_WOUT);
    LAS bf16_t* T = (LAS bf16_t*)lds;
    LAS f32x4* red = (LAS f32x4*)(lds + 131584);
    const int r0 = 32 * (it >> 4), c0 = 64 * (it & 15);
    const int fr = lane & 15, grp = lane >> 4, kh = wave >> 2, cg = wave & 3;
    __syncthreads();
    {   u32x4 tv[16];
#pragma unroll
        for (int i = 0; i < 16; ++i) { const int ci = tid + NT * i, row = ci >> 8, k = 8 * (ci & 255);
            tv[i] = *(const u32x4*)(U + (size_t)(MP + r0 + row) * UW + (k < 1024 ? C_Z + k : C_Q + (k - 1024))); }
#pragma unroll
        for (int i = 0; i < 16; ++i) { const int ci = tid + NT * i, row = ci >> 8, k = 8 * (ci & 255); *(LAS u32x4*)(T + row * 2056 + k) = tv[i]; }
    }
    const bf16_t* wp = Wt + (size_t)(c0 + 16 * cg + fr) * 2048 + 1024 * kh + 8 * grp;
    const LAS bf16_t* tp = T + fr * 2056 + 1024 * kh + 8 * grp;
    f32x4 acc0 = (f32x4){0.f, 0.f, 0.f, 0.f}, acc1 = (f32x4){0.f, 0.f, 0.f, 0.f};
    bf16x8 wf[8];
#pragma unroll
    for (int i = 0; i < 8; ++i) wf[i] = *(const bf16x8*)(wp + 32 * i);
    __syncthreads();
#pragma unroll
    for (int kb = 0; kb < 4; ++kb) {
        bf16x8 wc[8];
#pragma unroll
        for (int i = 0; i < 8; ++i) wc[i] = wf[i];
        if (kb < 3) {
#pragma unroll
            for (int i = 0; i < 8; ++i) wf[i] = *(const bf16x8*)(wp + 32 * (8 * (kb + 1) + i)); }
#pragma unroll
        for (int i = 0; i < 8; ++i) { const int ks = 8 * kb + i;
            const bf16x8 t0 = *(const LAS bf16x8*)(tp + 32 * ks), t1 = *(const LAS bf16x8*)(tp + 16 * 2056 + 32 * ks);
            acc0 = mfma16(wc[i], t0, acc0); acc1 = mfma16(wc[i], t1, acc1); }
    }
    if (kh) { red[(cg * 2 + 0) * 64 + lane] = acc0; red[(cg * 2 + 1) * 64 + lane] = acc1; }
    __syncthreads();
    if (!kh) {
        acc0 += red[(cg * 2 + 0) * 64 + lane]; acc1 += red[(cg * 2 + 1) * 64 + lane];
        const size_t o0 = (size_t)(r0 + fr) * DM + c0 + 16 * cg + 4 * grp, o1 = o0 + (size_t)16 * DM;
        *(f32x4*)(a.out + O_YS + o0) = *(const f32x4*)(a.x_sample + o0) + acc0;
        *(f32x4*)(a.out + O_YS + o1) = *(const f32x4*)(a.x_sample + o1) + acc1;
    }
}

__global__ void __launch_bounds__(NT, 2) mk_fwd(Args args) {
    extern __shared__ __attribute__((aligned(16))) unsigned char lds_raw[];
    LAS unsigned char* lds = (LAS unsigned char*)lds_raw;
    volatile LAS unsigned* MISC = (volatile LAS unsigned*)(lds + MISC_OFF);
    const int tid = threadIdx.x, lane = tid & 63, wave = __builtin_amdgcn_readfirstlane(tid >> 6);
    const int G = gridDim.x; const int bx = blockIdx.x; const int vcu = (G % 8 == 0) ? (bx % 8) * (G / 8) + bx / 8 : bx;
    gu32* ctl = (gu32*)(args.ws + WS_CTL);
    for (int u = tid; u < 512 / 4; u += NT) ((LAS unsigned*)(lds + MISC_OFF))[u] = 0u;
    __syncthreads();
    XcdBarrier bar; bar.bar = (unsigned*)(ctl + CW_BAR); bar.x = 0; bar.st = nullptr;
    if (MK_N_LAUNCHES == 1) bar = xcd_barrier_post((unsigned*)(ctl + CW_BAR), MISC + 8);
    const int lo = args.ph_lo, hi = args.ph_hi;
#define IN(k) (lo <= (k) && (k) < hi)
#define GRID_BAR() do { if (MK_N_LAUNCHES == 1) xcd_barrier(bar); } while (0)

    const bool dry = (args.dry != 0);
    unsigned long long amp_t = 0ull, amp_d = 0ull;
#define AMP_BEGIN(k) do { if (MK_AMP == (k)) amp_t = __builtin_amdgcn_s_memrealtime(); } while (0)
#define AMP_END(k) do { if (MK_AMP == (k)) amp_d += __builtin_amdgcn_s_memrealtime() - amp_t; } while (0)
    AMP_BEGIN(0);
    if (IN(0)) { p0_prologue(args, lds, vcu, G, wave, lane, amp_d); AMP_BEGIN(102); GRID_BAR(); AMP_END(102); }
    AMP_END(0);

    AMP_BEGIN(1);
    if (IN(1)) {
        pg8::Gemm g{(const bf16_t*)(args.ws + WS_H), (const bf16_t*)(args.ws + WS_WIN), MT, NINP, DM, DM, 1 << 20, 0};
        pg8::StaticOrder S; S.init(MT, NINP, G, bx);
        pg8::EpiU E{(bf16_t*)(args.ws + WS_U), (float*)(args.ws + WS_DT), (bf16_t*)(args.ws + WS_HALO)};
        pg8::gemm_phase<pg8::EpiU, pg8::StaticOrder, true>(lds, g, S, E);
        for (int it = bx; it < 2 * DB; it += G) cache_shift_copy(args, it, tid);
        GRID_BAR();
    }
    AMP_END(1);

    AMP_BEGIN(2);
    if (IN(2)) {
        float bmax2; const float m2 = attn_shift(args, lane, bmax2);
        const int sub = args.sub;
#define P2_PROMPT() do { AMP_BEGIN(20); if (sub & 1) for (int it = bx; it < 256; it += G) ssd_state_item(args, lds, it, tid, wave, lane); AMP_END(20); \
        AMP_BEGIN(21); if (sub & 2) attn_phase(args, lds, bx, G, tid, wave, lane, m2, dry, amp_d); AMP_END(21); } while (0)
#define P2_SAMPLE() do { AMP_BEGIN(22); if (sub & 4) for (int it = bx; it < 256; it += G) samp_ssm_item(args, lds, it, tid, wave, lane, dry); AMP_END(22); \
        AMP_BEGIN(23); if (sub & 8) samp_attn_phase(args, lds, bx, G, tid, wave, lane, dry, bmax2); AMP_END(23); } while (0)
        if (bx & 1) { P2_SAMPLE(); P2_PROMPT(); } else { P2_PROMPT(); P2_SAMPLE(); }
#undef P2_PROMPT
#undef P2_SAMPLE
        if (sub & 16) for (int it = bx; it < NB + DB; it += G) conv_out_item(args, it, tid);
        if (MK_AMP == 200) { const bool dr = (args.ph_hi < 1000); __syncthreads(); AMP_BEGIN(200); for (int it = bx; it < 256; it += G) ssd_state_item(args, lds, it, tid, wave, lane, dr); AMP_END(200); }
        if (MK_AMP == 212) { const bool dr = (args.ph_hi < 1000); __syncthreads(); AMP_BEGIN(212); attn_phase(args, lds, bx, G, tid, wave, lane, m2, dr, amp_d); AMP_END(212); }
        AMP_BEGIN(24); GRID_BAR(); AMP_END(24);
    }
    AMP_END(2);

    AMP_BEGIN(3);
    if (IN(3)) { ssd_scan(args, lds, bx, G, tid, wave, lane, dry); GRID_BAR(); }
    AMP_END(3);

    AMP_BEGIN(4);
    if (IN(4)) {
        for (int it = bx; it < 256; it += G) ssd_out_item(args, lds, it, tid, wave, lane, dry);
        if (MK_AMP == 400) { const bool dr = (args.ph_hi < 1000); __syncthreads(); AMP_BEGIN(400); for (int it = bx; it < 256; it += G) ssd_out_item(args, lds, it, tid, wave, lane, dr); AMP_END(400); }
        GRID_BAR();
    }
    AMP_END(4);

    AMP_BEGIN(5);
    if (IN(5)) {
        pg8::Gemm g{(const bf16_t*)(args.ws + WS_U), (const bf16_t*)(args.ws + WS_WOUT), MP, DM, 2048, UW, 16, (size_t)(C_Q - 1024) * 2};
        pg8::StaticOrder S; S.init(MP, DM, G, bx);
        pg8::EpiOut E{args.x_prompt, args.x_sample, args.out};
        if (bx & 1) { for (int it = bx; it < 256; it += G) samp_outproj_tile(args, lds, it, tid, wave, lane); __syncthreads(); }
        pg8::gemm_phase<pg8::EpiOut, pg8::StaticOrder, true>(lds, g, S, E);
        if (!(bx & 1)) { for (int it = bx; it < 256; it += G) samp_outproj_tile(args, lds, it, tid, wave, lane); }
    }
    AMP_END(5);
    if (MK_AMP >= 0 && bx == 0 && tid == 0) {
        const unsigned long long t0 = __builtin_amdgcn_s_memrealtime();
        while (__builtin_amdgcn_s_memrealtime() - t0 < 4ull * amp_d) __builtin_amdgcn_s_sleep(8);
    }
#undef AMP_BEGIN
#undef AMP_END
#undef IN
#undef GRID_BAR
}

extern "C" void kernel_launch(void* const* d_in, const int* in_sizes, int n_in, void* d_out, int out_size, void* d_ws, size_t ws_size, hipStream_t stream) {
    static int grid = 0;
    if (grid == 0) {
        if (n_in != 19 || (size_t)out_size != O_END || ws_size < WS_END) { fprintf(stderr, "kernel_launch: unexpected shapes (n_in %d, out %d, ws %zu)\n", n_in, out_size, ws_size); grid = -1; return; }
        int dev = 0, cus = 0;
        if (hipGetDevice(&dev) != hipSuccess || hipDeviceGetAttribute(&cus, hipDeviceAttributeMultiprocessorCount, dev) != hipSuccess) { grid = -1; return; }
        if (hipFuncSetAttribute((const void*)mk_fwd, hipFuncAttributeMaxDynamicSharedMemorySize, LDS_BYTES) != hipSuccess) { fprintf(stderr, "kernel_launch: hipFuncSetAttribute failed\n"); grid = -1; return; }
        int per_cu = 0;
        if (hipOccupancyMaxActiveBlocksPerMultiprocessor(&per_cu, (const void*)mk_fwd, NT, LDS_BYTES) != hipSuccess || per_cu < 1) fprintf(stderr, "kernel_launch: occupancy query reports %d blocks per CU\n", per_cu);
        (void)hipGetLastError();
        grid = cus;
    }
    if (grid < 0) return;
    (void)hipMemsetAsync((char*)d_ws + WS_CTL, 0, CTL_ZERO_BYTES, stream);
    Args a{};
    const float** ap = (const float**)&a;
    for (int i = 0; i < 19; ++i) ap[i] = (const float*)d_in[i];
    a.out = (float*)d_out; a.ws = (unsigned char*)d_ws;
    a.sub = 31; a.dry = 0;
    if (MK_N_LAUNCHES == 1) { a.ph_lo = 0; a.ph_hi = 6; hipLaunchKernelGGL(mk_fwd, dim3(grid), dim3(NT), LDS_BYTES, stream, a); }
    else for (int ph = 0; ph < 6; ++ph) {
        a.ph_lo = ph; a.ph_hi = ph + 1; a.sub = 31; a.dry = 0;
        hipLaunchKernelGGL(mk_fwd, dim3(grid), dim3(NT), LDS_BYTES, stream, a);
        if (MK_DUP == ph) { a.dry = 1; hipLaunchKernelGGL(mk_fwd, dim3(grid), dim3(NT), LDS_BYTES, stream, a); }
        if (ph == 2 && MK_DUP >= 20 && MK_DUP < 24) { a.sub = 1 << (MK_DUP - 20); a.dry = 1; hipLaunchKernelGGL(mk_fwd, dim3(grid), dim3(NT), LDS_BYTES, stream, a); }
    }
}
```

```cpp
#include <hip/hip_runtime.h>
#include <cstdio>
#include <cstdint>

#ifndef MK_N_LAUNCHES
#define MK_N_LAUNCHES 1
#endif

#ifndef MK_AMP
#define MK_AMP (-1)
#endif
#ifndef MK_ABL
#define MK_ABL 0
#endif
#ifndef MK_DUP
#define MK_DUP (-1)
#endif
#define LAS __attribute__((address_space(3)))
#define GAS __attribute__((address_space(1)))
typedef unsigned short bf16_t;
typedef short bf16x8 __attribute__((ext_vector_type(8)));
typedef short bf16x4 __attribute__((ext_vector_type(4)));
typedef float f32x4 __attribute__((ext_vector_type(4)));
typedef float f32x2 __attribute__((ext_vector_type(2)));
typedef unsigned u32x4 __attribute__((ext_vector_type(4)));
typedef unsigned u32x2 __attribute__((ext_vector_type(2)));

constexpr int DM = 1024, SEQ = 8192, NB = 2, MP = NB * SEQ;
constexpr int DB = 128, DL = 4, MS = DB * DL, MT = MP + MS;
constexpr int NIN = 5136, NINP = 5376;
constexpr int UW = 5120;
constexpr int C_Z = 0, C_X = 1024, C_B = 2048, C_C = 2304, C_Q = 2560, C_K = 3584, C_V = 3840, C_ZA = 4096;
constexpr int CONVD = 1536;
constexpr float EPS = 1e-6f;
constexpr float LOG2E = 1.4426950408889634f;

constexpr size_t MiB = 1u << 20;
constexpr size_t WS_CTL = 0, CTL_ZERO_BYTES = 32768;
constexpr size_t WS_WIN = 1 * MiB;
constexpr size_t WS_WOUT = 12 * MiB;
constexpr size_t WS_DT = 16 * MiB;
constexpr size_t WS_DEC = 17 * MiB + 512 * 1024;
constexpr size_t WS_U = 18 * MiB;
constexpr size_t WS_H = 183 * MiB;
constexpr size_t WS_ST = 183 * MiB;
constexpr size_t WS_HALO = 247 * MiB;
constexpr size_t WS_DTA = 249 * MiB;
constexpr size_t WS_END = 251 * MiB;
constexpr int CW_BAR = 4096;

constexpr size_t O_YP = 0, O_YS = 16777216, O_KP = 17301504, O_VP = 17367040, O_SP = 17432576, O_CP = 17694720,
                 O_KS = 17703936, O_VS = 21898240, O_SS = 26092544, O_CS = 42869760, O_END = 43459584;

typedef __bf16 hwbf16x2 __attribute__((ext_vector_type(2)));
__device__ __forceinline__ unsigned pk2(float lo, float hi) { const f32x2 v = {lo, hi}; return __builtin_bit_cast(unsigned, __builtin_convertvector(v, hwbf16x2)); }
__device__ __forceinline__ unsigned f2bf(float f) { return pk2(f, 0.f) & 0xffffu; }
__device__ __forceinline__ float bf2f(unsigned v) { return __builtin_bit_cast(float, v << 16); }
__device__ __forceinline__ float bflo(unsigned w) { return __builtin_bit_cast(float, w << 16); }
__device__ __forceinline__ float bfhi(unsigned w) { return __builtin_bit_cast(float, w & 0xffff0000u); }
__device__ __forceinline__ float silu_f(float x) { return x * __builtin_amdgcn_rcpf(1.0f + __expf(-x)); }
__device__ __forceinline__ float softplus_f(float x) { return fmaxf(x, 0.f) + log1pf(__expf(-fabsf(x))); }
__device__ __forceinline__ float wave_sum(float v) {
#pragma unroll
    for (int o = 1; o < 64; o <<= 1) v += __shfl_xor(v, o);
    return v;
}
__device__ __forceinline__ f32x4 mfma16(bf16x8 a, bf16x8 b, f32x4 c) { return __builtin_amdgcn_mfma_f32_16x16x32_bf16(a, b, c, 0, 0, 0); }
#define LDS_WAIT() asm volatile("s_waitcnt lgkmcnt(0)" ::: "memory")
#define VM_WAIT() asm volatile("s_waitcnt vmcnt(0)" ::: "memory")

namespace pg8 {
constexpr int BM = 256, BK = 64, HALF = 128, HTB = HALF * BK * 2, STAGE_BYTES = 8 * HTB, NXCD = 8, WGM = 11;
__host__ __device__ __forceinline__ int lds_byte(int r, int c) { const int st = (r >> 4) * 2 + (c >> 5), rr = r & 15, cc = c & 31, ob = rr * 64 + cc * 2; return st * 1024 + (ob ^ (((ob >> 9) & 1) << 5)); }
__host__ __device__ __forceinline__ void stage_rc(int b, int& R, int& C) { const int st = b / 1024, sb = b % 1024, swz = sb ^ (((sb >> 9) & 1) << 5); R = (st >> 1) * 16 + swz / 64; C = (st & 1) * 32 + (swz % 64) / 2; }
__host__ __device__ __forceinline__ int perm32(int rho) { const int n = rho >> 4, i = rho & 15; return 8 * (i >> 2) + 4 * n + (i & 3); }

struct Unit { int pm, pn; };
struct Gemm { const bf16_t* A; const bf16_t* Bt; int M, N, K, lda, kseg; size_t segskip; };

struct StaticOrder {
    int nM, nN, nwg, G, c;
    __host__ __device__ void init(int M, int N, int G_, int c_) { nM = M / BM; nN = N / BM; nwg = nM * nN; G = G_; c = c_; }
    __host__ __device__ bool next(int i, Unit& u) const {
        const long L = (long)i * G + c; if (L >= nwg) return false;
        int wgid = (int)L; { const int q = nwg / NXCD, r = nwg % NXCD, xcd = wgid % NXCD, off = wgid / NXCD; wgid = (xcd < r ? xcd * (q + 1) : r * (q + 1) + (xcd - r) * q) + off; }
        const int nig = WGM * nN, gid = wgid / nig, fm = gid * WGM, gsz = (nM - fm) < WGM ? (nM - fm) : WGM;
        u.pm = fm + ((wgid % nig) % gsz); u.pn = (wgid % nig) / gsz; return true;
    }
};

__device__ __forceinline__ unsigned cvt_pk_bf16(float lo, float hi) { unsigned r; asm volatile("v_cvt_pk_bf16_f32 %0, %1, %2" : "=v"(r) : "v"(lo), "v"(hi)); return r; }

struct EpiU {
    static constexpr bool PERM = true;
    bf16_t* U; float* DT; bf16_t* HALO;
    __device__ __forceinline__ void operator()(const f32x4 (&acc)[2][2][4][2], const Unit& u, int wr, int wc, int fr, int fq) const {
        const int row0 = u.pm * BM + wr * 64 + fr;
        if (u.pn < 20) {
            const bool halo = (u.pn >= 4) && (u.pn < 10) && (u.pm < MP / BM) && (wr == 1) && (fr >= 13);
            const int col0 = u.pn * BM + wc * 32 + 8 * fq;
#pragma unroll
            for (int ai = 0; ai < 2; ++ai)
#pragma unroll
                for (int m = 0; m < 4; ++m) { bf16_t* rowp = U + (size_t)(row0 + ai * HALF + m * 16) * UW + col0;
#pragma unroll
                    for (int bj = 0; bj < 2; ++bj) { const f32x4 v0 = acc[ai][bj][m][0], v1 = acc[ai][bj][m][1];
                        u32x4 w; w.x = cvt_pk_bf16(v0[0], v0[1]); w.y = cvt_pk_bf16(v0[2], v0[3]); w.z = cvt_pk_bf16(v1[0], v1[1]); w.w = cvt_pk_bf16(v1[2], v1[3]);
                        *(u32x4*)(rowp + bj * HALF) = w;
                        if (m == 3 && halo) *(u32x4*)(HALO + (size_t)((u.pm * 2 + ai) * 3 + (fr - 13)) * CONVD + (col0 - C_X) + bj * HALF) = w; } }
        } else if (wc == 0 && fq < 2) {
#pragma unroll
            for (int ai = 0; ai < 2; ++ai)
#pragma unroll
                for (int m = 0; m < 4; ++m) { float* rowp = DT + (size_t)(row0 + ai * HALF + m * 16) * 16 + 8 * fq;
                    *(f32x4*)(rowp) = acc[ai][0][m][0]; *(f32x4*)(rowp + 4) = acc[ai][0][m][1]; }
        }
    }
};
struct EpiOut {
    static constexpr bool PERM = false;
    const float* xp; const float* xs; float* out;
    __device__ __forceinline__ void operator()(const f32x4 (&acc)[2][2][4][2], const Unit& u, int wr, int wc, int fr, int fq) const {
        const int col0 = u.pn * BM + wc * 32 + 4 * fq;
#pragma unroll
        for (int ai = 0; ai < 2; ++ai)
#pragma unroll
            for (int m = 0; m < 4; ++m) { const int row = u.pm * BM + ai * HALF + wr * 64 + m * 16 + fr;
                const float* xb = (row < MP) ? xp + (size_t)row * DM : xs + (size_t)(row - MP) * DM; float* ob = out + (size_t)row * DM;
#pragma unroll
                for (int bj = 0; bj < 2; ++bj)
#pragma unroll
                    for (int n = 0; n < 2; ++n) { const int c = col0 + bj * HALF + n * 16; const f32x4 xv = __builtin_nontemporal_load((const f32x4*)(xb + c)); __builtin_nontemporal_store(xv + acc[ai][bj][m][n], (f32x4*)(ob + c)); } }
    }
};

template <class Epi, class Sched, bool ALIGN_EPI>
__device__ __forceinline__ void gemm_phase(LAS unsigned char* lds, const Gemm g, const Sched& S, const Epi& E) {
    const int tid = threadIdx.x, wid = __builtin_amdgcn_readfirstlane(tid >> 6), lane = tid & 63, wr = wid >> 2, wc = wid & 3, fr = lane & 15, fq = lane >> 4;
    const int K = g.K, nt = K / BK, lda = g.lda, kseg = g.kseg;
    unsigned voffA[2], voffB[2];
#pragma unroll
    for (int i = 0; i < 2; ++i) { int R, C; stage_rc(tid * 16 + i * 8192, R, C); const int Rb = Epi::PERM ? ((R & ~31) + perm32(R & 31)) : R;
        voffA[i] = (unsigned)(R * lda + C) * 2u; voffB[i] = (unsigned)(Rb * K + C) * 2u; }
    const size_t kstep = (size_t)(BK * 2);
    const size_t hstepA = (size_t)HALF * lda * 2, tstepA = 2 * hstepA;
    const size_t hstepB = (size_t)HALF * K * 2, tstepB = 2 * hstepB;
    const size_t segskip = g.segskip;
#define KOFFA(t) ((size_t)(t) * kstep + (((t) >= kseg) ? segskip : (size_t)0))
    const unsigned ldsw = (unsigned)wid * 1024u;
    const int aoff = lds_byte(wr * 64 + fr, fq * 8), boff = lds_byte(wc * 32 + fr, fq * 8);
#define PG8_SA(b, h) (((b) * 2 + (h)) * HTB)
#define PG8_SB(b, h) ((4 + (b) * 2 + (h)) * HTB)
#define PG8_STAGE(bufoff, gbase, voff) do { _Pragma("unroll") for (int _i = 0; _i < 2; ++_i) \
        __builtin_amdgcn_global_load_lds((const unsigned*)((const char*)(gbase) + (voff)[_i]), (LAS unsigned*)(lds + (bufoff) + ldsw + _i * 8192), 16, 0, 0); } while (0)
#define PG8_LDA(dst, b, h) do { _Pragma("unroll") for (int m = 0; m < 4; ++m) _Pragma("unroll") for (int k = 0; k < 2; ++k) dst[m][k] = *(const LAS bf16x8*)(lds + PG8_SA(b, h) + aoff + m * 2048 + k * 1024); } while (0)
#define PG8_LDB(dst, b, h) do { _Pragma("unroll") for (int n = 0; n < 2; ++n) _Pragma("unroll") for (int k = 0; k < 2; ++k) dst[n][k] = *(const LAS bf16x8*)(lds + PG8_SB(b, h) + boff + n * 2048 + k * 1024); } while (0)
#define PG8_MMA(ai, bj, At, Bt) do { __builtin_amdgcn_s_setprio(1); _Pragma("unroll") for (int m = 0; m < 4; ++m) _Pragma("unroll") for (int n = 0; n < 2; ++n) _Pragma("unroll") for (int k = 0; k < 2; ++k) \
        acc[ai][bj][m][n] = __builtin_amdgcn_mfma_f32_16x16x32_bf16(Bt[n][k], At[m][k], acc[ai][bj][m][n], 0, 0, 0); __builtin_amdgcn_s_setprio(0); } while (0)
#define PG8_WAIT_V(n) asm volatile("s_waitcnt vmcnt(" #n ")" ::: "memory")
#define PG8_WAIT_L(n) asm volatile("s_waitcnt lgkmcnt(" #n ")" ::: "memory")
#define PG8_BAR __builtin_amdgcn_s_barrier()
#define PG8_SCHED __builtin_amdgcn_sched_barrier(0)
    Unit cur, nxt; int ui = 0;
    if (!S.next(0, cur)) return;
    f32x4 acc[2][2][4][2];
#pragma unroll
    for (int a = 0; a < 2; ++a)
#pragma unroll
        for (int b = 0; b < 2; ++b)
#pragma unroll
            for (int m = 0; m < 4; ++m)
#pragma unroll
                for (int n = 0; n < 2; ++n) acc[a][b][m][n] = (f32x4){0.f, 0.f, 0.f, 0.f};
    bf16x8 At[4][2], B0[2][2], B1[2][2];
    const char* cA = (const char*)g.A + (size_t)cur.pm * tstepA; const char* cB = (const char*)g.Bt + (size_t)cur.pn * tstepB;
    PG8_STAGE(PG8_SB(0, 0), cB, voffB); PG8_STAGE(PG8_SB(0, 1), cB + hstepB, voffB); PG8_STAGE(PG8_SA(0, 0), cA, voffA); PG8_STAGE(PG8_SA(0, 1), cA + hstepA, voffA);
    if (wr == 1) PG8_BAR;
    PG8_WAIT_V(2); PG8_BAR;
    PG8_STAGE(PG8_SB(1, 0), cB + kstep, voffB); PG8_STAGE(PG8_SA(1, 0), cA + KOFFA(1), voffA); PG8_STAGE(PG8_SB(1, 1), cB + hstepB + kstep, voffB);
    PG8_WAIT_V(6); PG8_BAR;
    for (;;) {
        const bool has_next = S.next(ui + 1, nxt);
        const char* nA = has_next ? (const char*)g.A + (size_t)nxt.pm * tstepA : cA; const char* nB = has_next ? (const char*)g.Bt + (size_t)nxt.pn * tstepB : cB;
        for (int t = 0; t < nt; t += 2) {
            const bool last = (t == nt - 2);
            const char* a1 = cA + KOFFA(t + 1);
            const char* a2 = last ? nA : cA + KOFFA(t + 2); const char* b2 = last ? nB : cB + (size_t)(t + 2) * kstep;
            const char* a3 = last ? nA + KOFFA(1) : cA + KOFFA(t + 3); const char* b3 = b2 + kstep;
            PG8_LDB(B0, 0, 0); PG8_LDB(B1, 0, 1); PG8_SCHED; PG8_LDA(At, 0, 0); PG8_STAGE(PG8_SA(1, 1), a1 + hstepA, voffA);
            PG8_WAIT_V(8); PG8_WAIT_L(0); PG8_BAR; PG8_MMA(0, 0, At, B0); PG8_MMA(0, 1, At, B1); PG8_BAR; PG8_SCHED;
            PG8_LDA(At, 0, 1); PG8_STAGE(PG8_SB(0, 0), b2, voffB); PG8_STAGE(PG8_SB(0, 1), b2 + hstepB, voffB); PG8_STAGE(PG8_SA(0, 0), a2, voffA);
            PG8_WAIT_V(8); PG8_WAIT_L(0); PG8_BAR; PG8_MMA(1, 0, At, B0); PG8_MMA(1, 1, At, B1); PG8_BAR; PG8_SCHED;
            PG8_LDB(B0, 1, 0); PG8_LDB(B1, 1, 1); PG8_SCHED; PG8_LDA(At, 1, 0); PG8_STAGE(PG8_SA(0, 1), a2 + hstepA, voffA);
            PG8_WAIT_V(8); PG8_WAIT_L(0); PG8_BAR; PG8_MMA(0, 0, At, B0); PG8_MMA(0, 1, At, B1); PG8_BAR; PG8_SCHED;
            PG8_LDA(At, 1, 1); PG8_STAGE(PG8_SB(1, 0), b3, voffB); PG8_STAGE(PG8_SB(1, 1), b3 + hstepB, voffB); PG8_STAGE(PG8_SA(1, 0), a3, voffA);
            PG8_WAIT_V(8); PG8_WAIT_L(0); PG8_BAR; PG8_MMA(1, 0, At, B0); PG8_MMA(1, 1, At, B1); PG8_BAR; PG8_SCHED;
        }
        if constexpr (ALIGN_EPI) { if (wr == 0) PG8_BAR; }
        E(acc, cur, wr, wc, fr, fq);
        if (!has_next) break;
#pragma unroll
        for (int a = 0; a < 2; ++a)
#pragma unroll
            for (int b = 0; b < 2; ++b)
#pragma unroll
                for (int m = 0; m < 4; ++m)
#pragma unroll
                    for (int n = 0; n < 2; ++n) acc[a][b][m][n] = (f32x4){0.f, 0.f, 0.f, 0.f};
        cur = nxt; cA = nA; cB = nB; ++ui;
        if constexpr (ALIGN_EPI) { if (wr == 1) PG8_BAR; }
    }
    PG8_WAIT_V(0);
    if constexpr (!ALIGN_EPI) { if (wr == 0) PG8_BAR; }
    PG8_BAR;
#undef KOFFA
#undef PG8_SA
#undef PG8_SB
#undef PG8_STAGE
#undef PG8_LDA
#undef PG8_LDB
#undef PG8_MMA
#undef PG8_WAIT_V
#undef PG8_WAIT_L
#undef PG8_BAR
#undef PG8_SCHED
}
}

typedef GAS unsigned gu32;
#define RLX_AGENT __ATOMIC_RELAXED, __HIP_MEMORY_SCOPE_AGENT
#define XB_TMO      128
#define XB_XCNT(j)  (256  + 64 * (j))
#define XB_XSUB(j)  (1280 + 64 * (j))
#define XB_XGEN(j)  (2304 + 64 * (j))
#define XB_TOP      3328
#define XB_TOPGEN   3392
#define XCD_BAR_WORDS 3456
#define XB_SPIN_CAP (1u << 18)
__device__ __forceinline__ unsigned xb_ld(unsigned* p)              { return __hip_atomic_load(p, __ATOMIC_RELAXED, __HIP_MEMORY_SCOPE_AGENT); }
__device__ __forceinline__ unsigned xb_add(unsigned* p, unsigned v) { return __hip_atomic_fetch_add(p, v, __ATOMIC_RELAXED, __HIP_MEMORY_SCOPE_AGENT); }
__device__ __forceinline__ unsigned xb_xcc_id() { return (unsigned)__builtin_amdgcn_s_getreg((3 << 11) | 20) & 0xFu; }
#define XB_SPIN(cond, bar) do { unsigned _sp = 0; while (cond) { __builtin_amdgcn_s_sleep(1); \
    if ((++_sp & 255u) == 0u) { if (xb_ld(&(bar)[XB_TMO])) break; if (_sp > XB_SPIN_CAP) { atomicAdd(&(bar)[XB_TMO], 1u); break; } } } } while (0)
struct XcdBarrier { unsigned* bar; unsigned x; volatile LAS unsigned* st; };
__device__ __forceinline__ XcdBarrier xcd_barrier_post(unsigned* bar, volatile LAS unsigned* st) {
    XcdBarrier b; b.bar = bar; b.x = xb_xcc_id(); b.st = st;
    if (threadIdx.x == 0) (void)xb_add(&bar[XB_XCNT(b.x)], 1u);
    return b;
}
__device__ __forceinline__ void xcd_barrier_complete(unsigned* bar, unsigned x, unsigned& nloc, unsigned& nx) {
    const unsigned G = gridDim.x * gridDim.y * gridDim.z;
    unsigned sum, cnt, mine, sp = 0u;
    for (;;) {
        sum = 0u; cnt = 0u; mine = 0u;
#pragma unroll
        for (unsigned j = 0; j < 16; ++j) { const unsigned c = xb_ld(&bar[XB_XCNT(j)]); sum += c; cnt += (c > 0u) ? 1u : 0u; mine = (j == x) ? c : mine; }
        if (sum == G) break;
        __builtin_amdgcn_s_sleep(1);
        if ((++sp & 255u) == 0u) { if (xb_ld(&bar[XB_TMO])) break; if (sp > XB_SPIN_CAP) { atomicAdd(&bar[XB_TMO], 1u); break; } }
    }
    nloc = mine > 0u ? mine : 1u; nx = cnt > 0u ? cnt : 1u;
}
__device__ __forceinline__ void xcd_barrier(const XcdBarrier& b) {
    asm volatile("s_waitcnt vmcnt(0)" ::: "memory");
    __syncthreads();
    if (threadIdx.x == 0) {
        unsigned* bar = b.bar;
        __builtin_amdgcn_s_waitcnt(0);
        unsigned nloc = b.st[0], nx = b.st[1];
        if (nloc == 0u) { xcd_barrier_complete(bar, b.x, nloc, nx); b.st[0] = nloc; b.st[1] = nx; }
        const unsigned old = xb_add(&bar[XB_XSUB(b.x)], 1u);
        const unsigned gen = old / nloc;
        if (old + 1u == (gen + 1u) * nloc) {
            __builtin_amdgcn_fence(__ATOMIC_RELEASE, "agent");
            asm volatile("s_waitcnt vmcnt(0)" ::: "memory");
            const unsigned og = xb_add(&bar[XB_TOP], 1u);
            const unsigned tg = og / nx;
            if (og + 1u == (tg + 1u) * nx) xb_add(&bar[XB_TOPGEN], 1u);
            else XB_SPIN(xb_ld(&bar[XB_TOPGEN]) == tg, bar);
            __builtin_amdgcn_fence(__ATOMIC_ACQUIRE, "agent");
            xb_add(&bar[XB_XGEN(b.x)], 1u);
            asm volatile("s_waitcnt vmcnt(0)" ::: "memory");
        } else {
            XB_SPIN(xb_ld(&bar[XB_XGEN(b.x)]) == gen, bar);
            __builtin_amdgcn_fence(__ATOMIC_ACQUIRE, "agent");
            asm volatile("s_waitcnt vmcnt(0)" ::: "memory");
        }
    }
    __syncthreads();
}

struct Args {
    const float *x_prompt, *x_sample, *cache_k, *cache_v, *state_ssm, *state_conv, *norm_w, *w_in, *conv_w, *conv_b,
                *dt_bias, *a_log, *d_skip, *ssm_norm_w, *q_norm_w, *k_norm_w, *sinks, *rel_table, *w_out;
    float* out; unsigned char* ws; int ph_lo, ph_hi, sub, dry;
};
constexpr int NWAVES = 8, NT = 512;
constexpr int RING_BYTES = 131072, LDS_BYTES = 147456, MISC_OFF = LDS_BYTES - 512;

template <bool REMAP>
__device__ __forceinline__ void p0_transpose_item(const float* W, int K, int N, bf16_t* WT, LAS bf16_t* scr, int item, int lane) {
    const int nblk = (N + 63) / 64, kb = item / nblk, nb = item % nblk, k0 = 64 * kb, n0 = 64 * nb;
    const bool nok = (n0 + lane) < N;
    const float* wp = W + (size_t)k0 * N + n0 + (nok ? lane : 0);
    float v[64];
#pragma unroll
    for (int kk = 0; kk < 64; ++kk) v[kk] = __builtin_nontemporal_load(wp + (size_t)kk * N);
#pragma unroll
    for (int kk = 0; kk < 64; kk += 2) *(LAS unsigned*)(scr + lane * 68 + kk) = pk2(v[kk], v[kk + 1]);
    LDS_WAIT(); asm volatile("" ::: "memory");
    const int c = lane & 7;
#pragma unroll
    for (int j = 0; j < 8; ++j) { const int n = (lane >> 3) + 8 * j;
        const u32x2 lo = *(const LAS u32x2*)(scr + n * 68 + 8 * c), hi = *(const LAS u32x2*)(scr + n * 68 + 8 * c + 4);
        u32x4 o; o.x = lo.x; o.y = lo.y; o.z = hi.x; o.w = hi.y;
        int ng = n0 + n;
        if (ng < N) { if (REMAP) ng = (ng < 2560) ? ng : (ng < 2576 ? ng + 2560 : ng - 16);
            *(u32x4*)(WT + (size_t)ng * K + k0 + 8 * c) = o; } }
    LDS_WAIT(); asm volatile("" ::: "memory");
}
__device__ __forceinline__ void p0_prologue(const Args& a, LAS unsigned char* lds, int vcu, int G, int wave, int lane, unsigned long long& amp_d) {
    unsigned long long amp_t = 0ull;
#define AMPB(k) do { if (MK_AMP == (k)) amp_t = __builtin_amdgcn_s_memrealtime(); } while (0)
#define AMPE(k) do { if (MK_AMP == (k)) { __syncthreads(); amp_d += __builtin_amdgcn_s_memrealtime() - amp_t; } } while (0)
    AMPB(100);
    LAS bf16_t* scr = (LAS bf16_t*)(lds + wave * 16384);
    bf16_t* WinT = (bf16_t*)(a.ws + WS_WIN); bf16_t* WoutT = (bf16_t*)(a.ws + WS_WOUT); bf16_t* H = (bf16_t*)(a.ws + WS_H);
    const int gw = vcu * NWAVES + wave, NGW = G * NWAVES;
    constexpr int I_IN = (DM / 64) * ((NIN + 63) / 64), I_OUT = (2048 / 64) * (DM / 64);
    for (int it = gw; it < I_IN + I_OUT; it += NGW) {
        if (it < I_IN) p0_transpose_item<true>(a.w_in, DM, NIN, WinT, scr, it, lane);
        else p0_transpose_item<false>(a.w_out, 2048, DM, WoutT, scr, it - I_IN, lane);
    }
    AMPE(100); AMPB(101);
    for (int r = gw; r < NINP - NIN; r += NGW) { u32x4* p = (u32x4*)(WinT + (size_t)(NIN + r) * DM); p[lane] = (u32x4){0u, 0u, 0u, 0u}; p[lane + 64] = (u32x4){0u, 0u, 0u, 0u}; }
    f32x4 nw[4];
#pragma unroll
    for (int j = 0; j < 4; ++j) nw[j] = ((const f32x4*)a.norm_w)[lane + 64 * j];
    f32x4 vn[4][4];
#define P0_LOAD(dst, mb) do { _Pragma("unroll") for (int r = 0; r < 4; ++r) { const int m = (mb) + r * NGW; \
        if (m < MT) { const float* xrow = (m < MP) ? a.x_prompt + (size_t)m * DM : a.x_sample + (size_t)(m - MP) * DM; const f32x4* xr = (const f32x4*)xrow + lane; \
            _Pragma("unroll") for (int j = 0; j < 4; ++j) dst[r][j] = __builtin_nontemporal_load(xr + 64 * j); } } } while (0)
    P0_LOAD(vn, gw);
    for (int m0 = gw; m0 < MT; m0 += 4 * NGW) {
        f32x4 v[4][4];
#pragma unroll
        for (int r = 0; r < 4; ++r)
#pragma unroll
            for (int j = 0; j < 4; ++j) v[r][j] = vn[r][j];
        if (m0 + 4 * NGW < MT) P0_LOAD(vn, m0 + 4 * NGW);
#pragma unroll
        for (int r = 0; r < 4; ++r) { const int m = m0 + r * NGW;
            if (m < MT) { float s = 0.f;
#pragma unroll
                for (int j = 0; j < 4; ++j) s += (v[r][j].x * v[r][j].x + v[r][j].y * v[r][j].y) + (v[r][j].z * v[r][j].z + v[r][j].w * v[r][j].w);
                const float rstd = __builtin_amdgcn_rsqf(wave_sum(s) * (1.f / DM) + EPS);
                unsigned long long* o8 = (unsigned long long*)(H + (size_t)m * DM) + lane;
#pragma unroll
                for (int j = 0; j < 4; ++j) { const f32x4 h = v[r][j] * rstd * nw[j]; o8[64 * j] = (unsigned long long)pk2(h.x, h.y) | ((unsigned long long)pk2(h.z, h.w) << 32); } } }
    }
#undef P0_LOAD
    AMPE(101);
#undef AMPB
#undef AMPE
}

__device__ __forceinline__ float ssd_dt_scan(const float* DT, int R0, int h, int e, int lane, const float* dt_bias, const float* a_log, LAS float* dtv, LAS float* acum, float& d0o, float& d1o, float& c0o, float& c1o) {
    const float bias = dt_bias[h]; const float A = -expf(a_log[h]);
    const int l0 = 2 * lane;
    const float d0 = softplus_f(DT[(size_t)(R0 + l0) * 16 + h] + bias), d1 = softplus_f(DT[(size_t)(R0 + l0 + 1) * 16 + h] + bias);
    const float a0 = d0 * A, a1 = d1 * A; float s = a0 + a1;
#pragma unroll
    for (int o = 1; o < 64; o <<= 1) { const float t = __shfl_up(s, o); if (lane >= o) s += t; }
    const float excl = s - (a0 + a1);
    const float c0 = excl + a0, c1 = excl + a0 + a1;
    dtv[e * 128 + l0] = d0; dtv[e * 128 + l0 + 1] = d1; acum[e * 128 + l0] = c0; acum[e * 128 + l0 + 1] = c1;
    d0o = d0; d1o = d1; c0o = c0; c1o = c1;
    return __shfl(s, 63);
}

typedef short v4i16_t __attribute__((ext_vector_type(4)));
__device__ __forceinline__ u32x2 lds_tr16(const LAS bf16_t* p) { return __builtin_bit_cast(u32x2, __builtin_amdgcn_ds_read_tr16_b64_v4i16((LAS v4i16_t*)p)); }
struct ConvRaw { u32x4 r[5]; };
__device__ __forceinline__ void conv_load(const bf16_t* U, const bf16_t* HALO, int R0, int gc, int c, int chb, int tid, ConvRaw& o) {
    const int q = tid & 7, r = tid >> 3;
#pragma unroll
    for (int i = 0; i < 5; ++i) {
        const int rr = 2 * r - 3 + i;
        u32x4 v = (u32x4){0u, 0u, 0u, 0u};
        if (rr >= 0) v = *(const u32x4*)(U + (size_t)(R0 + rr) * UW + C_X + chb + 8 * q);
        else if (c > 0) v = *(const u32x4*)(HALO + (size_t)((gc - 1) * 3 + 3 + rr) * CONVD + chb + 8 * q);
        o.r[i] = v;
    }
}
__device__ __forceinline__ void conv_apply(const ConvRaw& in, const LAS float* cw, int lc, float (&o0)[8], float (&o1)[8]) {
    float x[5][8];
#pragma unroll
    for (int i = 0; i < 5; ++i) { const u32x4 v = in.r[i]; x[i][0] = bflo(v.x); x[i][1] = bfhi(v.x); x[i][2] = bflo(v.y); x[i][3] = bfhi(v.y); x[i][4] = bflo(v.z); x[i][5] = bfhi(v.z); x[i][6] = bflo(v.w); x[i][7] = bfhi(v.w); }
    float w[5][8];
#pragma unroll
    for (int t = 0; t < 5; ++t) { const f32x4 a0 = *(const LAS f32x4*)(cw + t * 768 + lc), a1 = *(const LAS f32x4*)(cw + t * 768 + lc + 4);
        w[t][0] = a0.x; w[t][1] = a0.y; w[t][2] = a0.z; w[t][3] = a0.w; w[t][4] = a1.x; w[t][5] = a1.y; w[t][6] = a1.z; w[t][7] = a1.w; }
#pragma unroll
    for (int i = 0; i < 8; ++i) {
        o0[i] = silu_f(w[4][i] + w[0][i] * x[0][i] + w[1][i] * x[1][i] + w[2][i] * x[2][i] + w[3][i] * x[3][i]);
        o1[i] = silu_f(w[4][i] + w[0][i] * x[1][i] + w[1][i] * x[2][i] + w[2][i] * x[3][i] + w[3][i] * x[4][i]);
    }
}
__device__ __forceinline__ u32x4 pack8(const float (&v)[8]) { u32x4 w; w.x = pk2(v[0], v[1]); w.y = pk2(v[2], v[3]); w.z = pk2(v[4], v[5]); w.w = pk2(v[6], v[7]); return w; }

__device__ __forceinline__ void ssd_state_item(const Args& a, LAS unsigned char* lds, int item, int tid, int wave, int lane, const bool dry = false) {
    const int b = item >> 7, c = (item >> 1) & 63, g = item & 1, gc = b * 64 + c;
    const int R0 = b * SEQ + c * 128;
    bf16_t* U = (bf16_t*)(a.ws + WS_U); const float* DT = (const float*)(a.ws + WS_DT); const bf16_t* HALO = (const bf16_t*)(a.ws + WS_HALO);
    bf16_t* ST = (bf16_t*)(a.ws + WS_ST); float* DEC = (float*)(a.ws + WS_DEC);
    LAS bf16_t* Bn = (LAS bf16_t*)lds;
    LAS bf16_t* Xw0 = (LAS bf16_t*)(lds + 34816);
    LAS float* dtv = (LAS float*)(lds + 71680); LAS float* acum = dtv + 1024; LAS float* wv = acum + 1024;
    LAS float* cw = (LAS float*)(lds + 83968);
    auto blk_chb = [&](int k) -> int { return (k < 2) ? (1024 + 128 * g + 64 * k) : (k < 4) ? (1280 + 128 * g + 64 * (k - 2)) : (512 * g + 64 * (k - 4)); };
    auto blk_lc = [&](int k) -> int { return (k < 2) ? (512 + 64 * k) : (k < 4) ? (640 + 64 * (k - 2)) : (64 * (k - 4)); };
    ConvRaw raw; conv_load(U, HALO, R0, gc, c, blk_chb(0), tid, raw);
    for (int i = tid; i < 5 * 768; i += NT) { const int t = i / 768, lc = i % 768; const int ch = (lc < 512) ? (512 * g + lc) : (lc < 640) ? (1024 + 128 * g + (lc - 512)) : (1280 + 128 * g + (lc - 640));
        cw[i] = (t < 4) ? a.conv_w[t * CONVD + ch] : a.conv_b[ch]; }
    {
        float d0, d1, c0, c1; const int h = 8 * g + wave;
        const float aend = ssd_dt_scan(DT, R0, h, wave, lane, a.dt_bias, a.a_log, dtv, acum, d0, d1, c0, c1);
        wv[wave * 128 + 2 * lane] = d0 * __expf(aend - c0); wv[wave * 128 + 2 * lane + 1] = d1 * __expf(aend - c1);
        if (lane == 0 && !dry) DEC[gc * 16 + h] = __expf(aend);
    }
    __syncthreads();
    if (!dry) ((f32x4*)(a.ws + WS_DTA))[(size_t)item * 512 + tid] = ((const LAS f32x4*)dtv)[tid];
    const int fr = lane & 15, grp = lane >> 4, q = tid & 7, r = tid >> 3;
#pragma unroll 1
    for (int k = 0; k < 12; ++k) {
        ConvRaw cur = raw;
        if (k + 1 < 12) conv_load(U, HALO, R0, gc, c, blk_chb(k + 1), tid, raw);
        float o0[8], o1[8];
        if (dry && MK_ABL == 22) {
#pragma unroll
            for (int i = 0; i < 8; ++i) { o0[i] = bflo(cur.r[0].x) + i; o1[i] = bfhi(cur.r[4].w) + i; } }
        else conv_apply(cur, cw, blk_lc(k) + 8 * q, o0, o1);
        const u32x4 p0 = pack8(o0), p1 = pack8(o1);
        __syncthreads();
        bf16_t* up = U + (size_t)(R0 + 2 * r) * UW + C_X + blk_chb(k) + 8 * q;
        if (!dry || p0.x == 0x12345678u) { *(u32x4*)up = p0; *(u32x4*)(up + UW) = p1; }
        if (k < 2) { *(LAS u32x4*)(Bn + (2 * r) * 136 + 64 * k + 8 * q) = p0; *(LAS u32x4*)(Bn + (2 * r + 1) * 136 + 64 * k + 8 * q) = p1; }
        if (k >= 4) {
            const int e = k - 4, h = 8 * g + e;
            LAS bf16_t* Xw = Xw0 + (e & 1) * (128 * 72);
            const float w0 = wv[e * 128 + 2 * r], w1 = wv[e * 128 + 2 * r + 1];
#pragma unroll
            for (int i = 0; i < 8; ++i) { o0[i] *= w0; o1[i] *= w1; }
            *(LAS u32x4*)(Xw + (2 * r) * 72 + 8 * q) = pack8(o0); *(LAS u32x4*)(Xw + (2 * r + 1) * 72 + 8 * q) = pack8(o1);
            __syncthreads();
            if (dry && MK_ABL == 21) continue;
            f32x4 acc[4];
#pragma unroll
            for (int pt = 0; pt < 4; ++pt) acc[pt] = (f32x4){0.f, 0.f, 0.f, 0.f};
#pragma unroll
            for (int ks = 0; ks < 4; ++ks) {
                const int l0 = 32 * ks + 8 * grp + (fr >> 2);
                const u32x2 a0 = lds_tr16(Bn + l0 * 136 + 16 * wave + 4 * (fr & 3)), a1 = lds_tr16(Bn + (l0 + 4) * 136 + 16 * wave + 4 * (fr & 3));
                u32x2 b0[4], b1[4];
#pragma unroll
                for (int pt = 0; pt < 4; ++pt) { b0[pt] = lds_tr16(Xw + l0 * 72 + 16 * pt + 4 * (fr & 3)); b1[pt] = lds_tr16(Xw + (l0 + 4) * 72 + 16 * pt + 4 * (fr & 3)); }
                __builtin_amdgcn_sched_barrier(0);
                u32x4 aw; aw.x = a0.x; aw.y = a0.y; aw.z = a1.x; aw.w = a1.y;
#pragma unroll
                for (int pt = 0; pt < 4; ++pt) {
                    u32x4 bw; bw.x = b0[pt].x; bw.y = b0[pt].y; bw.z = b1[pt].x; bw.w = b1[pt].y;
                    acc[pt] = mfma16(__builtin_bit_cast(bf16x8, aw), __builtin_bit_cast(bf16x8, bw), acc[pt]);
                }
            }
            bf16_t* stp = ST + ((size_t)(gc * 16 + h) * 64) * 128 + 16 * wave + 4 * grp;
#pragma unroll
            for (int pt = 0; pt < 4; ++pt) { u32x2 o; o.x = pk2(acc[pt][0], acc[pt][1]); o.y = pk2(acc[pt][2], acc[pt][3]); if (!dry || o.x == 0x12345678u) *(u32x2*)(stp + (size_t)(16 * pt + fr) * 128) = o; }
        }
    }
    __syncthreads();
}

__device__ __forceinline__ void ssd_scan(const Args& a, LAS unsigned char* lds, int bx, int G, int tid, int wave, int lane, const bool dry) {
    u32x4* ST = (u32x4*)(a.ws + WS_ST); const float* DEC = (const float*)(a.ws + WS_DEC);
    LAS float* agg = (LAS float*)lds;
    const int seg = wave >> 1, gl = (wave & 1) * 64 + lane;
    for (int blk = bx; blk < NB * 16 * 8; blk += G) {
        const int bh = blk >> 3, b = bh >> 4, h = bh & 15, g8 = (blk & 7) * 128 + gl;
        u32x4* p = ST + ((size_t)(b * 64 + 16 * seg) * 16 + h) * 1024 + g8;
        const float* dp = DEC + (b * 64) * 16 + h;
        u32x4 v[16]; float d[16];
#pragma unroll
        for (int c = 0; c < 16; ++c) v[c] = p[(size_t)c * 16 * 1024];
        float pr[4];
#pragma unroll
        for (int s4 = 0; s4 < 4; ++s4) { float q = 1.f;
#pragma unroll
            for (int c = 0; c < 16; ++c) { const float dd = dp[(16 * s4 + c) * 16]; q *= dd; if (s4 == seg) d[c] = dd; }
            pr[s4] = q; }
        float cr[8];
#pragma unroll
        for (int i = 0; i < 8; ++i) cr[i] = 0.f;
#pragma unroll
        for (int c = 0; c < 16; ++c) { const u32x4 w = v[c]; const float f[8] = {bflo(w.x), bfhi(w.x), bflo(w.y), bfhi(w.y), bflo(w.z), bfhi(w.z), bflo(w.w), bfhi(w.w)};
#pragma unroll
            for (int i = 0; i < 8; ++i) cr[i] = cr[i] * d[c] + f[i]; }
        __syncthreads();
        *(LAS f32x4*)(agg + (seg * 128 + gl) * 8) = (f32x4){cr[0], cr[1], cr[2], cr[3]}; *(LAS f32x4*)(agg + (seg * 128 + gl) * 8 + 4) = (f32x4){cr[4], cr[5], cr[6], cr[7]};
        __syncthreads();
        float cin[8];
#pragma unroll
        for (int i = 0; i < 8; ++i) cin[i] = 0.f;
#pragma unroll
        for (int s4 = 0; s4 < 3; ++s4) if (s4 < seg) { const f32x4 a0 = *(const LAS f32x4*)(agg + (s4 * 128 + gl) * 8), a1 = *(const LAS f32x4*)(agg + (s4 * 128 + gl) * 8 + 4);
            const float av[8] = {a0.x, a0.y, a0.z, a0.w, a1.x, a1.y, a1.z, a1.w};
#pragma unroll
            for (int i = 0; i < 8; ++i) cin[i] = cin[i] * pr[s4] + av[i]; }
#pragma unroll
        for (int c = 0; c < 16; ++c) { const u32x4 w = v[c]; const float f[8] = {bflo(w.x), bfhi(w.x), bflo(w.y), bfhi(w.y), bflo(w.z), bfhi(w.z), bflo(w.w), bfhi(w.w)};
            u32x4 o; o.x = pk2(cin[0], cin[1]); o.y = pk2(cin[2], cin[3]); o.z = pk2(cin[4], cin[5]); o.w = pk2(cin[6], cin[7]);
            if (!dry) p[(size_t)c * 16 * 1024] = o;
#pragma unroll
            for (int i = 0; i < 8; ++i) cin[i] = cin[i] * d[c] + f[i]; }
        if (seg == 3 && (!dry || cin[0] == 12345.678f)) { float* o = a.out + O_SP + (size_t)bh * 8192 + 8 * g8;
            *(f32x4*)o = (f32x4){cin[0], cin[1], cin[2], cin[3]}; *(f32x4*)(o + 4) = (f32x4){cin[4], cin[5], cin[6], cin[7]}; }
    }
}

struct HeadRegs { u32x4 x[2], s[2]; u32x2 z[4]; };
__device__ __forceinline__ void ssd_out_load(const bf16_t* U, const bf16_t* ST, int R0, int gc, int h, int tid, int l, int grp, HeadRegs& o) {
#pragma unroll
    for (int i = 0; i < 2; ++i) { const int ci = tid + NT * i;
        o.x[i] = *(const u32x4*)(U + (size_t)(R0 + (ci >> 3)) * UW + C_X + 64 * h + 8 * (ci & 7));
        o.s[i] = *(const u32x4*)(ST + ((size_t)(gc * 16 + h) * 64 + (ci >> 4)) * 128 + 8 * (ci & 15)); }
    const bf16_t* zrow = U + (size_t)(R0 + l) * UW + C_Z + 64 * h + 4 * grp;
#pragma unroll
    for (int pt = 0; pt < 4; ++pt) o.z[pt] = *(const u32x2*)(zrow + 16 * pt);
}
__device__ __forceinline__ void ssd_out_stage(const HeadRegs& in, LAS bf16_t* X, LAS bf16_t* St, int tid) {
#pragma unroll
    for (int i = 0; i < 2; ++i) { const int ci = tid + NT * i;
        *(LAS u32x4*)(X + (ci >> 3) * 72 + 8 * (ci & 7)) = in.x[i];
        *(LAS u32x4*)(St + (ci >> 4) * 136 + 8 * (ci & 15)) = in.s[i]; }
}
__device__ __forceinline__ void ssd_out_item(const Args& a, LAS unsigned char* lds, int item, int tid, int wave, int lane, const bool dry) {
    const int b = item >> 7, c = (item >> 1) & 63, g = item & 1, gc = b * 64 + c;
    const int R0 = b * SEQ + c * 128;
    bf16_t* U = (bf16_t*)(a.ws + WS_U); const float* DT = (const float*)(a.ws + WS_DT); const bf16_t* ST = (const bf16_t*)(a.ws + WS_ST);
    LAS bf16_t* Cn = (LAS bf16_t*)lds;
    LAS bf16_t* setA = (LAS bf16_t*)(lds + 34816);
    LAS bf16_t* setB = (LAS bf16_t*)(lds + 70656);
    LAS bf16_t* Bn = setB;
    LAS float* dtv = (LAS float*)(lds + 106496); LAS float* acum = dtv + 1024;
    const int fr = lane & 15, grp = lane >> 4;
    const int l = 16 * wave + fr;
    HeadRegs hr; ssd_out_load(U, ST, R0, gc, 8 * g, tid, l, grp, hr);
    {
        u32x4 bv[4], cv[4];
#pragma unroll
        for (int i = 0; i < 4; ++i) { const int ci = tid + NT * i; const bf16_t* rp = U + (size_t)(R0 + (ci >> 4)) * UW + 128 * g + 8 * (ci & 15); bv[i] = *(const u32x4*)(rp + C_B); cv[i] = *(const u32x4*)(rp + C_C); }
        const f32x4 dta = ((const f32x4*)(a.ws + WS_DTA))[(size_t)item * 512 + tid];
#pragma unroll
        for (int i = 0; i < 4; ++i) { const int ci = tid + NT * i; *(LAS u32x4*)(Bn + (ci >> 4) * 136 + 8 * (ci & 15)) = bv[i]; *(LAS u32x4*)(Cn + (ci >> 4) * 136 + 8 * (ci & 15)) = cv[i]; }
        ((LAS f32x4*)dtv)[tid] = dta;
    }
    ssd_out_stage(hr, setA, setA + 128 * 72, tid);
    u32x2 zc[4];
#pragma unroll
    for (int pt = 0; pt < 4; ++pt) zc[pt] = hr.z[pt];
    __syncthreads();
    f32x4 cb[8];
#pragma unroll
    for (int st = 0; st < 8; ++st) cb[st] = (f32x4){0.f, 0.f, 0.f, 0.f};
#pragma unroll
    for (int ks = 0; ks < 4; ++ks) {
        const bf16x8 cf = *(const LAS bf16x8*)(Cn + (16 * wave + fr) * 136 + 32 * ks + 8 * grp);
#pragma unroll
        for (int st = 0; st < 8; ++st) if (st <= wave) { const bf16x8 bfm = *(const LAS bf16x8*)(Bn + (16 * st + fr) * 136 + 32 * ks + 8 * grp); cb[st] = mfma16(bfm, cf, cb[st]); }
    }
    __syncthreads();
    float ssq = 0.f;
    LAS bf16_t* stg = (LAS bf16_t*)(lds + 114688) + wave * (16 * 64);
    bf16_t* yb = U + (size_t)(R0 + 16 * wave) * UW + C_Z + 512 * g;
    const int e_n = (dry && MK_ABL == 13) ? 0 : 8;
#pragma unroll 1
    for (int e = 0; e < e_n; ++e) {
        const int h = 8 * g + e;
        LAS bf16_t* X = (e & 1) ? setB : setA; LAS bf16_t* St = X + 128 * 72;
        if (e < 7) ssd_out_load(U, ST, R0, gc, h + 1, tid, l, grp, hr);
        f32x4 accd[4], acco[4];
#pragma unroll
        for (int pt = 0; pt < 4; ++pt) { accd[pt] = (f32x4){0.f, 0.f, 0.f, 0.f}; acco[pt] = (f32x4){0.f, 0.f, 0.f, 0.f}; }
        const float al = acum[e * 128 + l];
#pragma unroll
        for (int ks = 0; ks < 4; ++ks) {
            if (dry && MK_ABL == 11) break;
            const int sA = 32 * ks + 4 * grp, sB = sA + 16;
            const bool diag = (2 * ks <= wave);
            const bf16x8 cf = *(const LAS bf16x8*)(Cn + (16 * wave + fr) * 136 + 32 * ks + 8 * grp);
            bf16x8 sf[4];
#pragma unroll
            for (int pt = 0; pt < 4; ++pt) sf[pt] = *(const LAS bf16x8*)(St + (16 * pt + fr) * 136 + 32 * ks + 8 * grp);
            f32x4 acA = (f32x4){0.f, 0.f, 0.f, 0.f}, acB = acA, dtA = acA, dtB = acA; u32x2 xlo[4], xhi[4];
            if (diag) {
                acA = *(const LAS f32x4*)(acum + e * 128 + sA); acB = *(const LAS f32x4*)(acum + e * 128 + sB);
                dtA = *(const LAS f32x4*)(dtv + e * 128 + sA); dtB = *(const LAS f32x4*)(dtv + e * 128 + sB);
#pragma unroll
                for (int pt = 0; pt < 4; ++pt) { xlo[pt] = lds_tr16(X + (sA + (fr >> 2)) * 72 + 16 * pt + 4 * (fr & 3)); xhi[pt] = lds_tr16(X + (sB + (fr >> 2)) * 72 + 16 * pt + 4 * (fr & 3)); }
            }
            __builtin_amdgcn_sched_barrier(0);
            if (diag) {
                float m[8];
#pragma unroll
                for (int j = 0; j < 4; ++j) {
                    const float va = cb[2 * ks][j] * dtA[j] * __expf(al - acA[j]); m[j] = (sA + j <= l) ? va : 0.f;
                    const float vb = cb[2 * ks + 1][j] * dtB[j] * __expf(al - acB[j]); m[4 + j] = (sB + j <= l) ? vb : 0.f;
                }
                u32x4 mw; mw.x = pk2(m[0], m[1]); mw.y = pk2(m[2], m[3]); mw.z = pk2(m[4], m[5]); mw.w = pk2(m[6], m[7]);
                const bf16x8 mf = __builtin_bit_cast(bf16x8, mw);
#pragma unroll
                for (int pt = 0; pt < 4; ++pt) {
                    u32x4 aw; aw.x = xlo[pt].x; aw.y = xlo[pt].y; aw.z = xhi[pt].x; aw.w = xhi[pt].y;
                    accd[pt] = mfma16(__builtin_bit_cast(bf16x8, aw), mf, accd[pt]);
                }
            }
#pragma unroll
            for (int pt = 0; pt < 4; ++pt) acco[pt] = mfma16(sf[pt], cf, acco[pt]);
        }
        const float eal = __expf(al), dsk = a.d_skip[h];
#pragma unroll
        for (int pt = 0; pt < 4; ++pt) {
            if (dry && MK_ABL == 12) break;
            const u32x2 zz = zc[pt];
            const u32x2 xx = *(const LAS u32x2*)(X + l * 72 + 16 * pt + 4 * grp);
            const float z[4] = {bflo(zz.x), bfhi(zz.x), bflo(zz.y), bfhi(zz.y)};
            const float xv[4] = {bflo(xx.x), bfhi(xx.x), bflo(xx.y), bfhi(xx.y)};
            float gy[4];
#pragma unroll
            for (int r = 0; r < 4; ++r) {
                const float y = accd[pt][r] + eal * acco[pt][r] + dsk * xv[r];
                gy[r] = y * silu_f(z[r]); ssq += gy[r] * gy[r];
            }
            u32x2 o; o.x = pk2(gy[0], gy[1]); o.y = pk2(gy[2], gy[3]);
            *(LAS u32x2*)(stg + fr * 64 + 8 * ((2 * pt + (grp >> 1)) ^ (fr & 7)) + 4 * (grp & 1)) = o;
        }
        LDS_WAIT(); asm volatile("" ::: "memory");
#pragma unroll
        for (int i = 0; i < 2; ++i) { const int row = 8 * i + (lane >> 3), ch = lane & 7;
            const u32x4 v = *(const LAS u32x4*)(stg + row * 64 + 8 * (ch ^ (row & 7)));
            if (!dry) *(u32x4*)(yb + (size_t)row * UW + 64 * e + 8 * ch) = v; }
        if (e < 7) {
            ssd_out_stage(hr, (e & 1) ? setA : setB, ((e & 1) ? setA : setB) + 128 * 72, tid);
#pragma unroll
            for (int pt = 0; pt < 4; ++pt) zc[pt] = hr.z[pt]; }
        __syncthreads();
    }
    ssq += __shfl_xor(ssq, 16); ssq += __shfl_xor(ssq, 32);
    const float rstd = __builtin_amdgcn_rsqf(ssq * (1.f / 512.f) + EPS);
    LAS float* rsw = (LAS float*)stg;
    if (grp == 0) rsw[fr] = rstd;
    LDS_WAIT(); asm volatile("" ::: "memory");
    const float rs0 = rsw[lane >> 3], rs1 = rsw[8 + (lane >> 3)];
#pragma unroll 2
    for (int e = 0; e < 8; ++e) {
        const int ch = lane & 7;
        const f32x4 nwa = *(const f32x4*)(a.ssm_norm_w + 512 * g + 64 * e + 8 * ch), nwb = *(const f32x4*)(a.ssm_norm_w + 512 * g + 64 * e + 8 * ch + 4);
#pragma unroll
        for (int i = 0; i < 2; ++i) { const int row = 8 * i + (lane >> 3); const float rs = i ? rs1 : rs0;
            bf16_t* p = yb + (size_t)row * UW + 64 * e + 8 * ch;
            const u32x4 v = *(const u32x4*)p;
            u32x4 o; o.x = pk2(bflo(v.x) * rs * nwa.x, bfhi(v.x) * rs * nwa.y); o.y = pk2(bflo(v.y) * rs * nwa.z, bfhi(v.y) * rs * nwa.w);
            o.z = pk2(bflo(v.z) * rs * nwb.x, bfhi(v.z) * rs * nwb.y); o.w = pk2(bflo(v.w) * rs * nwb.z, bfhi(v.w) * rs * nwb.w);
            if (!dry || o.x == 0x12345678u) *(u32x4*)p = o; }
    }
    __syncthreads();
}

__device__ __forceinline__ int rel_bucket(int d) {
    if (d < 16) return d;
    const int lg = 16 + (int)(logf((float)d * (1.0f / 16.0f)) * (16.0f / 2.0794415416798357f));
    return lg < 31 ? lg : 31;
}
struct AttnKV { u32x4 k[4], v[4]; };
__device__ __forceinline__ void attn_load_kv(const bf16_t* U, int unit, int tid, AttnKV& r) {
    const int b = unit >> 8, blk = (unit >> 2) & 63, kvh = unit & 3; const int R0 = b * SEQ + blk * 128;
    const int j = tid >> 1, hf = tid & 1;
    const bool z = (blk == 0 && j < 128);
    const bf16_t* rp = U + (size_t)(R0 - 128 + (z ? 128 : j)) * UW + 64 * kvh + 32 * hf;
    const u32x4* kp = (const u32x4*)(rp + C_K); const u32x4* vp = (const u32x4*)(rp + C_V);
#pragma unroll
    for (int i = 0; i < 4; ++i) { r.k[i] = kp[i]; r.v[i] = vp[i]; }
}
typedef float f32x16 __attribute__((ext_vector_type(16)));
__device__ __forceinline__ f32x16 mfma32(bf16x8 a, bf16x8 b, f32x16 c) { return __builtin_amdgcn_mfma_f32_32x32x16_bf16(a, b, c, 0, 0, 0); }
__device__ __forceinline__ void attn_phase(const Args& a, LAS unsigned char* lds, int bx, int G, int tid, int wave, int lane, float m2, const bool dry, unsigned long long& amp_d) {
    unsigned long long amp_t = 0ull;
#define AMPB(k) do { if (MK_AMP == (k)) amp_t = __builtin_amdgcn_s_memrealtime(); } while (0)
#define AMPE(k) do { if (MK_AMP == (k)) amp_d += __builtin_amdgcn_s_memrealtime() - amp_t; } while (0)
    AMPB(210);
    bf16_t* U = (bf16_t*)(a.ws + WS_U);
    LAS bf16_t* Kn = (LAS bf16_t*)lds;
    LAS bf16_t* Vn = (LAS bf16_t*)(lds + 41472);
    LAS float* bias2 = (LAS float*)(lds + 82944);
    LAS float* qnw = (LAS float*)(lds + 95232);
    int unit = bx; if (unit >= 512) return;
    AttnKV kv; attn_load_kv(U, unit, tid, kv);
    __syncthreads();
    for (int i = tid; i < 16 * 192; i += NT) { const int hh = i / 192, t = i % 192, d = 128 - (t - 32); bias2[i] = (d >= 0 && d <= 128) ? a.rel_table[rel_bucket(d) * 16 + hh] * LOG2E - m2 : -1e30f; }
    if (tid < 288) { *(LAS u32x4*)(Kn + 256 * 72 + tid * 8) = (u32x4){0u, 0u, 0u, 0u}; *(LAS u32x4*)(Vn + 256 * 72 + tid * 8) = (u32x4){0u, 0u, 0u, 0u}; }
    if (tid < 64) qnw[tid] = a.q_norm_w[tid] * (0.125f * LOG2E);
    const int r32 = lane & 31, hh = lane >> 5;
    while (unit < 512) {
        const int b = unit >> 8, blk = (unit >> 2) & 63, kvh = unit & 3;
        const int R0 = b * SEQ + blk * 128;
        const int gq = wave >> 1, hq = 4 * kvh + gq;
        u32x4 qraw[2][4];
#pragma unroll
        for (int qt = 0; qt < 2; ++qt) {
            const bf16_t* qrow = U + (size_t)(R0 + 64 * (wave & 1) + 32 * qt + r32) * UW + C_Q + 64 * hq + 8 * hh;
#pragma unroll
            for (int ks = 0; ks < 4; ++ks) qraw[qt][ks] = *(const u32x4*)(qrow + 16 * ks);
        }
        {
            const int j = tid >> 1, hf = tid & 1;
            const bool zero = (blk == 0 && j < 128);
            f32x4 kf[8];
#pragma unroll
            for (int i = 0; i < 4; ++i) { const u32x4 w = kv.k[i]; kf[2 * i] = (f32x4){bflo(w.x), bfhi(w.x), bflo(w.y), bfhi(w.y)}; kf[2 * i + 1] = (f32x4){bflo(w.z), bfhi(w.z), bflo(w.w), bfhi(w.w)}; }
            float ss = 0.f;
#pragma unroll
            for (int i = 0; i < 8; ++i) ss += (kf[i].x * kf[i].x + kf[i].y * kf[i].y) + (kf[i].z * kf[i].z + kf[i].w * kf[i].w);
            ss += __shfl_xor(ss, 1);
            const float rstd = zero ? 0.f : __builtin_amdgcn_rsqf(ss * (1.f / 64.f) + EPS);
#pragma unroll
            for (int i = 0; i < 8; ++i) { const f32x4 w = *(const f32x4*)(a.k_norm_w + 32 * hf + 4 * i); kf[i] = kf[i] * rstd * w; }
#pragma unroll
            for (int i = 0; i < 4; ++i) { u32x4 w; w.x = pk2(kf[2 * i].x, kf[2 * i].y); w.y = pk2(kf[2 * i].z, kf[2 * i].w); w.z = pk2(kf[2 * i + 1].x, kf[2 * i + 1].y); w.w = pk2(kf[2 * i + 1].z, kf[2 * i + 1].w);
                *(LAS u32x4*)(Kn + j * 72 + 32 * hf + 8 * i) = w;
                u32x4 vw = kv.v[i]; if (zero) vw = (u32x4){0u, 0u, 0u, 0u};
                *(LAS u32x4*)(Vn + j * 72 + 32 * hf + 8 * i) = vw; }
            if (blk == 63 && j >= 128 && !dry) {
                float* ok = a.out + O_KP + ((size_t)(b * 128 + (j - 128)) * 4 + kvh) * 64 + 32 * hf; float* ov = a.out + O_VP + ((size_t)(b * 128 + (j - 128)) * 4 + kvh) * 64 + 32 * hf;
#pragma unroll
                for (int i = 0; i < 8; ++i) *(f32x4*)(ok + 4 * i) = kf[i];
#pragma unroll
                for (int i = 0; i < 4; ++i) { const u32x4 w = kv.v[i]; *(f32x4*)(ov + 8 * i) = (f32x4){bflo(w.x), bfhi(w.x), bflo(w.y), bfhi(w.y)}; *(f32x4*)(ov + 8 * i + 4) = (f32x4){bflo(w.z), bfhi(w.z), bflo(w.w), bfhi(w.w)}; }
            }
        }
        const int nxt = unit + G;
        if (nxt < 512) attn_load_kv(U, nxt, tid, kv);
        __syncthreads();
        AMPE(210); AMPB(211);
        const float sink2 = a.sinks[hq] * LOG2E;
#pragma unroll
        for (int qt = 0; qt < 2; ++qt) {
            if (dry && MK_ABL == 2) break;
            const int i0 = 64 * (wave & 1) + 32 * qt, iq = i0 + r32;
            bf16_t* qrow = U + (size_t)(R0 + iq) * UW + C_Q + 64 * hq;
            u32x2 zraw[8];
            { const bf16_t* zrow = U + (size_t)(R0 + iq) * UW + C_ZA + 64 * hq + 4 * hh;
#pragma unroll
              for (int i = 0; i < 8; ++i) zraw[i] = *(const u32x2*)(zrow + 8 * i); }
            bf16x8 qf[4];
            {
                float qv[4][8]; float ss = 0.f;
#pragma unroll
                for (int ks = 0; ks < 4; ++ks) { const u32x4 w = qraw[qt][ks];
                    qv[ks][0] = bflo(w.x); qv[ks][1] = bfhi(w.x); qv[ks][2] = bflo(w.y); qv[ks][3] = bfhi(w.y); qv[ks][4] = bflo(w.z); qv[ks][5] = bfhi(w.z); qv[ks][6] = bflo(w.w); qv[ks][7] = bfhi(w.w);
#pragma unroll
                    for (int i = 0; i < 8; ++i) ss += qv[ks][i] * qv[ks][i]; }
                ss += __shfl_xor(ss, 32);
                const float rs = __builtin_amdgcn_rsqf(ss * (1.f / 64.f) + EPS);
#pragma unroll
                for (int ks = 0; ks < 4; ++ks) { const f32x4 w0 = *(const LAS f32x4*)(qnw + 16 * ks + 8 * hh), w1 = *(const LAS f32x4*)(qnw + 16 * ks + 8 * hh + 4);
                    u32x4 p; p.x = pk2(qv[ks][0] * rs * w0.x, qv[ks][1] * rs * w0.y); p.y = pk2(qv[ks][2] * rs * w0.z, qv[ks][3] * rs * w0.w);
                    p.z = pk2(qv[ks][4] * rs * w1.x, qv[ks][5] * rs * w1.y); p.w = pk2(qv[ks][6] * rs * w1.z, qv[ks][7] * rs * w1.w);
                    qf[ks] = __builtin_bit_cast(bf16x8, p); }
            }
            f32x16 oacc[2];
#pragma unroll
            for (int dt = 0; dt < 2; ++dt)
#pragma unroll
                for (int r = 0; r < 16; ++r) oacc[dt][r] = 0.f;
            float lsum = 0.f;
            const int kk_n = (dry && MK_ABL == 1) ? 0 : 5;
#pragma unroll 1
            for (int kk = 0; kk < kk_n; ++kk) {
                const int j0 = i0 + 32 * kk;
                bf16x8 kfr[4]; u32x2 vfr[2][2][2]; float btv[16];
#pragma unroll
                for (int ks = 0; ks < 4; ++ks) kfr[ks] = *(const LAS bf16x8*)(Kn + (j0 + r32) * 72 + 16 * ks + 8 * hh);
                const LAS float* bt = bias2 + hq * 192 + (32 * kk + 4 * hh - r32 + 32);
#pragma unroll
                for (int r = 0; r < 16; ++r) btv[r] = bt[(r & 3) + 8 * (r >> 2)];
                {   const int i16 = lane & 15, dsub = ((lane >> 4) & 1) * 16;
                    const LAS bf16_t* vb = Vn + (j0 + 4 * hh + (i16 >> 2)) * 72 + dsub + 4 * (i16 & 3);
#pragma unroll
                    for (int s2 = 0; s2 < 2; ++s2)
#pragma unroll
                        for (int dt = 0; dt < 2; ++dt) { vfr[s2][dt][0] = lds_tr16(vb + (16 * s2) * 72 + 32 * dt); vfr[s2][dt][1] = lds_tr16(vb + (16 * s2 + 8) * 72 + 32 * dt); }
                }
                __builtin_amdgcn_sched_barrier(0);
                f32x16 sacc;
#pragma unroll
                for (int r = 0; r < 16; ++r) sacc[r] = 0.f;
#pragma unroll
                for (int ks = 0; ks < 4; ++ks) sacc = mfma32(kfr[ks], qf[ks], sacc);
                float p[16];
#pragma unroll
                for (int r = 0; r < 16; ++r) p[r] = __builtin_amdgcn_exp2f(sacc[r] + btv[r]);
                if (blk == 0) {
#pragma unroll
                    for (int r = 0; r < 16; ++r) if (j0 + (r & 3) + 8 * (r >> 2) + 4 * hh < 128) p[r] = 0.f;
                }
#pragma unroll
                for (int r = 0; r < 16; ++r) lsum += p[r];
                u32x4 pw0, pw1;
                pw0.x = pk2(p[0], p[1]); pw0.y = pk2(p[2], p[3]); pw0.z = pk2(p[4], p[5]); pw0.w = pk2(p[6], p[7]);
                pw1.x = pk2(p[8], p[9]); pw1.y = pk2(p[10], p[11]); pw1.z = pk2(p[12], p[13]); pw1.w = pk2(p[14], p[15]);
                const bf16x8 pf0 = __builtin_bit_cast(bf16x8, pw0), pf1 = __builtin_bit_cast(bf16x8, pw1);
#pragma unroll
                for (int dt = 0; dt < 2; ++dt) {
                    u32x4 a0; a0.x = vfr[0][dt][0].x; a0.y = vfr[0][dt][0].y; a0.z = vfr[0][dt][1].x; a0.w = vfr[0][dt][1].y;
                    u32x4 a1; a1.x = vfr[1][dt][0].x; a1.y = vfr[1][dt][0].y; a1.z = vfr[1][dt][1].x; a1.w = vfr[1][dt][1].y;
                    oacc[dt] = mfma32(__builtin_bit_cast(bf16x8, a0), pf0, oacc[dt]);
                    oacc[dt] = mfma32(__builtin_bit_cast(bf16x8, a1), pf1, oacc[dt]);
                }
            }
            lsum += __shfl_xor(lsum, 32);
            const float rl = __builtin_amdgcn_rcpf(lsum + __builtin_amdgcn_exp2f(sink2 - m2));
#pragma unroll
            for (int dt = 0; dt < 2; ++dt)
#pragma unroll
                for (int g4 = 0; g4 < 4; ++g4) {
                    const u32x2 zz = zraw[4 * dt + g4];
                    u32x2 o; o.x = pk2(oacc[dt][4 * g4] * rl * silu_f(bflo(zz.x)), oacc[dt][4 * g4 + 1] * rl * silu_f(bfhi(zz.x))); o.y = pk2(oacc[dt][4 * g4 + 2] * rl * silu_f(bflo(zz.y)), oacc[dt][4 * g4 + 3] * rl * silu_f(bfhi(zz.y)));
                    if (!dry || o.x == 0x12345678u) *(u32x2*)(qrow + 32 * dt + 8 * g4 + 4 * hh) = o;
                }
        }
        unit = nxt;
        __syncthreads();
        AMPE(211); AMPB(210);
    }
#undef AMPB
#undef AMPE
}
__device__ __forceinline__ float attn_shift(const Args& a, int lane, float& bmax2) {
    float wq = fabsf(a.q_norm_w[lane]), wk = fabsf(a.k_norm_w[lane]);
    float rb = 0.f;
    for (int i = lane; i < 512; i += 64) rb = fmaxf(rb, fabsf(a.rel_table[i]));
    if (lane < 16) rb = fmaxf(rb, fabsf(a.sinks[lane]));
#pragma unroll
    for (int o = 1; o < 64; o <<= 1) { wq = fmaxf(wq, __shfl_xor(wq, o)); wk = fmaxf(wk, __shfl_xor(wk, o)); rb = fmaxf(rb, __shfl_xor(rb, o)); }
    bmax2 = rb * LOG2E;
    return (8.0f * wq * wk + rb) * LOG2E;
}

__device__ __forceinline__ void samp_ssm_item(const Args& a, LAS unsigned char* lds, int item, int tid, int wave, int lane, const bool dry) {
    const int b = item >> 1, g = item & 1;
    const int Rs = MP + 4 * b;
    bf16_t* U = (bf16_t*)(a.ws + WS_U); const float* DT = (const float*)(a.ws + WS_DT);
    LAS float* xs = (LAS float*)lds;
    LAS float* Bs = xs + 2048;
    LAS float* Cs = Bs + 512;
    LAS float* gy = Cs + 512;
    LAS float* dts = gy + 2048;
    LAS float* avs = dts + 32;
    LAS float* rstd_s = avs + 32;
    __syncthreads();
    for (int cc = tid; cc < 768; cc += NT) {
        int ch; LAS float* dst;
        if (cc < 512) { ch = 512 * g + cc; dst = xs + cc; } else if (cc < 640) { ch = 1024 + 128 * g + (cc - 512); dst = Bs + (cc - 512); } else { ch = 1280 + 128 * g + (cc - 640); dst = Cs + (cc - 640); }
        const int stride = (cc < 512) ? 512 : 128;
        const float w0 = a.conv_w[ch], w1 = a.conv_w[CONVD + ch], w2 = a.conv_w[2 * CONVD + ch], w3 = a.conv_w[3 * CONVD + ch], cb = a.conv_b[ch];
        const float* sc = a.state_conv + (size_t)b * 3 * CONVD + ch;
        float f[7]; f[0] = sc[0]; f[1] = sc[CONVD]; f[2] = sc[2 * CONVD];
#pragma unroll
        for (int t = 0; t < 4; ++t) f[3 + t] = bf2f(U[(size_t)(Rs + t) * UW + C_X + ch]);
#pragma unroll
        for (int t = 0; t < 4; ++t) dst[t * stride] = silu_f(cb + w0 * f[t] + w1 * f[t + 1] + w2 * f[t + 2] + w3 * f[t + 3]);
    }
    if (tid < 32) { const int e = tid >> 2, t = tid & 3, h = 8 * g + e; const float d = softplus_f(DT[(size_t)(Rs + t) * 16 + h] + a.dt_bias[h]); dts[tid] = d; avs[tid] = d * (-expf(a.a_log[h])); }
    __syncthreads();
    const int p = tid >> 3, nq = tid & 7;
    f32x4 Sn[4];
    { const float* sp0 = a.state_ssm + ((size_t)(b * 16 + 8 * g) * 64 + p) * 128 + 4 * nq;
#pragma unroll
      for (int i = 0; i < 4; ++i) Sn[i] = __builtin_nontemporal_load((const f32x4*)(sp0 + 32 * i)); }
#pragma unroll 1
    for (int e = 0; e < 8; ++e) {
        const int h = 8 * g + e;
        f32x4 S[4];
#pragma unroll
        for (int i = 0; i < 4; ++i) S[i] = Sn[i];
        if (e < 7) { const float* sp = a.state_ssm + ((size_t)(b * 16 + h + 1) * 64 + p) * 128 + 4 * nq;
#pragma unroll
            for (int i = 0; i < 4; ++i) Sn[i] = __builtin_nontemporal_load((const f32x4*)(sp + 32 * i)); }
        float yv[4];
#pragma unroll
        for (int t = 0; t < 4; ++t) {
            const float dA = __expf(avs[e * 4 + t]); const float coef = dts[e * 4 + t] * xs[t * 512 + 64 * e + p];
            float acc = 0.f;
#pragma unroll
            for (int i = 0; i < 4; ++i) { const f32x4 Bv = *(const LAS f32x4*)(Bs + t * 128 + 4 * nq + 32 * i), Cv = *(const LAS f32x4*)(Cs + t * 128 + 4 * nq + 32 * i);
                S[i] = S[i] * dA + coef * Bv; acc += (Cv.x * S[i].x + Cv.y * S[i].y) + (Cv.z * S[i].z + Cv.w * S[i].w); }
            acc += __shfl_xor(acc, 1); acc += __shfl_xor(acc, 2); acc += __shfl_xor(acc, 4);
            yv[t] = acc;
        }
        float* op = a.out + O_SS + ((size_t)(b * 16 + h) * 64 + p) * 128 + 4 * nq;
#pragma unroll
        for (int i = 0; i < 4; ++i) if (!dry || S[i].x == 12345.678f) __builtin_nontemporal_store(S[i], (f32x4*)(op + 32 * i));
        if (nq < 4) { const int t = nq; const float xv = xs[t * 512 + 64 * e + p];
            const float yt = (nq == 0) ? yv[0] : (nq == 1) ? yv[1] : (nq == 2) ? yv[2] : yv[3];
            const float y = yt + a.d_skip[h] * xv; const float z = bf2f(U[(size_t)(Rs + t) * UW + C_Z + 64 * h + p]);
            gy[t * 512 + 64 * e + p] = y * silu_f(z); }
    }
    __syncthreads();
    if (wave < 4) { float s = 0.f;
#pragma unroll
        for (int i = 0; i < 8; ++i) { const float v = gy[wave * 512 + lane + 64 * i]; s += v * v; }
        s = wave_sum(s); if (lane == 0) rstd_s[wave] = __builtin_amdgcn_rsqf(s * (1.f / 512.f) + EPS); }
    __syncthreads();
    for (int i = tid; i < 2048; i += NT) { const int t = i >> 9, ch = i & 511;
        const unsigned ov = f2bf(gy[i] * rstd_s[t] * a.ssm_norm_w[512 * g + ch]); if (!dry || ov == 0x12345u) U[(size_t)(Rs + t) * UW + C_Z + 512 * g + ch] = (bf16_t)ov; }
}

struct SampAttnRegs { f32x4 k[4], v[4]; unsigned kx, vx, q0, q1; };
__device__ __forceinline__ void samp_attn_load(const Args& a, const bf16_t* U, int item, int tid, int wave, int lane, SampAttnRegs& r) {
    const int b = item >> 2, kvh = item & 3, Rs = MP + 4 * b;
    const int w = tid >> 2, qd = tid & 3;
    const float* kp = a.cache_k + ((size_t)(b * 128 + w) * 4 + kvh) * 64 + 16 * qd; const float* vp = a.cache_v + ((size_t)(b * 128 + w) * 4 + kvh) * 64 + 16 * qd;
#pragma unroll
    for (int i = 0; i < 4; ++i) { r.k[i] = __builtin_nontemporal_load((const f32x4*)(kp + 4 * i)); r.v[i] = __builtin_nontemporal_load((const f32x4*)(vp + 4 * i)); }
    const int t = wave & 3;
    r.kx = U[(size_t)(Rs + t) * UW + C_K + 64 * kvh + lane]; r.vx = U[(size_t)(Rs + t) * UW + C_V + 64 * kvh + lane];
    { const int qi = 2 * wave, gq = qi >> 2, tt = qi & 3; r.q0 = U[(size_t)(Rs + tt) * UW + C_Q + 64 * (4 * kvh + gq) + lane]; }
    { const int qi = 2 * wave + 1, gq = qi >> 2, tt = qi & 3; r.q1 = U[(size_t)(Rs + tt) * UW + C_Q + 64 * (4 * kvh + gq) + lane]; }
}
__device__ __forceinline__ void samp_attn_phase(const Args& a, LAS unsigned char* lds, int bx, int G, int tid, int wave, int lane, const bool dry, float bmax2) {
    bf16_t* U = (bf16_t*)(a.ws + WS_U);
    LAS bf16_t* Kn = (LAS bf16_t*)lds;
    LAS bf16_t* Vn = (LAS bf16_t*)(lds + 23040);
    LAS float* tb = (LAS float*)(lds + 46080);
    LAS f32x4* redo = (LAS f32x4*)(lds + 49152);
    LAS float* redl = (LAS float*)(lds + 69632);
    LAS unsigned* kmx = (LAS unsigned*)(lds + 70912);
    int item = bx; if (item >= 512) return;
    SampAttnRegs rg; samp_attn_load(a, U, item, tid, wave, lane, rg);
    __syncthreads();
    for (int i = tid; i < 28 * 72 / 8; i += NT) { *(LAS u32x4*)(Kn + 132 * 72 + 8 * i) = (u32x4){0u, 0u, 0u, 0u}; *(LAS u32x4*)(Vn + 132 * 72 + 8 * i) = (u32x4){0u, 0u, 0u, 0u}; }
    const int fr = lane & 15, grp = lane >> 4;
    while (item < 512) {
        const int b = item >> 2, kvh = item & 3;
        const int Rs = MP + 4 * b;
        if (tid == 0) kmx[0] = 0u;
        for (int i = tid; i < 4 * 168; i += NT) { const int gq = i / 168, u = (i % 168) - 3, d = 128 - u; tb[i] = (d >= 0 && d <= 128) ? a.rel_table[rel_bucket(d) * 16 + 4 * kvh + gq] * LOG2E : -1e30f; }
        __syncthreads();
        float k2 = 0.f;
        {
            const int w = tid >> 2, qd = tid & 3;
#pragma unroll
            for (int i = 0; i < 4; ++i) k2 += (rg.k[i].x * rg.k[i].x + rg.k[i].y * rg.k[i].y) + (rg.k[i].z * rg.k[i].z + rg.k[i].w * rg.k[i].w);
            u32x4 k0, k1, v0, v1;
            k0.x = pk2(rg.k[0].x, rg.k[0].y); k0.y = pk2(rg.k[0].z, rg.k[0].w); k0.z = pk2(rg.k[1].x, rg.k[1].y); k0.w = pk2(rg.k[1].z, rg.k[1].w);
            k1.x = pk2(rg.k[2].x, rg.k[2].y); k1.y = pk2(rg.k[2].z, rg.k[2].w); k1.z = pk2(rg.k[3].x, rg.k[3].y); k1.w = pk2(rg.k[3].z, rg.k[3].w);
            v0.x = pk2(rg.v[0].x, rg.v[0].y); v0.y = pk2(rg.v[0].z, rg.v[0].w); v0.z = pk2(rg.v[1].x, rg.v[1].y); v0.w = pk2(rg.v[1].z, rg.v[1].w);
            v1.x = pk2(rg.v[2].x, rg.v[2].y); v1.y = pk2(rg.v[2].z, rg.v[2].w); v1.z = pk2(rg.v[3].x, rg.v[3].y); v1.w = pk2(rg.v[3].z, rg.v[3].w);
            *(LAS u32x4*)(Kn + w * 72 + 16 * qd) = k0; *(LAS u32x4*)(Kn + w * 72 + 16 * qd + 8) = k1;
            *(LAS u32x4*)(Vn + w * 72 + 16 * qd) = v0; *(LAS u32x4*)(Vn + w * 72 + 16 * qd + 8) = v1;
            k2 += __shfl_xor(k2, 1); k2 += __shfl_xor(k2, 2);
        }
        if (wave < 4) {
            const int t = wave;
            const float kx = bf2f(rg.kx), vx = bf2f(rg.vx);
            const float ss = wave_sum(kx * kx); const float kn = kx * __builtin_amdgcn_rsqf(ss * (1.f / 64.f) + EPS) * a.k_norm_w[lane];
            Kn[(128 + t) * 72 + lane] = (bf16_t)f2bf(kn); Vn[(128 + t) * 72 + lane] = (bf16_t)rg.vx;
            k2 = fmaxf(k2, wave_sum(kn * kn));
            if (!dry) { a.out[O_KS + ((size_t)(b * 128 + 124 + t) * 4 + kvh) * 64 + lane] = kn; a.out[O_VS + ((size_t)(b * 128 + 124 + t) * 4 + kvh) * 64 + lane] = vx; }
        }
#pragma unroll
        for (int o = 1; o < 64; o <<= 1) k2 = fmaxf(k2, __shfl_xor(k2, o));
        if (lane == 0) (void)__hip_atomic_fetch_max(kmx, __builtin_bit_cast(unsigned, k2), __ATOMIC_RELAXED, __HIP_MEMORY_SCOPE_WORKGROUP);
        bf16x8 qf[2]; float qn2 = 0.f;
        const int tq = fr & 3, hq = 4 * kvh + (fr >> 2);
        if (wave < 5) {
            const bf16_t* qrow = U + (size_t)(Rs + tq) * UW + C_Q + 64 * hq + 8 * grp;
            const u32x4 w0 = *(const u32x4*)(qrow), w1 = *(const u32x4*)(qrow + 32);
            float qv[16] = {bflo(w0.x), bfhi(w0.x), bflo(w0.y), bfhi(w0.y), bflo(w0.z), bfhi(w0.z), bflo(w0.w), bfhi(w0.w),
                            bflo(w1.x), bfhi(w1.x), bflo(w1.y), bfhi(w1.y), bflo(w1.z), bfhi(w1.z), bflo(w1.w), bfhi(w1.w)};
            float ss = 0.f;
#pragma unroll
            for (int i = 0; i < 16; ++i) ss += qv[i] * qv[i];
            ss += __shfl_xor(ss, 16); ss += __shfl_xor(ss, 32);
            const float rs = (0.125f * LOG2E) * __builtin_amdgcn_rsqf(ss * (1.f / 64.f) + EPS);
#pragma unroll
            for (int i = 0; i < 16; ++i) { qv[i] *= rs * a.q_norm_w[(i < 8 ? 0 : 32) + 8 * grp + (i & 7)]; qn2 += qv[i] * qv[i]; }
            qn2 += __shfl_xor(qn2, 16); qn2 += __shfl_xor(qn2, 32);
            u32x4 p0, p1;
            p0.x = pk2(qv[0], qv[1]); p0.y = pk2(qv[2], qv[3]); p0.z = pk2(qv[4], qv[5]); p0.w = pk2(qv[6], qv[7]);
            p1.x = pk2(qv[8], qv[9]); p1.y = pk2(qv[10], qv[11]); p1.z = pk2(qv[12], qv[13]); p1.w = pk2(qv[14], qv[15]);
            qf[0] = __builtin_bit_cast(bf16x8, p0); qf[1] = __builtin_bit_cast(bf16x8, p1);
        }
        const int nxt = item + G;
        if (nxt < 512) samp_attn_load(a, U, nxt, tid, wave, lane, rg);
        __syncthreads();
        const float mq = sqrtf(qn2 * __builtin_bit_cast(float, kmx[0])) + bmax2;
        if (wave < 5) {
            const int j0 = 32 * wave;
            bf16x8 kfr[2][2]; u32x2 vlo[4], vhi[4]; float btv[8];
#pragma unroll
            for (int ks = 0; ks < 2; ++ks) { kfr[0][ks] = *(const LAS bf16x8*)(Kn + (j0 + fr) * 72 + 32 * ks + 8 * grp); kfr[1][ks] = *(const LAS bf16x8*)(Kn + (j0 + 16 + fr) * 72 + 32 * ks + 8 * grp); }
            const LAS float* bt = tb + (fr >> 2) * 168 + (j0 + 4 * grp - tq + 3);
#pragma unroll
            for (int r = 0; r < 4; ++r) { btv[r] = bt[r]; btv[4 + r] = bt[16 + r]; }
#pragma unroll
            for (int dt = 0; dt < 4; ++dt) { vlo[dt] = lds_tr16(Vn + (j0 + 4 * grp + (fr >> 2)) * 72 + 16 * dt + 4 * (fr & 3)); vhi[dt] = lds_tr16(Vn + (j0 + 16 + 4 * grp + (fr >> 2)) * 72 + 16 * dt + 4 * (fr & 3)); }
            __builtin_amdgcn_sched_barrier(0);
            f32x4 s0 = (f32x4){0.f, 0.f, 0.f, 0.f}, s1 = (f32x4){0.f, 0.f, 0.f, 0.f};
#pragma unroll
            for (int ks = 0; ks < 2; ++ks) { s0 = mfma16(kfr[0][ks], qf[ks], s0); s1 = mfma16(kfr[1][ks], qf[ks], s1); }
            float p[8]; float lsum = 0.f;
#pragma unroll
            for (int r = 0; r < 4; ++r) { p[r] = __builtin_amdgcn_exp2f(s0[r] + btv[r] - mq); p[4 + r] = __builtin_amdgcn_exp2f(s1[r] + btv[4 + r] - mq); }
#pragma unroll
            for (int r = 0; r < 8; ++r) lsum += p[r];
            u32x4 pw; pw.x = pk2(p[0], p[1]); pw.y = pk2(p[2], p[3]); pw.z = pk2(p[4], p[5]); pw.w = pk2(p[6], p[7]);
            const bf16x8 pf = __builtin_bit_cast(bf16x8, pw);
#pragma unroll
            for (int dt = 0; dt < 4; ++dt) {
                u32x4 aw; aw.x = vlo[dt].x; aw.y = vlo[dt].y; aw.z = vhi[dt].x; aw.w = vhi[dt].y;
                redo[(wave * 4 + dt) * 64 + lane] = mfma16(__builtin_bit_cast(bf16x8, aw), pf, (f32x4){0.f, 0.f, 0.f, 0.f});
            }
            redl[wave * 64 + lane] = lsum;
        }
        __syncthreads();
        if (wave < 4) {
            const int dt = wave;
            f32x4 o = redo[(0 * 4 + dt) * 64 + lane]; float l = redl[lane];
#pragma unroll
            for (int k5 = 1; k5 < 5; ++k5) { o += redo[(k5 * 4 + dt) * 64 + lane]; l += redl[k5 * 64 + lane]; }
            l += __shfl_xor(l, 16); l += __shfl_xor(l, 32);
            const float rl = __builtin_amdgcn_rcpf(l + __builtin_amdgcn_exp2f(a.sinks[hq] * LOG2E - mq));
            const u32x2 zz = *(const u32x2*)(U + (size_t)(Rs + tq) * UW + C_ZA + 64 * hq + 16 * dt + 4 * grp);
            u32x2 ov; ov.x = pk2(o[0] * rl * silu_f(bflo(zz.x)), o[1] * rl * silu_f(bfhi(zz.x))); ov.y = pk2(o[2] * rl * silu_f(bflo(zz.y)), o[3] * rl * silu_f(bfhi(zz.y)));
            if (!dry || ov.x == 0x12345678u) *(u32x2*)(U + (size_t)(Rs + tq) * UW + C_Q + 64 * hq + 16 * dt + 4 * grp) = ov;
        }
        item = nxt;
    }
}
__device__ __forceinline__ void cache_shift_copy(const Args& a, int it, int tid) {
    const int b = it >> 1; const float* src = (it & 1) ? a.cache_v : a.cache_k; float* dst = a.out + ((it & 1) ? O_VS : O_KS);
    const f32x4* s4 = (const f32x4*)(src + (size_t)(b * 128 + 4) * 256); f32x4* d4 = (f32x4*)(dst + (size_t)(b * 128) * 256);
#pragma unroll 8
    for (int i = tid; i < 124 * 64; i += NT) __builtin_nontemporal_store(__builtin_nontemporal_load(s4 + i), d4 + i);
}

__device__ __forceinline__ void conv_out_item(const Args& a, int item, int tid) {
    const bf16_t* U = (const bf16_t*)(a.ws + WS_U);
    for (int i = tid; i < 3 * CONVD; i += NT) {
        const int r = i / CONVD, ch = i % CONVD;
        if (item < NB) a.out[O_CP + (size_t)item * 3 * CONVD + i] = bf2f(((const bf16_t*)(a.ws + WS_HALO))[(size_t)((item * 64 + 63) * 3 + r) * CONVD + ch]);
        else { const int b = item - NB; a.out[O_CS + (size_t)b * 3 * CONVD + i] = bf2f(U[(size_t)(MP + 4 * b + 1 + r) * UW + C_X + ch]); }
    }
}

__device__ __forceinline__ void samp_outproj_tile(const Args& a, LAS unsigned char* lds, int it, int tid, int wave, int lane) {
    const bf16_t* U = (const bf16_t*)(a.ws + WS_U); const bf16_t* Wt = (const bf16_t*)(a.ws + WS_WOUT);
    LAS bf16_t* T = (LAS bf16_t*)lds;
    LAS f32x4* red = (LAS f32x4*)(lds + 131584);
    const int r0 = 32 * (it >> 4), c0 = 64 * (it & 15);
    const int fr = lane & 15, grp = lane >> 4, kh = wave >> 2, cg = wave & 3;
    __syncthreads();
    {   u32x4 tv[16];
#pragma unroll
        for (int i = 0; i < 16; ++i) { const int ci = tid + NT * i, row = ci >> 8, k = 8 * (ci & 255);
            tv[i] = *(const u32x4*)(U + (size_t)(MP + r0 + row) * UW + (k < 1024 ? C_Z + k : C_Q + (k - 1024))); }
#pragma unroll
        for (int i = 0; i < 16; ++i) { const int ci = tid + NT * i, row = ci >> 8, k = 8 * (ci & 255); *(LAS u32x4*)(T + row * 2056 + k) = tv[i]; }
    }
    const bf16_t* wp = Wt + (size_t)(c0 + 16 * cg + fr) * 2048 + 1024 * kh + 8 * grp;
    const LAS bf16_t* tp = T + fr * 2056 + 1024 * kh + 8 * grp;
    f32x4 acc0 = (f32x4){0.f, 0.f, 0.f, 0.f}, acc1 = (f32x4){0.f, 0.f, 0.f, 0.f};
    bf16x8 wf[8];
#pragma unroll
    for (int i = 0; i < 8; ++i) wf[i] = *(const bf16x8*)(wp + 32 * i);
    __syncthreads();
#pragma unroll
    for (int kb = 0; kb < 4; ++kb) {
        bf16x8 wc[8];
#pragma unroll
        for (int i = 0; i < 8; ++i) wc[i] = wf[i];
        if (kb < 3) {
#pragma unroll
            for (int i = 0; i < 8; ++i) wf[i] = *(const bf16x8*)(wp + 32 * (8 * (kb + 1) + i)); }
#pragma unroll
        for (int i = 0; i < 8; ++i) { const int ks = 8 * kb + i;
            const bf16x8 t0 = *(const LAS bf16x8*)(tp + 32 * ks), t1 = *(const LAS bf16x8*)(tp + 16 * 2056 + 32 * ks);
            acc0 = mfma16(wc[i], t0, acc0); acc1 = mfma16(wc[i], t1, acc1); }
    }
    if (kh) { red[(cg * 2 + 0) * 64 + lane] = acc0; red[(cg * 2 + 1) * 64 + lane] = acc1; }
    __syncthreads();
    if (!kh) {
        acc0 += red[(cg * 2 + 0) * 64 + lane]; acc1 += red[(cg * 2 + 1) * 64 + lane];
        const size_t o0 = (size_t)(r0 + fr) * DM + c0 + 16 * cg + 4 * grp, o1 = o0 + (size_t)16 * DM;
        *(f32x4*)(a.out + O_YS + o0) = *(const f32x4*)(a.x_sample + o0) + acc0;
        *(f32x4*)(a.out + O_YS + o1) = *(const f32x4*)(a.x_sample + o1) + acc1;
    }
}

__global__ void __launch_bounds__(NT, 2) mk_fwd(Args args) {
    extern __shared__ __attribute__((aligned(16))) unsigned char lds_raw[];
    LAS unsigned char* lds = (LAS unsigned char*)lds_raw;
    volatile LAS unsigned* MISC = (volatile LAS unsigned*)(lds + MISC_OFF);
    const int tid = threadIdx.x, lane = tid & 63, wave = __builtin_amdgcn_readfirstlane(tid >> 6);
    const int G = gridDim.x; const int bx = blockIdx.x; const int vcu = (G % 8 == 0) ? (bx % 8) * (G / 8) + bx / 8 : bx;
    gu32* ctl = (gu32*)(args.ws + WS_CTL);
    for (int u = tid; u < 512 / 4; u += NT) ((LAS unsigned*)(lds + MISC_OFF))[u] = 0u;
    __syncthreads();
    XcdBarrier bar; bar.bar = (unsigned*)(ctl + CW_BAR); bar.x = 0; bar.st = nullptr;
    if (MK_N_LAUNCHES == 1) bar = xcd_barrier_post((unsigned*)(ctl + CW_BAR), MISC + 8);
    const int lo = args.ph_lo, hi = args.ph_hi;
#define IN(k) (lo <= (k) && (k) < hi)
#define GRID_BAR() do { if (MK_N_LAUNCHES == 1) xcd_barrier(bar); } while (0)

    const bool dry = (args.dry != 0);
    unsigned long long amp_t = 0ull, amp_d = 0ull;
#define AMP_BEGIN(k) do { if (MK_AMP == (k)) amp_t = __builtin_amdgcn_s_memrealtime(); } while (0)
#define AMP_END(k) do { if (MK_AMP == (k)) amp_d += __builtin_amdgcn_s_memrealtime() - amp_t; } while (0)
    AMP_BEGIN(0);
    if (IN(0)) { p0_prologue(args, lds, vcu, G, wave, lane, amp_d); AMP_BEGIN(102); GRID_BAR(); AMP_END(102); }
    AMP_END(0);

    AMP_BEGIN(1);
    if (IN(1)) {
        pg8::Gemm g{(const bf16_t*)(args.ws + WS_H), (const bf16_t*)(args.ws + WS_WIN), MT, NINP, DM, DM, 1 << 20, 0};
        pg8::StaticOrder S; S.init(MT, NINP, G, bx);
        pg8::EpiU E{(bf16_t*)(args.ws + WS_U), (float*)(args.ws + WS_DT), (bf16_t*)(args.ws + WS_HALO)};
        pg8::gemm_phase<pg8::EpiU, pg8::StaticOrder, true>(lds, g, S, E);
        { const int rem = S.nwg % G;
          if (rem == 0) { for (int it = bx; it < 2 * DB; it += G) cache_shift_copy(args, it, tid); }
          else if (bx >= rem) { for (int it = bx - rem; it < 2 * DB; it += G - rem) cache_shift_copy(args, it, tid); } }
        GRID_BAR();
    }
    AMP_END(1);

    AMP_BEGIN(2);
    if (IN(2)) {
        float bmax2; const float m2 = attn_shift(args, lane, bmax2);
        const int sub = args.sub;
#define P2_PROMPT() do { AMP_BEGIN(20); if (sub & 1) for (int it = bx; it < 256; it += G) ssd_state_item(args, lds, it, tid, wave, lane); AMP_END(20); \
        AMP_BEGIN(21); if (sub & 2) attn_phase(args, lds, bx, G, tid, wave, lane, m2, dry, amp_d); AMP_END(21); } while (0)
#define P2_SAMPLE() do { AMP_BEGIN(22); if (sub & 4) for (int it = bx; it < 256; it += G) samp_ssm_item(args, lds, it, tid, wave, lane, dry); AMP_END(22); \
        AMP_BEGIN(23); if (sub & 8) samp_attn_phase(args, lds, bx, G, tid, wave, lane, dry, bmax2); AMP_END(23); } while (0)
        if (bx & 1) { P2_SAMPLE(); P2_PROMPT(); } else { P2_PROMPT(); P2_SAMPLE(); }
#undef P2_PROMPT
#undef P2_SAMPLE
        if (sub & 16) for (int it = bx; it < NB + DB; it += G) conv_out_item(args, it, tid);
        if (MK_AMP == 200) { const bool dr = (args.ph_hi < 1000); __syncthreads(); AMP_BEGIN(200); for (int it = bx; it < 256; it += G) ssd_state_item(args, lds, it, tid, wave, lane, dr); AMP_END(200); }
        if (MK_AMP == 212) { const bool dr = (args.ph_hi < 1000); __syncthreads(); AMP_BEGIN(212); attn_phase(args, lds, bx, G, tid, wave, lane, m2, dr, amp_d); AMP_END(212); }
        AMP_BEGIN(24); GRID_BAR(); AMP_END(24);
    }
    AMP_END(2);

    AMP_BEGIN(3);
    if (IN(3)) { ssd_scan(args, lds, bx, G, tid, wave, lane, dry); GRID_BAR(); }
    AMP_END(3);

    AMP_BEGIN(4);
    if (IN(4)) {
        for (int it = bx; it < 256; it += G) ssd_out_item(args, lds, it, tid, wave, lane, dry);
        if (MK_AMP == 400) { const bool dr = (args.ph_hi < 1000); __syncthreads(); AMP_BEGIN(400); for (int it = bx; it < 256; it += G) ssd_out_item(args, lds, it, tid, wave, lane, dr); AMP_END(400); }
        GRID_BAR();
    }
    AMP_END(4);

    AMP_BEGIN(5);
    if (IN(5)) {
        pg8::Gemm g{(const bf16_t*)(args.ws + WS_U), (const bf16_t*)(args.ws + WS_WOUT), MP, DM, 2048, UW, 16, (size_t)(C_Q - 1024) * 2};
        pg8::StaticOrder S; S.init(MP, DM, G, bx);
        pg8::EpiOut E{args.x_prompt, args.x_sample, args.out};
        if (bx & 1) { for (int it = bx; it < 256; it += G) samp_outproj_tile(args, lds, it, tid, wave, lane); __syncthreads(); }
        pg8::gemm_phase<pg8::EpiOut, pg8::StaticOrder, true>(lds, g, S, E);
        if (!(bx & 1)) { for (int it = bx; it < 256; it += G) samp_outproj_tile(args, lds, it, tid, wave, lane); }
    }
    AMP_END(5);
    if (MK_AMP >= 0 && bx == 0 && tid == 0) {
        const unsigned long long t0 = __builtin_amdgcn_s_memrealtime();
        while (__builtin_amdgcn_s_memrealtime() - t0 < 4ull * amp_d) __builtin_amdgcn_s_sleep(8);
    }
#undef AMP_BEGIN
#undef AMP_END
#undef IN
#undef GRID_BAR
}

extern "C" void kernel_launch(void* const* d_in, const int* in_sizes, int n_in, void* d_out, int out_size, void* d_ws, size_t ws_size, hipStream_t stream) {
    static int grid = 0;
    if (grid == 0) {
        if (n_in != 19 || (size_t)out_size != O_END || ws_size < WS_END) { fprintf(stderr, "kernel_launch: unexpected shapes (n_in %d, out %d, ws %zu)\n", n_in, out_size, ws_size); grid = -1; return; }
        int dev = 0, cus = 0;
        if (hipGetDevice(&dev) != hipSuccess || hipDeviceGetAttribute(&cus, hipDeviceAttributeMultiprocessorCount, dev) != hipSuccess) { grid = -1; return; }
        if (hipFuncSetAttribute((const void*)mk_fwd, hipFuncAttributeMaxDynamicSharedMemorySize, LDS_BYTES) != hipSuccess) { fprintf(stderr, "kernel_launch: hipFuncSetAttribute failed\n"); grid = -1; return; }
        int per_cu = 0;
        if (hipOccupancyMaxActiveBlocksPerMultiprocessor(&per_cu, (const void*)mk_fwd, NT, LDS_BYTES) != hipSuccess || per_cu < 1) fprintf(stderr, "kernel_launch: occupancy query reports %d blocks per CU\n", per_cu);
        (void)hipGetLastError();
        grid = cus;
    }
    if (grid < 0) return;
    (void)hipMemsetAsync((char*)d_ws + WS_CTL, 0, CTL_ZERO_BYTES, stream);
    Args a{};
    const float** ap = (const float**)&a;
    for (int i = 0; i < 19; ++i) ap[i] = (const float*)d_in[i];
    a.out = (float*)d_out; a.ws = (unsigned char*)d_ws;
    a.sub = 31; a.dry = 0;
    if (MK_N_LAUNCHES == 1) { a.ph_lo = 0; a.ph_hi = 6; hipLaunchKernelGGL(mk_fwd, dim3(grid), dim3(NT), LDS_BYTES, stream, a); }
    else for (int ph = 0; ph < 6; ++ph) {
        a.ph_lo = ph; a.ph_hi = ph + 1; a.sub = 31; a.dry = 0;
        hipLaunchKernelGGL(mk_fwd, dim3(grid), dim3(NT), LDS_BYTES, stream, a);
        if (MK_DUP == ph) { a.dry = 1; hipLaunchKernelGGL(mk_fwd, dim3(grid), dim3(NT), LDS_BYTES, stream, a); }
        if (ph == 2 && MK_DUP >= 20 && MK_DUP < 24) { a.sub = 1 << (MK_DUP - 20); a.dry = 1; hipLaunchKernelGGL(mk_fwd, dim3(grid), dim3(NT), LDS_BYTES, stream, a); }
    }
}
```

```cpp
#include <hip/hip_runtime.h>
#include <cstdio>
#include <cstdint>

#ifndef MK_N_LAUNCHES
#define MK_N_LAUNCHES 1
#endif

#ifndef MK_AMP
#define MK_AMP (-1)
#endif
#ifndef MK_ABL
#define MK_ABL 0
#endif
#ifndef MK_AMPBLK
#define MK_AMPBLK 0
#endif
#ifndef MK_DUP
#define MK_DUP (-1)
#endif
#define LAS __attribute__((address_space(3)))
#define GAS __attribute__((address_space(1)))
typedef unsigned short bf16_t;
typedef short bf16x8 __attribute__((ext_vector_type(8)));
typedef short bf16x4 __attribute__((ext_vector_type(4)));
typedef float f32x4 __attribute__((ext_vector_type(4)));
typedef float f32x2 __attribute__((ext_vector_type(2)));
typedef unsigned u32x4 __attribute__((ext_vector_type(4)));
typedef unsigned u32x2 __attribute__((ext_vector_type(2)));

constexpr int DM = 1024, SEQ = 8192, NB = 2, MP = NB * SEQ;
constexpr int DB = 128, DL = 4, MS = DB * DL, MT = MP + MS;
constexpr int NIN = 5136, NINP = 5376;
constexpr int UW = 5120;
constexpr int C_Z = 0, C_X = 1024, C_B = 2048, C_C = 2304, C_Q = 2560, C_K = 3584, C_V = 3840, C_ZA = 4096;
constexpr int CONVD = 1536;
constexpr float EPS = 1e-6f;
constexpr float LOG2E = 1.4426950408889634f;

constexpr size_t MiB = 1u << 20;
constexpr size_t WS_CTL = 0, CTL_ZERO_BYTES = 32768;
constexpr size_t WS_WIN = 1 * MiB;
constexpr size_t WS_WOUT = 12 * MiB;
constexpr size_t WS_DT = 16 * MiB;
constexpr size_t WS_DEC = 17 * MiB + 512 * 1024;
constexpr size_t WS_U = 18 * MiB;
constexpr size_t WS_H = 183 * MiB;
constexpr size_t WS_ST = 183 * MiB;
constexpr size_t WS_HALO = 247 * MiB;
constexpr size_t WS_DTA = 249 * MiB;
constexpr size_t WS_END = 251 * MiB;
constexpr int CW_BAR = 4096;

constexpr size_t O_YP = 0, O_YS = 16777216, O_KP = 17301504, O_VP = 17367040, O_SP = 17432576, O_CP = 17694720,
                 O_KS = 17703936, O_VS = 21898240, O_SS = 26092544, O_CS = 42869760, O_END = 43459584;

typedef __bf16 hwbf16x2 __attribute__((ext_vector_type(2)));
__device__ __forceinline__ unsigned pk2(float lo, float hi) { const f32x2 v = {lo, hi}; return __builtin_bit_cast(unsigned, __builtin_convertvector(v, hwbf16x2)); }
__device__ __forceinline__ unsigned f2bf(float f) { return pk2(f, 0.f) & 0xffffu; }
__device__ __forceinline__ float bf2f(unsigned v) { return __builtin_bit_cast(float, v << 16); }
__device__ __forceinline__ float bflo(unsigned w) { return __builtin_bit_cast(float, w << 16); }
__device__ __forceinline__ float bfhi(unsigned w) { return __builtin_bit_cast(float, w & 0xffff0000u); }
__device__ __forceinline__ float silu_f(float x) { return x * __builtin_amdgcn_rcpf(1.0f + __expf(-x)); }
__device__ __forceinline__ float softplus_f(float x) { return fmaxf(x, 0.f) + log1pf(__expf(-fabsf(x))); }
__device__ __forceinline__ float wave_sum(float v) {
#pragma unroll
    for (int o = 1; o < 64; o <<= 1) v += __shfl_xor(v, o);
    return v;
}
__device__ __forceinline__ f32x4 mfma16(bf16x8 a, bf16x8 b, f32x4 c) { return __builtin_amdgcn_mfma_f32_16x16x32_bf16(a, b, c, 0, 0, 0); }
__device__ __forceinline__ void st_wt16(void* p, u32x4 v) { asm volatile("global_store_dwordx4 %0, %1, off sc1\n\ts_nop 1" :: "v"(p), "v"(v) : "memory"); }
__device__ __forceinline__ void st_wt8(void* p, u32x2 v) { asm volatile("global_store_dwordx2 %0, %1, off sc1\n\ts_nop 1" :: "v"(p), "v"(v) : "memory"); }
#define LDS_WAIT() asm volatile("s_waitcnt lgkmcnt(0)" ::: "memory")
#define VM_WAIT() asm volatile("s_waitcnt vmcnt(0)" ::: "memory")

namespace pg8 {
constexpr int BM = 256, BK = 64, HALF = 128, HTB = HALF * BK * 2, STAGE_BYTES = 8 * HTB, NXCD = 8, WGM = 8;
__host__ __device__ __forceinline__ int lds_byte(int r, int c) { const int st = (r >> 4) * 2 + (c >> 5), rr = r & 15, cc = c & 31, ob = rr * 64 + cc * 2; return st * 1024 + (ob ^ (((ob >> 9) & 1) << 5)); }
__host__ __device__ __forceinline__ void stage_rc(int b, int& R, int& C) { const int st = b / 1024, sb = b % 1024, swz = sb ^ (((sb >> 9) & 1) << 5); R = (st >> 1) * 16 + swz / 64; C = (st & 1) * 32 + (swz % 64) / 2; }
__host__ __device__ __forceinline__ int perm32(int rho) { const int n = rho >> 4, i = rho & 15; return 8 * (i >> 2) + 4 * n + (i & 3); }

struct Unit { int pm, pn; };
struct Gemm { const bf16_t* A; const bf16_t* Bt; int M, N, K, lda, kseg; size_t segskip; };

struct StaticOrder {
    int nM, nN, nwg, G, c;
    __host__ __device__ void init(int M, int N, int G_, int c_) { nM = M / BM; nN = N / BM; nwg = nM * nN; G = G_; c = c_; }
    __host__ __device__ bool next(int i, Unit& u) const {
        const long L = (long)i * G + c; if (L >= nwg) return false;
        int wgid = (int)L; { const int q = nwg / NXCD, r = nwg % NXCD, xcd = wgid % NXCD, off = wgid / NXCD; wgid = (xcd < r ? xcd * (q + 1) : r * (q + 1) + (xcd - r) * q) + off; }
        const int nig = WGM * nN, gid = wgid / nig, fm = gid * WGM, gsz = (nM - fm) < WGM ? (nM - fm) : WGM;
        u.pm = fm + ((wgid % nig) % gsz); u.pn = (wgid % nig) / gsz; return true;
    }
};

__device__ __forceinline__ unsigned cvt_pk_bf16(float lo, float hi) { unsigned r; asm volatile("v_cvt_pk_bf16_f32 %0, %1, %2" : "=v"(r) : "v"(lo), "v"(hi)); return r; }

struct EpiU {
    static constexpr bool PERM = true;
    bf16_t* U; float* DT; bf16_t* HALO;
    __device__ __forceinline__ void operator()(const f32x4 (&acc)[2][2][4][2], const Unit& u, int wr, int wc, int fr, int fq) const {
        const int row0 = u.pm * BM + wr * 64 + fr;
        if (u.pn < 20) {
            const bool halo = (u.pn >= 4) && (u.pn < 10) && (u.pm < MP / BM) && (wr == 1) && (fr >= 13);
            const int col0 = u.pn * BM + wc * 32 + 8 * fq;
#pragma unroll
            for (int ai = 0; ai < 2; ++ai)
#pragma unroll
                for (int m = 0; m < 4; ++m) { bf16_t* rowp = U + (size_t)(row0 + ai * HALF + m * 16) * UW + col0;
#pragma unroll
                    for (int bj = 0; bj < 2; ++bj) { const f32x4 v0 = acc[ai][bj][m][0], v1 = acc[ai][bj][m][1];
                        u32x4 w; w.x = cvt_pk_bf16(v0[0], v0[1]); w.y = cvt_pk_bf16(v0[2], v0[3]); w.z = cvt_pk_bf16(v1[0], v1[1]); w.w = cvt_pk_bf16(v1[2], v1[3]);
                        *(u32x4*)(rowp + bj * HALF) = w;
                        if (m == 3 && halo) *(u32x4*)(HALO + (size_t)((u.pm * 2 + ai) * 3 + (fr - 13)) * CONVD + (col0 - C_X) + bj * HALF) = w; } }
        } else if (wc == 0 && fq < 2) {
#pragma unroll
            for (int ai = 0; ai < 2; ++ai)
#pragma unroll
                for (int m = 0; m < 4; ++m) { float* rowp = DT + (size_t)(row0 + ai * HALF + m * 16) * 16 + 8 * fq;
                    *(f32x4*)(rowp) = acc[ai][0][m][0]; *(f32x4*)(rowp + 4) = acc[ai][0][m][1]; }
        }
    }
};
struct EpiOut {
    static constexpr bool PERM = false;
    const float* xp; const float* xs; float* out;
    __device__ __forceinline__ void operator()(const f32x4 (&acc)[2][2][4][2], const Unit& u, int wr, int wc, int fr, int fq) const {
        const int col0 = u.pn * BM + wc * 32 + 4 * fq;
#pragma unroll
        for (int ai = 0; ai < 2; ++ai)
#pragma unroll
            for (int m = 0; m < 4; ++m) { const int row = u.pm * BM + ai * HALF + wr * 64 + m * 16 + fr;
                const float* xb = (row < MP) ? xp + (size_t)row * DM : xs + (size_t)(row - MP) * DM; float* ob = out + (size_t)row * DM;
#pragma unroll
                for (int bj = 0; bj < 2; ++bj)
#pragma unroll
                    for (int n = 0; n < 2; ++n) { const int c = col0 + bj * HALF + n * 16; const f32x4 xv = __builtin_nontemporal_load((const f32x4*)(xb + c)); __builtin_nontemporal_store(xv + acc[ai][bj][m][n], (f32x4*)(ob + c)); } }
    }
};

template <class Epi, class Sched, bool ALIGN_EPI>
__device__ __forceinline__ void gemm_phase(LAS unsigned char* lds, const Gemm g, const Sched& S, const Epi& E) {
    const int tid = threadIdx.x, wid = __builtin_amdgcn_readfirstlane(tid >> 6), lane = tid & 63, wr = wid >> 2, wc = wid & 3, fr = lane & 15, fq = lane >> 4;
    const int K = g.K, nt = K / BK, lda = g.lda, kseg = g.kseg;
    unsigned voffA[2], voffB[2];
#pragma unroll
    for (int i = 0; i < 2; ++i) { int R, C; stage_rc(tid * 16 + i * 8192, R, C); const int Rb = Epi::PERM ? ((R & ~31) + perm32(R & 31)) : R;
        voffA[i] = (unsigned)(R * lda + C) * 2u; voffB[i] = (unsigned)(Rb * K + C) * 2u; }
    const size_t kstep = (size_t)(BK * 2);
    const size_t hstepA = (size_t)HALF * lda * 2, tstepA = 2 * hstepA;
    const size_t hstepB = (size_t)HALF * K * 2, tstepB = 2 * hstepB;
    const size_t segskip = g.segskip;
#define KOFFA(t) ((size_t)(t) * kstep + (((t) >= kseg) ? segskip : (size_t)0))
    const unsigned ldsw = (unsigned)wid * 1024u;
    const int aoff = lds_byte(wr * 64 + fr, fq * 8), boff = lds_byte(wc * 32 + fr, fq * 8);
#define PG8_SA(b, h) (((b) * 2 + (h)) * HTB)
#define PG8_SB(b, h) ((4 + (b) * 2 + (h)) * HTB)
#define PG8_STAGE(bufoff, gbase, voff) do { _Pragma("unroll") for (int _i = 0; _i < 2; ++_i) \
        __builtin_amdgcn_global_load_lds((const unsigned*)((const char*)(gbase) + (voff)[_i]), (LAS unsigned*)(lds + (bufoff) + ldsw + _i * 8192), 16, 0, 0); } while (0)
#define PG8_LDA(dst, b, h) do { _Pragma("unroll") for (int m = 0; m < 4; ++m) _Pragma("unroll") for (int k = 0; k < 2; ++k) dst[m][k] = *(const LAS bf16x8*)(lds + PG8_SA(b, h) + aoff + m * 2048 + k * 1024); } while (0)
#define PG8_LDB(dst, b, h) do { _Pragma("unroll") for (int n = 0; n < 2; ++n) _Pragma("unroll") for (int k = 0; k < 2; ++k) dst[n][k] = *(const LAS bf16x8*)(lds + PG8_SB(b, h) + boff + n * 2048 + k * 1024); } while (0)
#define PG8_MMA(ai, bj, At, Bt) do { __builtin_amdgcn_s_setprio(1); _Pragma("unroll") for (int m = 0; m < 4; ++m) _Pragma("unroll") for (int n = 0; n < 2; ++n) _Pragma("unroll") for (int k = 0; k < 2; ++k) \
        acc[ai][bj][m][n] = __builtin_amdgcn_mfma_f32_16x16x32_bf16(Bt[n][k], At[m][k], acc[ai][bj][m][n], 0, 0, 0); __builtin_amdgcn_s_setprio(0); } while (0)
#define PG8_WAIT_V(n) asm volatile("s_waitcnt vmcnt(" #n ")" ::: "memory")
#define PG8_WAIT_L(n) asm volatile("s_waitcnt lgkmcnt(" #n ")" ::: "memory")
#define PG8_BAR __builtin_amdgcn_s_barrier()
#define PG8_SCHED __builtin_amdgcn_sched_barrier(0)
    Unit cur, nxt; int ui = 0;
    if (!S.next(0, cur)) return;
    f32x4 acc[2][2][4][2];
#pragma unroll
    for (int a = 0; a < 2; ++a)
#pragma unroll
        for (int b = 0; b < 2; ++b)
#pragma unroll
            for (int m = 0; m < 4; ++m)
#pragma unroll
                for (int n = 0; n < 2; ++n) acc[a][b][m][n] = (f32x4){0.f, 0.f, 0.f, 0.f};
    bf16x8 At[4][2], B0[2][2], B1[2][2];
    const char* cA = (const char*)g.A + (size_t)cur.pm * tstepA; const char* cB = (const char*)g.Bt + (size_t)cur.pn * tstepB;
    PG8_STAGE(PG8_SB(0, 0), cB, voffB); PG8_STAGE(PG8_SB(0, 1), cB + hstepB, voffB); PG8_STAGE(PG8_SA(0, 0), cA, voffA); PG8_STAGE(PG8_SA(0, 1), cA + hstepA, voffA);
    if (wr == 1) PG8_BAR;
    PG8_WAIT_V(2); PG8_BAR;
    PG8_STAGE(PG8_SB(1, 0), cB + kstep, voffB); PG8_STAGE(PG8_SA(1, 0), cA + KOFFA(1), voffA); PG8_STAGE(PG8_SB(1, 1), cB + hstepB + kstep, voffB);
    PG8_WAIT_V(6); PG8_BAR;
    for (;;) {
        const bool has_next = S.next(ui + 1, nxt);
        const char* nA = has_next ? (const char*)g.A + (size_t)nxt.pm * tstepA : cA; const char* nB = has_next ? (const char*)g.Bt + (size_t)nxt.pn * tstepB : cB;
        for (int t = 0; t < nt; t += 2) {
            const bool last = (t == nt - 2);
            const char* a1 = cA + KOFFA(t + 1);
            const char* a2 = last ? nA : cA + KOFFA(t + 2); const char* b2 = last ? nB : cB + (size_t)(t + 2) * kstep;
            const char* a3 = last ? nA + KOFFA(1) : cA + KOFFA(t + 3); const char* b3 = b2 + kstep;
            PG8_LDB(B0, 0, 0); PG8_LDB(B1, 0, 1); PG8_SCHED; PG8_LDA(At, 0, 0); PG8_STAGE(PG8_SA(1, 1), a1 + hstepA, voffA);
            PG8_WAIT_V(8); PG8_WAIT_L(0); PG8_BAR; PG8_MMA(0, 0, At, B0); PG8_MMA(0, 1, At, B1); PG8_BAR; PG8_SCHED;
            PG8_LDA(At, 0, 1); PG8_STAGE(PG8_SB(0, 0), b2, voffB); PG8_STAGE(PG8_SB(0, 1), b2 + hstepB, voffB); PG8_STAGE(PG8_SA(0, 0), a2, voffA);
            PG8_WAIT_V(8); PG8_WAIT_L(0); PG8_BAR; PG8_MMA(1, 0, At, B0); PG8_MMA(1, 1, At, B1); PG8_BAR; PG8_SCHED;
            PG8_LDB(B0, 1, 0); PG8_LDB(B1, 1, 1); PG8_SCHED; PG8_LDA(At, 1, 0); PG8_STAGE(PG8_SA(0, 1), a2 + hstepA, voffA);
            PG8_WAIT_V(8); PG8_WAIT_L(0); PG8_BAR; PG8_MMA(0, 0, At, B0); PG8_MMA(0, 1, At, B1); PG8_BAR; PG8_SCHED;
            PG8_LDA(At, 1, 1); PG8_STAGE(PG8_SB(1, 0), b3, voffB); PG8_STAGE(PG8_SB(1, 1), b3 + hstepB, voffB); PG8_STAGE(PG8_SA(1, 0), a3, voffA);
            PG8_WAIT_V(8); PG8_WAIT_L(0); PG8_BAR; PG8_MMA(1, 0, At, B0); PG8_MMA(1, 1, At, B1); PG8_BAR; PG8_SCHED;
        }
        if constexpr (ALIGN_EPI) { if (wr == 0) PG8_BAR; }
        E(acc, cur, wr, wc, fr, fq);
        if (!has_next) break;
#pragma unroll
        for (int a = 0; a < 2; ++a)
#pragma unroll
            for (int b = 0; b < 2; ++b)
#pragma unroll
                for (int m = 0; m < 4; ++m)
#pragma unroll
                    for (int n = 0; n < 2; ++n) acc[a][b][m][n] = (f32x4){0.f, 0.f, 0.f, 0.f};
        cur = nxt; cA = nA; cB = nB; ++ui;
        if constexpr (ALIGN_EPI) { if (wr == 1) PG8_BAR; }
    }
    PG8_WAIT_V(0);
    if constexpr (!ALIGN_EPI) { if (wr == 0) PG8_BAR; }
    PG8_BAR;
#undef KOFFA
#undef PG8_SA
#undef PG8_SB
#undef PG8_STAGE
#undef PG8_LDA
#undef PG8_LDB
#undef PG8_MMA
#undef PG8_WAIT_V
#undef PG8_WAIT_L
#undef PG8_BAR
#undef PG8_SCHED
}
}

typedef GAS unsigned gu32;
#define RLX_AGENT __ATOMIC_RELAXED, __HIP_MEMORY_SCOPE_AGENT
#define XB_TMO      128
#define XB_XCNT(j)  (256  + 64 * (j))
#define XB_XSUB(j)  (1280 + 64 * (j))
#define XB_XGEN(j)  (2304 + 64 * (j))
#define XB_TOP      3328
#define XB_TOPGEN   3392
#define XCD_BAR_WORDS 3456
#define XB_SPIN_CAP (1u << 18)
__device__ __forceinline__ unsigned xb_ld(unsigned* p)              { return __hip_atomic_load(p, __ATOMIC_RELAXED, __HIP_MEMORY_SCOPE_AGENT); }
__device__ __forceinline__ unsigned xb_add(unsigned* p, unsigned v) { return __hip_atomic_fetch_add(p, v, __ATOMIC_RELAXED, __HIP_MEMORY_SCOPE_AGENT); }
__device__ __forceinline__ unsigned xb_xcc_id() { return (unsigned)__builtin_amdgcn_s_getreg((3 << 11) | 20) & 0xFu; }
#define XB_SPIN(cond, bar) do { unsigned _sp = 0; while (cond) { __builtin_amdgcn_s_sleep(1); \
    if ((++_sp & 255u) == 0u) { if (xb_ld(&(bar)[XB_TMO])) break; if (_sp > XB_SPIN_CAP) { atomicAdd(&(bar)[XB_TMO], 1u); break; } } } } while (0)
struct XcdBarrier { unsigned* bar; unsigned x; volatile LAS unsigned* st; };
__device__ __forceinline__ XcdBarrier xcd_barrier_post(unsigned* bar, volatile LAS unsigned* st) {
    XcdBarrier b; b.bar = bar; b.x = xb_xcc_id(); b.st = st;
    if (threadIdx.x == 0) (void)xb_add(&bar[XB_XCNT(b.x)], 1u);
    return b;
}
__device__ __forceinline__ void xcd_barrier_complete(unsigned* bar, unsigned x, unsigned& nloc, unsigned& nx) {
    const unsigned G = gridDim.x * gridDim.y * gridDim.z;
    unsigned sum, cnt, mine, sp = 0u;
    for (;;) {
        sum = 0u; cnt = 0u; mine = 0u;
#pragma unroll
        for (unsigned j = 0; j < 16; ++j) { const unsigned c = xb_ld(&bar[XB_XCNT(j)]); sum += c; cnt += (c > 0u) ? 1u : 0u; mine = (j == x) ? c : mine; }
        if (sum == G) break;
        __builtin_amdgcn_s_sleep(1);
        if ((++sp & 255u) == 0u) { if (xb_ld(&bar[XB_TMO])) break; if (sp > XB_SPIN_CAP) { atomicAdd(&bar[XB_TMO], 1u); break; } }
    }
    nloc = mine > 0u ? mine : 1u; nx = cnt > 0u ? cnt : 1u;
}
__device__ __forceinline__ void xcd_barrier(const XcdBarrier& b) {
    asm volatile("s_waitcnt vmcnt(0)" ::: "memory");
    __syncthreads();
    if (threadIdx.x == 0) {
        unsigned* bar = b.bar;
        __builtin_amdgcn_s_waitcnt(0);
        unsigned nloc = b.st[0], nx = b.st[1];
        if (nloc == 0u) { xcd_barrier_complete(bar, b.x, nloc, nx); b.st[0] = nloc; b.st[1] = nx; }
        const unsigned old = xb_add(&bar[XB_XSUB(b.x)], 1u);
        const unsigned gen = old / nloc;
        if (old + 1u == (gen + 1u) * nloc) {
            __builtin_amdgcn_fence(__ATOMIC_RELEASE, "agent");
            asm volatile("s_waitcnt vmcnt(0)" ::: "memory");
            const unsigned og = xb_add(&bar[XB_TOP], 1u);
            const unsigned tg = og / nx;
            if (og + 1u == (tg + 1u) * nx) xb_add(&bar[XB_TOPGEN], 1u);
            else XB_SPIN(xb_ld(&bar[XB_TOPGEN]) == tg, bar);
            __builtin_amdgcn_fence(__ATOMIC_ACQUIRE, "agent");
            xb_add(&bar[XB_XGEN(b.x)], 1u);
            asm volatile("s_waitcnt vmcnt(0)" ::: "memory");
        } else {
            XB_SPIN(xb_ld(&bar[XB_XGEN(b.x)]) == gen, bar);
            __builtin_amdgcn_fence(__ATOMIC_ACQUIRE, "agent");
            asm volatile("s_waitcnt vmcnt(0)" ::: "memory");
        }
    }
    __syncthreads();
}

struct Args {
    const float *x_prompt, *x_sample, *cache_k, *cache_v, *state_ssm, *state_conv, *norm_w, *w_in, *conv_w, *conv_b,
                *dt_bias, *a_log, *d_skip, *ssm_norm_w, *q_norm_w, *k_norm_w, *sinks, *rel_table, *w_out;
    float* out; unsigned char* ws; int ph_lo, ph_hi, sub, dry;
};
constexpr int NWAVES = 8, NT = 512;
constexpr int RING_BYTES = 131072, LDS_BYTES = 147456, MISC_OFF = LDS_BYTES - 512;

template <bool REMAP>
__device__ __forceinline__ void p0_transpose_item(const float* W, int K, int N, bf16_t* WT, LAS bf16_t* scr, int item, int lane) {
    const int nblk = (N + 63) / 64, kb = item / nblk, nb = item % nblk, k0 = 64 * kb, n0 = 64 * nb;
    const bool nok = (n0 + lane) < N;
    const float* wp = W + (size_t)k0 * N + n0 + (nok ? lane : 0);
    float v[64];
#pragma unroll
    for (int kk = 0; kk < 64; ++kk) v[kk] = __builtin_nontemporal_load(wp + (size_t)kk * N);
#pragma unroll
    for (int kk = 0; kk < 64; kk += 2) *(LAS unsigned*)(scr + lane * 68 + kk) = pk2(v[kk], v[kk + 1]);
    LDS_WAIT(); asm volatile("" ::: "memory");
    const int c = lane & 7;
#pragma unroll
    for (int j = 0; j < 8; ++j) { const int n = (lane >> 3) + 8 * j;
        const u32x2 lo = *(const LAS u32x2*)(scr + n * 68 + 8 * c), hi = *(const LAS u32x2*)(scr + n * 68 + 8 * c + 4);
        u32x4 o; o.x = lo.x; o.y = lo.y; o.z = hi.x; o.w = hi.y;
        int ng = n0 + n;
        if (ng < N) { if (REMAP) ng = (ng < 2560) ? ng : (ng < 2576 ? ng + 2560 : ng - 16);
            st_wt16(WT + (size_t)ng * K + k0 + 8 * c, o); } }
    LDS_WAIT(); asm volatile("" ::: "memory");
}
__device__ __forceinline__ void p0_prologue(const Args& a, LAS unsigned char* lds, int vcu, int G, int wave, int lane, unsigned long long& amp_d) {
    unsigned long long amp_t = 0ull;
#define AMPB(k) do { if (MK_AMP == (k)) amp_t = __builtin_amdgcn_s_memrealtime(); } while (0)
#define AMPE(k) do { if (MK_AMP == (k)) { __syncthreads(); amp_d += __builtin_amdgcn_s_memrealtime() - amp_t; } } while (0)
    AMPB(100);
    LAS bf16_t* scr = (LAS bf16_t*)(lds + wave * 16384);
    bf16_t* WinT = (bf16_t*)(a.ws + WS_WIN); bf16_t* WoutT = (bf16_t*)(a.ws + WS_WOUT); bf16_t* H = (bf16_t*)(a.ws + WS_H);
    const int gw = vcu * NWAVES + wave, NGW = G * NWAVES;
    constexpr int I_IN = (DM / 64) * ((NIN + 63) / 64), I_OUT = (2048 / 64) * (DM / 64);
    for (int it = gw; it < I_IN + I_OUT; it += NGW) {
        if (it < I_IN) p0_transpose_item<true>(a.w_in, DM, NIN, WinT, scr, it, lane);
        else p0_transpose_item<false>(a.w_out, 2048, DM, WoutT, scr, it - I_IN, lane);
    }
    AMPE(100); AMPB(101);
    for (int r = gw; r < NINP - NIN; r += NGW) { u32x4* p = (u32x4*)(WinT + (size_t)(NIN + r) * DM); p[lane] = (u32x4){0u, 0u, 0u, 0u}; p[lane + 64] = (u32x4){0u, 0u, 0u, 0u}; }
    f32x4 nw[4];
#pragma unroll
    for (int j = 0; j < 4; ++j) nw[j] = ((const f32x4*)a.norm_w)[lane + 64 * j];
    f32x4 vn[4][4];
#define P0_LOAD(dst, mb) do { _Pragma("unroll") for (int r = 0; r < 4; ++r) { const int m = (mb) + r * NGW; \
        if (m < MT) { const float* xrow = (m < MP) ? a.x_prompt + (size_t)m * DM : a.x_sample + (size_t)(m - MP) * DM; const f32x4* xr = (const f32x4*)xrow + lane; \
            _Pragma("unroll") for (int j = 0; j < 4; ++j) dst[r][j] = __builtin_nontemporal_load(xr + 64 * j); } } } while (0)
    P0_LOAD(vn, gw);
    for (int m0 = gw; m0 < MT; m0 += 4 * NGW) {
        f32x4 v[4][4];
#pragma unroll
        for (int r = 0; r < 4; ++r)
#pragma unroll
            for (int j = 0; j < 4; ++j) v[r][j] = vn[r][j];
        if (m0 + 4 * NGW < MT) P0_LOAD(vn, m0 + 4 * NGW);
#pragma unroll
        for (int r = 0; r < 4; ++r) { const int m = m0 + r * NGW;
            if (m < MT) { float s = 0.f;
#pragma unroll
                for (int j = 0; j < 4; ++j) s += (v[r][j].x * v[r][j].x + v[r][j].y * v[r][j].y) + (v[r][j].z * v[r][j].z + v[r][j].w * v[r][j].w);
                const float rstd = __builtin_amdgcn_rsqf(wave_sum(s) * (1.f / DM) + EPS);
                unsigned long long* o8 = (unsigned long long*)(H + (size_t)m * DM) + lane;
#pragma unroll
                for (int j = 0; j < 4; ++j) { const f32x4 h = v[r][j] * rstd * nw[j]; u32x2 hw; hw.x = pk2(h.x, h.y); hw.y = pk2(h.z, h.w); st_wt8(o8 + 64 * j, hw); } } }
    }
#undef P0_LOAD
    AMPE(101);
#undef AMPB
#undef AMPE
}

__device__ __forceinline__ float ssd_dt_scan(const float* DT, int R0, int h, int e, int lane, const float* dt_bias, const float* a_log, LAS float* dtv, LAS float* acum, float& d0o, float& d1o, float& c0o, float& c1o) {
    const float bias = dt_bias[h]; const float A = -expf(a_log[h]);
    const int l0 = 2 * lane;
    const float d0 = softplus_f(DT[(size_t)(R0 + l0) * 16 + h] + bias), d1 = softplus_f(DT[(size_t)(R0 + l0 + 1) * 16 + h] + bias);
    const float a0 = d0 * A, a1 = d1 * A; float s = a0 + a1;
#pragma unroll
    for (int o = 1; o < 64; o <<= 1) { const float t = __shfl_up(s, o); if (lane >= o) s += t; }
    const float excl = s - (a0 + a1);
    const float c0 = excl + a0, c1 = excl + a0 + a1;
    dtv[e * 128 + l0] = d0; dtv[e * 128 + l0 + 1] = d1; acum[e * 128 + l0] = c0; acum[e * 128 + l0 + 1] = c1;
    d0o = d0; d1o = d1; c0o = c0; c1o = c1;
    return __shfl(s, 63);
}

typedef short v4i16_t __attribute__((ext_vector_type(4)));
__device__ __forceinline__ u32x2 lds_tr16(const LAS bf16_t* p) { return __builtin_bit_cast(u32x2, __builtin_amdgcn_ds_read_tr16_b64_v4i16((LAS v4i16_t*)p)); }
struct ConvRaw { u32x4 r[5]; };
__device__ __forceinline__ void conv_load(const bf16_t* U, const bf16_t* HALO, int R0, int gc, int c, int chb, int tid, ConvRaw& o) {
    const int q = tid & 7, r = tid >> 3;
#pragma unroll
    for (int i = 0; i < 5; ++i) {
        const int rr = 2 * r - 3 + i;
        u32x4 v = (u32x4){0u, 0u, 0u, 0u};
        if (rr >= 0) v = *(const u32x4*)(U + (size_t)(R0 + rr) * UW + C_X + chb + 8 * q);
        else if (c > 0) v = *(const u32x4*)(HALO + (size_t)((gc - 1) * 3 + 3 + rr) * CONVD + chb + 8 * q);
        o.r[i] = v;
    }
}
__device__ __forceinline__ void conv_apply(const ConvRaw& in, const LAS float* cw, int lc, float (&o0)[8], float (&o1)[8]) {
    float x[5][8];
#pragma unroll
    for (int i = 0; i < 5; ++i) { const u32x4 v = in.r[i]; x[i][0] = bflo(v.x); x[i][1] = bfhi(v.x); x[i][2] = bflo(v.y); x[i][3] = bfhi(v.y); x[i][4] = bflo(v.z); x[i][5] = bfhi(v.z); x[i][6] = bflo(v.w); x[i][7] = bfhi(v.w); }
    float w[5][8];
#pragma unroll
    for (int t = 0; t < 5; ++t) { const f32x4 a0 = *(const LAS f32x4*)(cw + t * 768 + lc), a1 = *(const LAS f32x4*)(cw + t * 768 + lc + 4);
        w[t][0] = a0.x; w[t][1] = a0.y; w[t][2] = a0.z; w[t][3] = a0.w; w[t][4] = a1.x; w[t][5] = a1.y; w[t][6] = a1.z; w[t][7] = a1.w; }
#pragma unroll
    for (int i = 0; i < 8; ++i) {
        o0[i] = silu_f(w[4][i] + w[0][i] * x[0][i] + w[1][i] * x[1][i] + w[2][i] * x[2][i] + w[3][i] * x[3][i]);
        o1[i] = silu_f(w[4][i] + w[0][i] * x[1][i] + w[1][i] * x[2][i] + w[2][i] * x[3][i] + w[3][i] * x[4][i]);
    }
}
__device__ __forceinline__ u32x4 pack8(const float (&v)[8]) { u32x4 w; w.x = pk2(v[0], v[1]); w.y = pk2(v[2], v[3]); w.z = pk2(v[4], v[5]); w.w = pk2(v[6], v[7]); return w; }

__device__ __forceinline__ void ssd_state_item(const Args& a, LAS unsigned char* lds, int item, int tid, int wave, int lane, const bool dry = false) {
    const int b = item >> 7, c = (item >> 1) & 63, g = item & 1, gc = b * 64 + c;
    const int R0 = b * SEQ + c * 128;
    bf16_t* U = (bf16_t*)(a.ws + WS_U); const float* DT = (const float*)(a.ws + WS_DT); const bf16_t* HALO = (const bf16_t*)(a.ws + WS_HALO);
    bf16_t* ST = (bf16_t*)(a.ws + WS_ST); float* DEC = (float*)(a.ws + WS_DEC);
    LAS bf16_t* Bn = (LAS bf16_t*)lds;
    LAS bf16_t* Xw0 = (LAS bf16_t*)(lds + 34816);
    LAS float* dtv = (LAS float*)(lds + 71680); LAS float* acum = dtv + 1024; LAS float* wv = acum + 1024;
    LAS float* cw = (LAS float*)(lds + 83968);
    auto blk_chb = [&](int k) -> int { return (k < 2) ? (1024 + 128 * g + 64 * k) : (k < 4) ? (1280 + 128 * g + 64 * (k - 2)) : (512 * g + 64 * (k - 4)); };
    auto blk_lc = [&](int k) -> int { return (k < 2) ? (512 + 64 * k) : (k < 4) ? (640 + 64 * (k - 2)) : (64 * (k - 4)); };
    ConvRaw raw; conv_load(U, HALO, R0, gc, c, blk_chb(0), tid, raw);
    for (int i = tid; i < 5 * 768; i += NT) { const int t = i / 768, lc = i % 768; const int ch = (lc < 512) ? (512 * g + lc) : (lc < 640) ? (1024 + 128 * g + (lc - 512)) : (1280 + 128 * g + (lc - 640));
        cw[i] = (t < 4) ? a.conv_w[t * CONVD + ch] : a.conv_b[ch]; }
    {
        float d0, d1, c0, c1; const int h = 8 * g + wave;
        const float aend = ssd_dt_scan(DT, R0, h, wave, lane, a.dt_bias, a.a_log, dtv, acum, d0, d1, c0, c1);
        wv[wave * 128 + 2 * lane] = d0 * __expf(aend - c0); wv[wave * 128 + 2 * lane + 1] = d1 * __expf(aend - c1);
        if (lane == 0 && !dry) DEC[gc * 16 + h] = __expf(aend);
    }
    __syncthreads();
    if (!dry) ((f32x4*)(a.ws + WS_DTA))[(size_t)item * 512 + tid] = ((const LAS f32x4*)dtv)[tid];
    const int fr = lane & 15, grp = lane >> 4, q = tid & 7, r = tid >> 3;
#pragma unroll 1
    for (int k = 0; k < 12; ++k) {
        ConvRaw cur = raw;
        if (k + 1 < 12) conv_load(U, HALO, R0, gc, c, blk_chb(k + 1), tid, raw);
        float o0[8], o1[8];
        if (dry && MK_ABL == 22) {
#pragma unroll
            for (int i = 0; i < 8; ++i) { o0[i] = bflo(cur.r[0].x) + i; o1[i] = bfhi(cur.r[4].w) + i; } }
        else conv_apply(cur, cw, blk_lc(k) + 8 * q, o0, o1);
        const u32x4 p0 = pack8(o0), p1 = pack8(o1);
        __syncthreads();
        bf16_t* up = U + (size_t)(R0 + 2 * r) * UW + C_X + blk_chb(k) + 8 * q;
        if (!dry || p0.x == 0x12345678u) { *(u32x4*)up = p0; *(u32x4*)(up + UW) = p1; }
        if (k < 2) { *(LAS u32x4*)(Bn + (2 * r) * 136 + 64 * k + 8 * q) = p0; *(LAS u32x4*)(Bn + (2 * r + 1) * 136 + 64 * k + 8 * q) = p1; }
        if (k >= 4) {
            const int e = k - 4, h = 8 * g + e;
            LAS bf16_t* Xw = Xw0 + (e & 1) * (128 * 72);
            const float w0 = wv[e * 128 + 2 * r], w1 = wv[e * 128 + 2 * r + 1];
#pragma unroll
            for (int i = 0; i < 8; ++i) { o0[i] *= w0; o1[i] *= w1; }
            *(LAS u32x4*)(Xw + (2 * r) * 72 + 8 * q) = pack8(o0); *(LAS u32x4*)(Xw + (2 * r + 1) * 72 + 8 * q) = pack8(o1);
            __syncthreads();
            if (dry && MK_ABL == 21) continue;
            f32x4 acc[4];
#pragma unroll
            for (int pt = 0; pt < 4; ++pt) acc[pt] = (f32x4){0.f, 0.f, 0.f, 0.f};
#pragma unroll
            for (int ks = 0; ks < 4; ++ks) {
                const int l0 = 32 * ks + 8 * grp + (fr >> 2);
                const u32x2 a0 = lds_tr16(Bn + l0 * 136 + 16 * wave + 4 * (fr & 3)), a1 = lds_tr16(Bn + (l0 + 4) * 136 + 16 * wave + 4 * (fr & 3));
                u32x2 b0[4], b1[4];
#pragma unroll
                for (int pt = 0; pt < 4; ++pt) { b0[pt] = lds_tr16(Xw + l0 * 72 + 16 * pt + 4 * (fr & 3)); b1[pt] = lds_tr16(Xw + (l0 + 4) * 72 + 16 * pt + 4 * (fr & 3)); }
                __builtin_amdgcn_sched_barrier(0);
                u32x4 aw; aw.x = a0.x; aw.y = a0.y; aw.z = a1.x; aw.w = a1.y;
#pragma unroll
                for (int pt = 0; pt < 4; ++pt) {
                    u32x4 bw; bw.x = b0[pt].x; bw.y = b0[pt].y; bw.z = b1[pt].x; bw.w = b1[pt].y;
                    acc[pt] = mfma16(__builtin_bit_cast(bf16x8, aw), __builtin_bit_cast(bf16x8, bw), acc[pt]);
                }
            }
            bf16_t* stp = ST + ((size_t)(gc * 16 + h) * 64) * 128 + 16 * wave + 4 * grp;
#pragma unroll
            for (int pt = 0; pt < 4; ++pt) { u32x2 o; o.x = pk2(acc[pt][0], acc[pt][1]); o.y = pk2(acc[pt][2], acc[pt][3]); if (!dry || o.x == 0x12345678u) *(u32x2*)(stp + (size_t)(16 * pt + fr) * 128) = o; }
        }
    }
    __syncthreads();
}

__device__ __forceinline__ void ssd_scan(const Args& a, LAS unsigned char* lds, int bx, int G, int tid, int wave, int lane, const bool dry) {
    u32x4* ST = (u32x4*)(a.ws + WS_ST); const float* DEC = (const float*)(a.ws + WS_DEC);
    LAS float* agg = (LAS float*)lds;
    const int seg = wave >> 1, gl = (wave & 1) * 64 + lane;
    for (int blk = bx; blk < NB * 16 * 8; blk += G) {
        const int bh = blk >> 3, b = bh >> 4, h = bh & 15, g8 = (blk & 7) * 128 + gl;
        u32x4* p = ST + ((size_t)(b * 64 + 16 * seg) * 16 + h) * 1024 + g8;
        const float* dp = DEC + (b * 64) * 16 + h;
        u32x4 v[16]; float d[16];
#pragma unroll
        for (int c = 0; c < 16; ++c) v[c] = p[(size_t)c * 16 * 1024];
        float pr[4];
#pragma unroll
        for (int s4 = 0; s4 < 4; ++s4) { float q = 1.f;
#pragma unroll
            for (int c = 0; c < 16; ++c) { const float dd = dp[(16 * s4 + c) * 16]; q *= dd; if (s4 == seg) d[c] = dd; }
            pr[s4] = q; }
        float cr[8];
#pragma unroll
        for (int i = 0; i < 8; ++i) cr[i] = 0.f;
#pragma unroll
        for (int c = 0; c < 16; ++c) { const u32x4 w = v[c]; const float f[8] = {bflo(w.x), bfhi(w.x), bflo(w.y), bfhi(w.y), bflo(w.z), bfhi(w.z), bflo(w.w), bfhi(w.w)};
#pragma unroll
            for (int i = 0; i < 8; ++i) cr[i] = cr[i] * d[c] + f[i]; }
        __syncthreads();
        *(LAS f32x4*)(agg + (seg * 128 + gl) * 8) = (f32x4){cr[0], cr[1], cr[2], cr[3]}; *(LAS f32x4*)(agg + (seg * 128 + gl) * 8 + 4) = (f32x4){cr[4], cr[5], cr[6], cr[7]};
        __syncthreads();
        float cin[8];
#pragma unroll
        for (int i = 0; i < 8; ++i) cin[i] = 0.f;
#pragma unroll
        for (int s4 = 0; s4 < 3; ++s4) if (s4 < seg) { const f32x4 a0 = *(const LAS f32x4*)(agg + (s4 * 128 + gl) * 8), a1 = *(const LAS f32x4*)(agg + (s4 * 128 + gl) * 8 + 4);
            const float av[8] = {a0.x, a0.y, a0.z, a0.w, a1.x, a1.y, a1.z, a1.w};
#pragma unroll
            for (int i = 0; i < 8; ++i) cin[i] = cin[i] * pr[s4] + av[i]; }
#pragma unroll
        for (int c = 0; c < 16; ++c) { const u32x4 w = v[c]; const float f[8] = {bflo(w.x), bfhi(w.x), bflo(w.y), bfhi(w.y), bflo(w.z), bfhi(w.z), bflo(w.w), bfhi(w.w)};
            u32x4 o; o.x = pk2(cin[0], cin[1]); o.y = pk2(cin[2], cin[3]); o.z = pk2(cin[4], cin[5]); o.w = pk2(cin[6], cin[7]);
            if (!dry) p[(size_t)c * 16 * 1024] = o;
#pragma unroll
            for (int i = 0; i < 8; ++i) cin[i] = cin[i] * d[c] + f[i]; }
        if (seg == 3 && (!dry || cin[0] == 12345.678f)) { float* o = a.out + O_SP + (size_t)bh * 8192 + 8 * g8;
            *(f32x4*)o = (f32x4){cin[0], cin[1], cin[2], cin[3]}; *(f32x4*)(o + 4) = (f32x4){cin[4], cin[5], cin[6], cin[7]}; }
    }
}

struct HeadRegs { u32x4 x[2], s[2]; u32x2 z[4]; };
__device__ __forceinline__ void ssd_out_load(const bf16_t* U, const bf16_t* ST, int R0, int gc, int h, int tid, int l, int grp, HeadRegs& o) {
#pragma unroll
    for (int i = 0; i < 2; ++i) { const int ci = tid + NT * i;
        o.x[i] = *(const u32x4*)(U + (size_t)(R0 + (ci >> 3)) * UW + C_X + 64 * h + 8 * (ci & 7));
        o.s[i] = *(const u32x4*)(ST + ((size_t)(gc * 16 + h) * 64 + (ci >> 4)) * 128 + 8 * (ci & 15)); }
    const bf16_t* zrow = U + (size_t)(R0 + l) * UW + C_Z + 64 * h + 4 * grp;
#pragma unroll
    for (int pt = 0; pt < 4; ++pt) o.z[pt] = *(const u32x2*)(zrow + 16 * pt);
}
__device__ __forceinline__ void ssd_out_stage(const HeadRegs& in, LAS bf16_t* X, LAS bf16_t* St, int tid) {
#pragma unroll
    for (int i = 0; i < 2; ++i) { const int ci = tid + NT * i;
        *(LAS u32x4*)(X + (ci >> 3) * 72 + 8 * (ci & 7)) = in.x[i];
        *(LAS u32x4*)(St + (ci >> 4) * 136 + 8 * (ci & 15)) = in.s[i]; }
}
__device__ __forceinline__ void ssd_out_item(const Args& a, LAS unsigned char* lds, int item, int tid, int wave, int lane, const bool dry) {
    const int b = item >> 7, c = (item >> 1) & 63, g = item & 1, gc = b * 64 + c;
    const int R0 = b * SEQ + c * 128;
    bf16_t* U = (bf16_t*)(a.ws + WS_U); const float* DT = (const float*)(a.ws + WS_DT); const bf16_t* ST = (const bf16_t*)(a.ws + WS_ST);
    LAS bf16_t* Cn = (LAS bf16_t*)lds;
    LAS bf16_t* setA = (LAS bf16_t*)(lds + 34816);
    LAS bf16_t* setB = (LAS bf16_t*)(lds + 70656);
    LAS bf16_t* Bn = setB;
    LAS float* dtv = (LAS float*)(lds + 106496); LAS float* acum = dtv + 1024;
    const int fr = lane & 15, grp = lane >> 4;
    const int l = 16 * wave + fr;
    HeadRegs hr; ssd_out_load(U, ST, R0, gc, 8 * g, tid, l, grp, hr);
    {
        u32x4 bv[4], cv[4];
#pragma unroll
        for (int i = 0; i < 4; ++i) { const int ci = tid + NT * i; const bf16_t* rp = U + (size_t)(R0 + (ci >> 4)) * UW + 128 * g + 8 * (ci & 15); bv[i] = *(const u32x4*)(rp + C_B); cv[i] = *(const u32x4*)(rp + C_C); }
        const f32x4 dta = ((const f32x4*)(a.ws + WS_DTA))[(size_t)item * 512 + tid];
#pragma unroll
        for (int i = 0; i < 4; ++i) { const int ci = tid + NT * i; *(LAS u32x4*)(Bn + (ci >> 4) * 136 + 8 * (ci & 15)) = bv[i]; *(LAS u32x4*)(Cn + (ci >> 4) * 136 + 8 * (ci & 15)) = cv[i]; }
        ((LAS f32x4*)dtv)[tid] = dta;
    }
    ssd_out_stage(hr, setA, setA + 128 * 72, tid);
    u32x2 zc[4];
#pragma unroll
    for (int pt = 0; pt < 4; ++pt) zc[pt] = hr.z[pt];
    __syncthreads();
    f32x4 cb[8];
#pragma unroll
    for (int st = 0; st < 8; ++st) cb[st] = (f32x4){0.f, 0.f, 0.f, 0.f};
#pragma unroll
    for (int ks = 0; ks < 4; ++ks) {
        const bf16x8 cf = *(const LAS bf16x8*)(Cn + (16 * wave + fr) * 136 + 32 * ks + 8 * grp);
#pragma unroll
        for (int st = 0; st < 8; ++st) if (st <= wave) { const bf16x8 bfm = *(const LAS bf16x8*)(Bn + (16 * st + fr) * 136 + 32 * ks + 8 * grp); cb[st] = mfma16(bfm, cf, cb[st]); }
    }
    __syncthreads();
    float ssq = 0.f;
    LAS bf16_t* stg = (LAS bf16_t*)(lds + 114688) + wave * (16 * 64);
    bf16_t* yb = U + (size_t)(R0 + 16 * wave) * UW + C_Z + 512 * g;
    const int e_n = (dry && MK_ABL == 13) ? 0 : 8;
#pragma unroll 1
    for (int e = 0; e < e_n; ++e) {
        const int h = 8 * g + e;
        LAS bf16_t* X = (e & 1) ? setB : setA; LAS bf16_t* St = X + 128 * 72;
        if (e < 7) ssd_out_load(U, ST, R0, gc, h + 1, tid, l, grp, hr);
        f32x4 accd[4], acco[4];
#pragma unroll
        for (int pt = 0; pt < 4; ++pt) { accd[pt] = (f32x4){0.f, 0.f, 0.f, 0.f}; acco[pt] = (f32x4){0.f, 0.f, 0.f, 0.f}; }
        const float al = acum[e * 128 + l];
#pragma unroll
        for (int ks = 0; ks < 4; ++ks) {
            if (dry && MK_ABL == 11) break;
            const int sA = 32 * ks + 4 * grp, sB = sA + 16;
            const bool diag = (2 * ks <= wave);
            const bf16x8 cf = *(const LAS bf16x8*)(Cn + (16 * wave + fr) * 136 + 32 * ks + 8 * grp);
            bf16x8 sf[4];
#pragma unroll
            for (int pt = 0; pt < 4; ++pt) sf[pt] = *(const LAS bf16x8*)(St + (16 * pt + fr) * 136 + 32 * ks + 8 * grp);
            f32x4 acA = (f32x4){0.f, 0.f, 0.f, 0.f}, acB = acA, dtA = acA, dtB = acA; u32x2 xlo[4], xhi[4];
            if (diag) {
                acA = *(const LAS f32x4*)(acum + e * 128 + sA); acB = *(const LAS f32x4*)(acum + e * 128 + sB);
                dtA = *(const LAS f32x4*)(dtv + e * 128 + sA); dtB = *(const LAS f32x4*)(dtv + e * 128 + sB);
#pragma unroll
                for (int pt = 0; pt < 4; ++pt) { xlo[pt] = lds_tr16(X + (sA + (fr >> 2)) * 72 + 16 * pt + 4 * (fr & 3)); xhi[pt] = lds_tr16(X + (sB + (fr >> 2)) * 72 + 16 * pt + 4 * (fr & 3)); }
            }
            __builtin_amdgcn_sched_barrier(0);
            if (diag) {
                float m[8];
#pragma unroll
                for (int j = 0; j < 4; ++j) {
                    const float va = cb[2 * ks][j] * dtA[j] * __expf(al - acA[j]); m[j] = (sA + j <= l) ? va : 0.f;
                    const float vb = cb[2 * ks + 1][j] * dtB[j] * __expf(al - acB[j]); m[4 + j] = (sB + j <= l) ? vb : 0.f;
                }
                u32x4 mw; mw.x = pk2(m[0], m[1]); mw.y = pk2(m[2], m[3]); mw.z = pk2(m[4], m[5]); mw.w = pk2(m[6], m[7]);
                const bf16x8 mf = __builtin_bit_cast(bf16x8, mw);
#pragma unroll
                for (int pt = 0; pt < 4; ++pt) {
                    u32x4 aw; aw.x = xlo[pt].x; aw.y = xlo[pt].y; aw.z = xhi[pt].x; aw.w = xhi[pt].y;
                    accd[pt] = mfma16(__builtin_bit_cast(bf16x8, aw), mf, accd[pt]);
                }
            }
#pragma unroll
            for (int pt = 0; pt < 4; ++pt) acco[pt] = mfma16(sf[pt], cf, acco[pt]);
        }
        const float eal = __expf(al), dsk = a.d_skip[h];
#pragma unroll
        for (int pt = 0; pt < 4; ++pt) {
            if (dry && MK_ABL == 12) break;
            const u32x2 zz = zc[pt];
            const u32x2 xx = *(const LAS u32x2*)(X + l * 72 + 16 * pt + 4 * grp);
            const float z[4] = {bflo(zz.x), bfhi(zz.x), bflo(zz.y), bfhi(zz.y)};
            const float xv[4] = {bflo(xx.x), bfhi(xx.x), bflo(xx.y), bfhi(xx.y)};
            float gy[4];
#pragma unroll
            for (int r = 0; r < 4; ++r) {
                const float y = accd[pt][r] + eal * acco[pt][r] + dsk * xv[r];
                gy[r] = y * silu_f(z[r]); ssq += gy[r] * gy[r];
            }
            u32x2 o; o.x = pk2(gy[0], gy[1]); o.y = pk2(gy[2], gy[3]);
            *(LAS u32x2*)(stg + fr * 64 + 8 * ((2 * pt + (grp >> 1)) ^ (fr & 7)) + 4 * (grp & 1)) = o;
        }
        LDS_WAIT(); asm volatile("" ::: "memory");
#pragma unroll
        for (int i = 0; i < 2; ++i) { const int row = 8 * i + (lane >> 3), ch = lane & 7;
            const u32x4 v = *(const LAS u32x4*)(stg + row * 64 + 8 * (ch ^ (row & 7)));
            if (!dry) *(u32x4*)(yb + (size_t)row * UW + 64 * e + 8 * ch) = v; }
        if (e < 7) {
            ssd_out_stage(hr, (e & 1) ? setA : setB, ((e & 1) ? setA : setB) + 128 * 72, tid);
#pragma unroll
            for (int pt = 0; pt < 4; ++pt) zc[pt] = hr.z[pt]; }
        __syncthreads();
    }
    ssq += __shfl_xor(ssq, 16); ssq += __shfl_xor(ssq, 32);
    const float rstd = __builtin_amdgcn_rsqf(ssq * (1.f / 512.f) + EPS);
    LAS float* rsw = (LAS float*)stg;
    if (grp == 0) rsw[fr] = rstd;
    LDS_WAIT(); asm volatile("" ::: "memory");
    const float rs0 = rsw[lane >> 3], rs1 = rsw[8 + (lane >> 3)];
#pragma unroll 2
    for (int e = 0; e < 8; ++e) {
        const int ch = lane & 7;
        const f32x4 nwa = *(const f32x4*)(a.ssm_norm_w + 512 * g + 64 * e + 8 * ch), nwb = *(const f32x4*)(a.ssm_norm_w + 512 * g + 64 * e + 8 * ch + 4);
#pragma unroll
        for (int i = 0; i < 2; ++i) { const int row = 8 * i + (lane >> 3); const float rs = i ? rs1 : rs0;
            bf16_t* p = yb + (size_t)row * UW + 64 * e + 8 * ch;
            const u32x4 v = *(const u32x4*)p;
            u32x4 o; o.x = pk2(bflo(v.x) * rs * nwa.x, bfhi(v.x) * rs * nwa.y); o.y = pk2(bflo(v.y) * rs * nwa.z, bfhi(v.y) * rs * nwa.w);
            o.z = pk2(bflo(v.z) * rs * nwb.x, bfhi(v.z) * rs * nwb.y); o.w = pk2(bflo(v.w) * rs * nwb.z, bfhi(v.w) * rs * nwb.w);
            if (!dry || o.x == 0x12345678u) *(u32x4*)p = o; }
    }
    __syncthreads();
}

__device__ __forceinline__ int rel_bucket(int d) {
    if (d < 16) return d;
    const int lg = 16 + (int)(logf((float)d * (1.0f / 16.0f)) * (16.0f / 2.0794415416798357f));
    return lg < 31 ? lg : 31;
}
struct AttnKV { u32x4 k[4], v[4]; };
__device__ __forceinline__ void attn_load_kv(const bf16_t* U, int unit, int tid, AttnKV& r) {
    const int b = unit >> 8, blk = (unit >> 2) & 63, kvh = unit & 3; const int R0 = b * SEQ + blk * 128;
    const int j = tid >> 1, hf = tid & 1;
    const bool z = (blk == 0 && j < 128);
    const bf16_t* rp = U + (size_t)(R0 - 128 + (z ? 128 : j)) * UW + 64 * kvh + 32 * hf;
    const u32x4* kp = (const u32x4*)(rp + C_K); const u32x4* vp = (const u32x4*)(rp + C_V);
#pragma unroll
    for (int i = 0; i < 4; ++i) { r.k[i] = kp[i]; r.v[i] = vp[i]; }
}
typedef float f32x16 __attribute__((ext_vector_type(16)));
__device__ __forceinline__ f32x16 mfma32(bf16x8 a, bf16x8 b, f32x16 c) { return __builtin_amdgcn_mfma_f32_32x32x16_bf16(a, b, c, 0, 0, 0); }
__device__ __forceinline__ void attn_phase(const Args& a, LAS unsigned char* lds, int bx, int G, int tid, int wave, int lane, float m2, const bool dry, unsigned long long& amp_d) {
    unsigned long long amp_t = 0ull;
#define AMPB(k) do { if (MK_AMP == (k)) amp_t = __builtin_amdgcn_s_memrealtime(); } while (0)
#define AMPE(k) do { if (MK_AMP == (k)) amp_d += __builtin_amdgcn_s_memrealtime() - amp_t; } while (0)
    AMPB(210);
    bf16_t* U = (bf16_t*)(a.ws + WS_U);
    LAS bf16_t* Kn = (LAS bf16_t*)lds;
    LAS bf16_t* Vn = (LAS bf16_t*)(lds + 41472);
    LAS float* bias2 = (LAS float*)(lds + 82944);
    LAS float* qnw = (LAS float*)(lds + 95232);
    int unit = bx; if (unit >= 512) return;
    AttnKV kv; attn_load_kv(U, unit, tid, kv);
    __syncthreads();
    for (int i = tid; i < 16 * 192; i += NT) { const int hh = i / 192, t = i % 192, d = 128 - (t - 32); bias2[i] = (d >= 0 && d <= 128) ? a.rel_table[rel_bucket(d) * 16 + hh] * LOG2E - m2 : -1e30f; }
    if (tid < 288) { *(LAS u32x4*)(Kn + 256 * 72 + tid * 8) = (u32x4){0u, 0u, 0u, 0u}; *(LAS u32x4*)(Vn + 256 * 72 + tid * 8) = (u32x4){0u, 0u, 0u, 0u}; }
    if (tid < 64) qnw[tid] = a.q_norm_w[tid] * (0.125f * LOG2E);
    const int r32 = lane & 31, hh = lane >> 5;
    while (unit < 512) {
        const int b = unit >> 8, blk = (unit >> 2) & 63, kvh = unit & 3;
        const int R0 = b * SEQ + blk * 128;
        const int gq = wave >> 1, hq = 4 * kvh + gq;
        u32x4 qraw[2][4];
#pragma unroll
        for (int qt = 0; qt < 2; ++qt) {
            const bf16_t* qrow = U + (size_t)(R0 + 64 * (wave & 1) + 32 * qt + r32) * UW + C_Q + 64 * hq + 8 * hh;
#pragma unroll
            for (int ks = 0; ks < 4; ++ks) qraw[qt][ks] = *(const u32x4*)(qrow + 16 * ks);
        }
        {
            const int j = tid >> 1, hf = tid & 1;
            const bool zero = (blk == 0 && j < 128);
            f32x4 kf[8];
#pragma unroll
            for (int i = 0; i < 4; ++i) { const u32x4 w = kv.k[i]; kf[2 * i] = (f32x4){bflo(w.x), bfhi(w.x), bflo(w.y), bfhi(w.y)}; kf[2 * i + 1] = (f32x4){bflo(w.z), bfhi(w.z), bflo(w.w), bfhi(w.w)}; }
            float ss = 0.f;
#pragma unroll
            for (int i = 0; i < 8; ++i) ss += (kf[i].x * kf[i].x + kf[i].y * kf[i].y) + (kf[i].z * kf[i].z + kf[i].w * kf[i].w);
            ss += __shfl_xor(ss, 1);
            const float rstd = zero ? 0.f : __builtin_amdgcn_rsqf(ss * (1.f / 64.f) + EPS);
#pragma unroll
            for (int i = 0; i < 8; ++i) { const f32x4 w = *(const f32x4*)(a.k_norm_w + 32 * hf + 4 * i); kf[i] = kf[i] * rstd * w; }
#pragma unroll
            for (int i = 0; i < 4; ++i) { u32x4 w; w.x = pk2(kf[2 * i].x, kf[2 * i].y); w.y = pk2(kf[2 * i].z, kf[2 * i].w); w.z = pk2(kf[2 * i + 1].x, kf[2 * i + 1].y); w.w = pk2(kf[2 * i + 1].z, kf[2 * i + 1].w);
                *(LAS u32x4*)(Kn + j * 72 + 32 * hf + 8 * i) = w;
                u32x4 vw = kv.v[i]; if (zero) vw = (u32x4){0u, 0u, 0u, 0u};
                *(LAS u32x4*)(Vn + j * 72 + 32 * hf + 8 * i) = vw; }
            if (blk == 63 && j >= 128 && !dry) {
                float* ok = a.out + O_KP + ((size_t)(b * 128 + (j - 128)) * 4 + kvh) * 64 + 32 * hf; float* ov = a.out + O_VP + ((size_t)(b * 128 + (j - 128)) * 4 + kvh) * 64 + 32 * hf;
#pragma unroll
                for (int i = 0; i < 8; ++i) *(f32x4*)(ok + 4 * i) = kf[i];
#pragma unroll
                for (int i = 0; i < 4; ++i) { const u32x4 w = kv.v[i]; *(f32x4*)(ov + 8 * i) = (f32x4){bflo(w.x), bfhi(w.x), bflo(w.y), bfhi(w.y)}; *(f32x4*)(ov + 8 * i + 4) = (f32x4){bflo(w.z), bfhi(w.z), bflo(w.w), bfhi(w.w)}; }
            }
        }
        const int nxt = unit + G;
        if (nxt < 512) attn_load_kv(U, nxt, tid, kv);
        __syncthreads();
        AMPE(210); AMPB(211);
        const float sink2 = a.sinks[hq] * LOG2E;
#pragma unroll
        for (int qt = 0; qt < 2; ++qt) {
            if (dry && MK_ABL == 2) break;
            const int i0 = 64 * (wave & 1) + 32 * qt, iq = i0 + r32;
            bf16_t* qrow = U + (size_t)(R0 + iq) * UW + C_Q + 64 * hq;
            u32x2 zraw[8];
            { const bf16_t* zrow = U + (size_t)(R0 + iq) * UW + C_ZA + 64 * hq + 4 * hh;
#pragma unroll
              for (int i = 0; i < 8; ++i) zraw[i] = *(const u32x2*)(zrow + 8 * i); }
            bf16x8 qf[4];
            {
                float qv[4][8]; float ss = 0.f;
#pragma unroll
                for (int ks = 0; ks < 4; ++ks) { const u32x4 w = qraw[qt][ks];
                    qv[ks][0] = bflo(w.x); qv[ks][1] = bfhi(w.x); qv[ks][2] = bflo(w.y); qv[ks][3] = bfhi(w.y); qv[ks][4] = bflo(w.z); qv[ks][5] = bfhi(w.z); qv[ks][6] = bflo(w.w); qv[ks][7] = bfhi(w.w);
#pragma unroll
                    for (int i = 0; i < 8; ++i) ss += qv[ks][i] * qv[ks][i]; }
                ss += __shfl_xor(ss, 32);
                const float rs = __builtin_amdgcn_rsqf(ss * (1.f / 64.f) + EPS);
#pragma unroll
                for (int ks = 0; ks < 4; ++ks) { const f32x4 w0 = *(const LAS f32x4*)(qnw + 16 * ks + 8 * hh), w1 = *(const LAS f32x4*)(qnw + 16 * ks + 8 * hh + 4);
                    u32x4 p; p.x = pk2(qv[ks][0] * rs * w0.x, qv[ks][1] * rs * w0.y); p.y = pk2(qv[ks][2] * rs * w0.z, qv[ks][3] * rs * w0.w);
                    p.z = pk2(qv[ks][4] * rs * w1.x, qv[ks][5] * rs * w1.y); p.w = pk2(qv[ks][6] * rs * w1.z, qv[ks][7] * rs * w1.w);
                    qf[ks] = __builtin_bit_cast(bf16x8, p); }
            }
            f32x16 oacc[2];
#pragma unroll
            for (int dt = 0; dt < 2; ++dt)
#pragma unroll
                for (int r = 0; r < 16; ++r) oacc[dt][r] = 0.f;
            float lsum = 0.f;
            const int kk_n = (dry && MK_ABL == 1) ? 0 : 5;
#pragma unroll 1
            for (int kk = 0; kk < kk_n; ++kk) {
                const int j0 = i0 + 32 * kk;
                bf16x8 kfr[4]; u32x2 vfr[2][2][2]; float btv[16];
#pragma unroll
                for (int ks = 0; ks < 4; ++ks) kfr[ks] = *(const LAS bf16x8*)(Kn + (j0 + r32) * 72 + 16 * ks + 8 * hh);
                const LAS float* bt = bias2 + hq * 192 + (32 * kk + 4 * hh - r32 + 32);
#pragma unroll
                for (int r = 0; r < 16; ++r) btv[r] = bt[(r & 3) + 8 * (r >> 2)];
                {   const int i16 = lane & 15, dsub = ((lane >> 4) & 1) * 16;
                    const LAS bf16_t* vb = Vn + (j0 + 4 * hh + (i16 >> 2)) * 72 + dsub + 4 * (i16 & 3);
#pragma unroll
                    for (int s2 = 0; s2 < 2; ++s2)
#pragma unroll
                        for (int dt = 0; dt < 2; ++dt) { vfr[s2][dt][0] = lds_tr16(vb + (16 * s2) * 72 + 32 * dt); vfr[s2][dt][1] = lds_tr16(vb + (16 * s2 + 8) * 72 + 32 * dt); }
                }
                __builtin_amdgcn_sched_barrier(0);
                f32x16 sacc;
#pragma unroll
                for (int r = 0; r < 16; ++r) sacc[r] = 0.f;
#pragma unroll
                for (int ks = 0; ks < 4; ++ks) sacc = mfma32(kfr[ks], qf[ks], sacc);
                float p[16];
#pragma unroll
                for (int r = 0; r < 16; ++r) p[r] = __builtin_amdgcn_exp2f(sacc[r] + btv[r]);
                if (blk == 0) {
#pragma unroll
                    for (int r = 0; r < 16; ++r) if (j0 + (r & 3) + 8 * (r >> 2) + 4 * hh < 128) p[r] = 0.f;
                }
#pragma unroll
                for (int r = 0; r < 16; ++r) lsum += p[r];
                u32x4 pw0, pw1;
                pw0.x = pk2(p[0], p[1]); pw0.y = pk2(p[2], p[3]); pw0.z = pk2(p[4], p[5]); pw0.w = pk2(p[6], p[7]);
                pw1.x = pk2(p[8], p[9]); pw1.y = pk2(p[10], p[11]); pw1.z = pk2(p[12], p[13]); pw1.w = pk2(p[14], p[15]);
                const bf16x8 pf0 = __builtin_bit_cast(bf16x8, pw0), pf1 = __builtin_bit_cast(bf16x8, pw1);
#pragma unroll
                for (int dt = 0; dt < 2; ++dt) {
                    u32x4 a0; a0.x = vfr[0][dt][0].x; a0.y = vfr[0][dt][0].y; a0.z = vfr[0][dt][1].x; a0.w = vfr[0][dt][1].y;
                    u32x4 a1; a1.x = vfr[1][dt][0].x; a1.y = vfr[1][dt][0].y; a1.z = vfr[1][dt][1].x; a1.w = vfr[1][dt][1].y;
                    oacc[dt] = mfma32(__builtin_bit_cast(bf16x8, a0), pf0, oacc[dt]);
                    oacc[dt] = mfma32(__builtin_bit_cast(bf16x8, a1), pf1, oacc[dt]);
                }
            }
            lsum += __shfl_xor(lsum, 32);
            const float rl = __builtin_amdgcn_rcpf(lsum + __builtin_amdgcn_exp2f(sink2 - m2));
#pragma unroll
            for (int dt = 0; dt < 2; ++dt)
#pragma unroll
                for (int g4 = 0; g4 < 4; ++g4) {
                    const u32x2 zz = zraw[4 * dt + g4];
                    u32x2 o; o.x = pk2(oacc[dt][4 * g4] * rl * silu_f(bflo(zz.x)), oacc[dt][4 * g4 + 1] * rl * silu_f(bfhi(zz.x))); o.y = pk2(oacc[dt][4 * g4 + 2] * rl * silu_f(bflo(zz.y)), oacc[dt][4 * g4 + 3] * rl * silu_f(bfhi(zz.y)));
                    if (!dry || o.x == 0x12345678u) *(u32x2*)(qrow + 32 * dt + 8 * g4 + 4 * hh) = o;
                }
        }
        unit = nxt;
        __syncthreads();
        AMPE(211); AMPB(210);
    }
#undef AMPB
#undef AMPE
}
__device__ __forceinline__ float attn_shift(const Args& a, int lane, float& bmax2) {
    float wq = fabsf(a.q_norm_w[lane]), wk = fabsf(a.k_norm_w[lane]);
    float rb = 0.f;
    for (int i = lane; i < 512; i += 64) rb = fmaxf(rb, fabsf(a.rel_table[i]));
    if (lane < 16) rb = fmaxf(rb, fabsf(a.sinks[lane]));
#pragma unroll
    for (int o = 1; o < 64; o <<= 1) { wq = fmaxf(wq, __shfl_xor(wq, o)); wk = fmaxf(wk, __shfl_xor(wk, o)); rb = fmaxf(rb, __shfl_xor(rb, o)); }
    bmax2 = rb * LOG2E;
    return (8.0f * wq * wk + rb) * LOG2E;
}

__device__ __forceinline__ void samp_ssm_item(const Args& a, LAS unsigned char* lds, int item, int tid, int wave, int lane, const bool dry) {
    const int b = item >> 1, g = item & 1;
    const int Rs = MP + 4 * b;
    bf16_t* U = (bf16_t*)(a.ws + WS_U); const float* DT = (const float*)(a.ws + WS_DT);
    LAS float* xs = (LAS float*)lds;
    LAS float* Bs = xs + 2048;
    LAS float* Cs = Bs + 512;
    LAS float* gy = Cs + 512;
    LAS float* dts = gy + 2048;
    LAS float* avs = dts + 32;
    LAS float* rstd_s = avs + 32;
    __syncthreads();
    for (int cc = tid; cc < 768; cc += NT) {
        int ch; LAS float* dst;
        if (cc < 512) { ch = 512 * g + cc; dst = xs + cc; } else if (cc < 640) { ch = 1024 + 128 * g + (cc - 512); dst = Bs + (cc - 512); } else { ch = 1280 + 128 * g + (cc - 640); dst = Cs + (cc - 640); }
        const int stride = (cc < 512) ? 512 : 128;
        const float w0 = a.conv_w[ch], w1 = a.conv_w[CONVD + ch], w2 = a.conv_w[2 * CONVD + ch], w3 = a.conv_w[3 * CONVD + ch], cb = a.conv_b[ch];
        const float* sc = a.state_conv + (size_t)b * 3 * CONVD + ch;
        float f[7]; f[0] = sc[0]; f[1] = sc[CONVD]; f[2] = sc[2 * CONVD];
#pragma unroll
        for (int t = 0; t < 4; ++t) f[3 + t] = bf2f(U[(size_t)(Rs + t) * UW + C_X + ch]);
#pragma unroll
        for (int t = 0; t < 4; ++t) dst[t * stride] = silu_f(cb + w0 * f[t] + w1 * f[t + 1] + w2 * f[t + 2] + w3 * f[t + 3]);
    }
    if (tid < 32) { const int e = tid >> 2, t = tid & 3, h = 8 * g + e; const float d = softplus_f(DT[(size_t)(Rs + t) * 16 + h] + a.dt_bias[h]); dts[tid] = d; avs[tid] = d * (-expf(a.a_log[h])); }
    __syncthreads();
    const int p = tid >> 3, nq = tid & 7;
    f32x4 Sn[4];
    { const float* sp0 = a.state_ssm + ((size_t)(b * 16 + 8 * g) * 64 + p) * 128 + 4 * nq;
#pragma unroll
      for (int i = 0; i < 4; ++i) Sn[i] = __builtin_nontemporal_load((const f32x4*)(sp0 + 32 * i)); }
#pragma unroll 1
    for (int e = 0; e < 8; ++e) {
        const int h = 8 * g + e;
        f32x4 S[4];
#pragma unroll
        for (int i = 0; i < 4; ++i) S[i] = Sn[i];
        if (e < 7) { const float* sp = a.state_ssm + ((size_t)(b * 16 + h + 1) * 64 + p) * 128 + 4 * nq;
#pragma unroll
            for (int i = 0; i < 4; ++i) Sn[i] = __builtin_nontemporal_load((const f32x4*)(sp + 32 * i)); }
        float yv[4];
#pragma unroll
        for (int t = 0; t < 4; ++t) {
            const float dA = __expf(avs[e * 4 + t]); const float coef = dts[e * 4 + t] * xs[t * 512 + 64 * e + p];
            float acc = 0.f;
#pragma unroll
            for (int i = 0; i < 4; ++i) { const f32x4 Bv = *(const LAS f32x4*)(Bs + t * 128 + 4 * nq + 32 * i), Cv = *(const LAS f32x4*)(Cs + t * 128 + 4 * nq + 32 * i);
                S[i] = S[i] * dA + coef * Bv; acc += (Cv.x * S[i].x + Cv.y * S[i].y) + (Cv.z * S[i].z + Cv.w * S[i].w); }
            acc += __shfl_xor(acc, 1); acc += __shfl_xor(acc, 2); acc += __shfl_xor(acc, 4);
            yv[t] = acc;
        }
        float* op = a.out + O_SS + ((size_t)(b * 16 + h) * 64 + p) * 128 + 4 * nq;
#pragma unroll
        for (int i = 0; i < 4; ++i) if (!dry || S[i].x == 12345.678f) __builtin_nontemporal_store(S[i], (f32x4*)(op + 32 * i));
        if (nq < 4) { const int t = nq; const float xv = xs[t * 512 + 64 * e + p];
            const float yt = (nq == 0) ? yv[0] : (nq == 1) ? yv[1] : (nq == 2) ? yv[2] : yv[3];
            const float y = yt + a.d_skip[h] * xv; const float z = bf2f(U[(size_t)(Rs + t) * UW + C_Z + 64 * h + p]);
            gy[t * 512 + 64 * e + p] = y * silu_f(z); }
    }
    __syncthreads();
    if (wave < 4) { float s = 0.f;
#pragma unroll
        for (int i = 0; i < 8; ++i) { const float v = gy[wave * 512 + lane + 64 * i]; s += v * v; }
        s = wave_sum(s); if (lane == 0) rstd_s[wave] = __builtin_amdgcn_rsqf(s * (1.f / 512.f) + EPS); }
    __syncthreads();
    for (int i = tid; i < 2048; i += NT) { const int t = i >> 9, ch = i & 511;
        const unsigned ov = f2bf(gy[i] * rstd_s[t] * a.ssm_norm_w[512 * g + ch]); if (!dry || ov == 0x12345u) U[(size_t)(Rs + t) * UW + C_Z + 512 * g + ch] = (bf16_t)ov; }
}

struct SampAttnRegs { f32x4 k[4], v[4]; unsigned kx, vx, q0, q1; };
__device__ __forceinline__ void samp_attn_load(const Args& a, const bf16_t* U, int item, int tid, int wave, int lane, SampAttnRegs& r) {
    const int b = item >> 2, kvh = item & 3, Rs = MP + 4 * b;
    const int w = tid >> 2, qd = tid & 3;
    const float* kp = a.cache_k + ((size_t)(b * 128 + w) * 4 + kvh) * 64 + 16 * qd; const float* vp = a.cache_v + ((size_t)(b * 128 + w) * 4 + kvh) * 64 + 16 * qd;
#pragma unroll
    for (int i = 0; i < 4; ++i) { r.k[i] = __builtin_nontemporal_load((const f32x4*)(kp + 4 * i)); r.v[i] = __builtin_nontemporal_load((const f32x4*)(vp + 4 * i)); }
    const int t = wave & 3;
    r.kx = U[(size_t)(Rs + t) * UW + C_K + 64 * kvh + lane]; r.vx = U[(size_t)(Rs + t) * UW + C_V + 64 * kvh + lane];
    { const int qi = 2 * wave, gq = qi >> 2, tt = qi & 3; r.q0 = U[(size_t)(Rs + tt) * UW + C_Q + 64 * (4 * kvh + gq) + lane]; }
    { const int qi = 2 * wave + 1, gq = qi >> 2, tt = qi & 3; r.q1 = U[(size_t)(Rs + tt) * UW + C_Q + 64 * (4 * kvh + gq) + lane]; }
}
__device__ __forceinline__ void samp_attn_phase(const Args& a, LAS unsigned char* lds, int bx, int G, int tid, int wave, int lane, const bool dry, float bmax2) {
    bf16_t* U = (bf16_t*)(a.ws + WS_U);
    LAS bf16_t* Kn = (LAS bf16_t*)lds;
    LAS bf16_t* Vn = (LAS bf16_t*)(lds + 23040);
    LAS float* tb = (LAS float*)(lds + 46080);
    LAS f32x4* redo = (LAS f32x4*)(lds + 49152);
    LAS float* redl = (LAS float*)(lds + 69632);
    LAS unsigned* kmx = (LAS unsigned*)(lds + 70912);
    int item = bx; if (item >= 512) return;
    SampAttnRegs rg; samp_attn_load(a, U, item, tid, wave, lane, rg);
    __syncthreads();
    for (int i = tid; i < 28 * 72 / 8; i += NT) { *(LAS u32x4*)(Kn + 132 * 72 + 8 * i) = (u32x4){0u, 0u, 0u, 0u}; *(LAS u32x4*)(Vn + 132 * 72 + 8 * i) = (u32x4){0u, 0u, 0u, 0u}; }
    const int fr = lane & 15, grp = lane >> 4;
    while (item < 512) {
        const int b = item >> 2, kvh = item & 3;
        const int Rs = MP + 4 * b;
        if (tid == 0) kmx[0] = 0u;
        for (int i = tid; i < 4 * 168; i += NT) { const int gq = i / 168, u = (i % 168) - 3, d = 128 - u; tb[i] = (d >= 0 && d <= 128) ? a.rel_table[rel_bucket(d) * 16 + 4 * kvh + gq] * LOG2E : -1e30f; }
        __syncthreads();
        float k2 = 0.f;
        {
            const int w = tid >> 2, qd = tid & 3;
#pragma unroll
            for (int i = 0; i < 4; ++i) k2 += (rg.k[i].x * rg.k[i].x + rg.k[i].y * rg.k[i].y) + (rg.k[i].z * rg.k[i].z + rg.k[i].w * rg.k[i].w);
            u32x4 k0, k1, v0, v1;
            k0.x = pk2(rg.k[0].x, rg.k[0].y); k0.y = pk2(rg.k[0].z, rg.k[0].w); k0.z = pk2(rg.k[1].x, rg.k[1].y); k0.w = pk2(rg.k[1].z, rg.k[1].w);
            k1.x = pk2(rg.k[2].x, rg.k[2].y); k1.y = pk2(rg.k[2].z, rg.k[2].w); k1.z = pk2(rg.k[3].x, rg.k[3].y); k1.w = pk2(rg.k[3].z, rg.k[3].w);
            v0.x = pk2(rg.v[0].x, rg.v[0].y); v0.y = pk2(rg.v[0].z, rg.v[0].w); v0.z = pk2(rg.v[1].x, rg.v[1].y); v0.w = pk2(rg.v[1].z, rg.v[1].w);
            v1.x = pk2(rg.v[2].x, rg.v[2].y); v1.y = pk2(rg.v[2].z, rg.v[2].w); v1.z = pk2(rg.v[3].x, rg.v[3].y); v1.w = pk2(rg.v[3].z, rg.v[3].w);
            *(LAS u32x4*)(Kn + w * 72 + 16 * qd) = k0; *(LAS u32x4*)(Kn + w * 72 + 16 * qd + 8) = k1;
            *(LAS u32x4*)(Vn + w * 72 + 16 * qd) = v0; *(LAS u32x4*)(Vn + w * 72 + 16 * qd + 8) = v1;
            k2 += __shfl_xor(k2, 1); k2 += __shfl_xor(k2, 2);
        }
        if (wave < 4) {
            const int t = wave;
            const float kx = bf2f(rg.kx), vx = bf2f(rg.vx);
            const float ss = wave_sum(kx * kx); const float kn = kx * __builtin_amdgcn_rsqf(ss * (1.f / 64.f) + EPS) * a.k_norm_w[lane];
            Kn[(128 + t) * 72 + lane] = (bf16_t)f2bf(kn); Vn[(128 + t) * 72 + lane] = (bf16_t)rg.vx;
            k2 = fmaxf(k2, wave_sum(kn * kn));
            if (!dry) { a.out[O_KS + ((size_t)(b * 128 + 124 + t) * 4 + kvh) * 64 + lane] = kn; a.out[O_VS + ((size_t)(b * 128 + 124 + t) * 4 + kvh) * 64 + lane] = vx; }
        }
#pragma unroll
        for (int o = 1; o < 64; o <<= 1) k2 = fmaxf(k2, __shfl_xor(k2, o));
        if (lane == 0) (void)__hip_atomic_fetch_max(kmx, __builtin_bit_cast(unsigned, k2), __ATOMIC_RELAXED, __HIP_MEMORY_SCOPE_WORKGROUP);
        bf16x8 qf[2]; float qn2 = 0.f;
        const int tq = fr & 3, hq = 4 * kvh + (fr >> 2);
        if (wave < 5) {
            const bf16_t* qrow = U + (size_t)(Rs + tq) * UW + C_Q + 64 * hq + 8 * grp;
            const u32x4 w0 = *(const u32x4*)(qrow), w1 = *(const u32x4*)(qrow + 32);
            float qv[16] = {bflo(w0.x), bfhi(w0.x), bflo(w0.y), bfhi(w0.y), bflo(w0.z), bfhi(w0.z), bflo(w0.w), bfhi(w0.w),
                            bflo(w1.x), bfhi(w1.x), bflo(w1.y), bfhi(w1.y), bflo(w1.z), bfhi(w1.z), bflo(w1.w), bfhi(w1.w)};
            float ss = 0.f;
#pragma unroll
            for (int i = 0; i < 16; ++i) ss += qv[i] * qv[i];
            ss += __shfl_xor(ss, 16); ss += __shfl_xor(ss, 32);
            const float rs = (0.125f * LOG2E) * __builtin_amdgcn_rsqf(ss * (1.f / 64.f) + EPS);
#pragma unroll
            for (int i = 0; i < 16; ++i) { qv[i] *= rs * a.q_norm_w[(i < 8 ? 0 : 32) + 8 * grp + (i & 7)]; qn2 += qv[i] * qv[i]; }
            qn2 += __shfl_xor(qn2, 16); qn2 += __shfl_xor(qn2, 32);
            u32x4 p0, p1;
            p0.x = pk2(qv[0], qv[1]); p0.y = pk2(qv[2], qv[3]); p0.z = pk2(qv[4], qv[5]); p0.w = pk2(qv[6], qv[7]);
            p1.x = pk2(qv[8], qv[9]); p1.y = pk2(qv[10], qv[11]); p1.z = pk2(qv[12], qv[13]); p1.w = pk2(qv[14], qv[15]);
            qf[0] = __builtin_bit_cast(bf16x8, p0); qf[1] = __builtin_bit_cast(bf16x8, p1);
        }
        const int nxt = item + G;
        if (nxt < 512) samp_attn_load(a, U, nxt, tid, wave, lane, rg);
        __syncthreads();
        const float mq = sqrtf(qn2 * __builtin_bit_cast(float, kmx[0])) + bmax2;
        if (wave < 5) {
            const int j0 = 32 * wave;
            bf16x8 kfr[2][2]; u32x2 vlo[4], vhi[4]; float btv[8];
#pragma unroll
            for (int ks = 0; ks < 2; ++ks) { kfr[0][ks] = *(const LAS bf16x8*)(Kn + (j0 + fr) * 72 + 32 * ks + 8 * grp); kfr[1][ks] = *(const LAS bf16x8*)(Kn + (j0 + 16 + fr) * 72 + 32 * ks + 8 * grp); }
            const LAS float* bt = tb + (fr >> 2) * 168 + (j0 + 4 * grp - tq + 3);
#pragma unroll
            for (int r = 0; r < 4; ++r) { btv[r] = bt[r]; btv[4 + r] = bt[16 + r]; }
#pragma unroll
            for (int dt = 0; dt < 4; ++dt) { vlo[dt] = lds_tr16(Vn + (j0 + 4 * grp + (fr >> 2)) * 72 + 16 * dt + 4 * (fr & 3)); vhi[dt] = lds_tr16(Vn + (j0 + 16 + 4 * grp + (fr >> 2)) * 72 + 16 * dt + 4 * (fr & 3)); }
            __builtin_amdgcn_sched_barrier(0);
            f32x4 s0 = (f32x4){0.f, 0.f, 0.f, 0.f}, s1 = (f32x4){0.f, 0.f, 0.f, 0.f};
#pragma unroll
            for (int ks = 0; ks < 2; ++ks) { s0 = mfma16(kfr[0][ks], qf[ks], s0); s1 = mfma16(kfr[1][ks], qf[ks], s1); }
            float p[8]; float lsum = 0.f;
#pragma unroll
            for (int r = 0; r < 4; ++r) { p[r] = __builtin_amdgcn_exp2f(s0[r] + btv[r] - mq); p[4 + r] = __builtin_amdgcn_exp2f(s1[r] + btv[4 + r] - mq); }
#pragma unroll
            for (int r = 0; r < 8; ++r) lsum += p[r];
            u32x4 pw; pw.x = pk2(p[0], p[1]); pw.y = pk2(p[2], p[3]); pw.z = pk2(p[4], p[5]); pw.w = pk2(p[6], p[7]);
            const bf16x8 pf = __builtin_bit_cast(bf16x8, pw);
#pragma unroll
            for (int dt = 0; dt < 4; ++dt) {
                u32x4 aw; aw.x = vlo[dt].x; aw.y = vlo[dt].y; aw.z = vhi[dt].x; aw.w = vhi[dt].y;
                redo[(wave * 4 + dt) * 64 + lane] = mfma16(__builtin_bit_cast(bf16x8, aw), pf, (f32x4){0.f, 0.f, 0.f, 0.f});
            }
            redl[wave * 64 + lane] = lsum;
        }
        __syncthreads();
        if (wave < 4) {
            const int dt = wave;
            f32x4 o = redo[(0 * 4 + dt) * 64 + lane]; float l = redl[lane];
#pragma unroll
            for (int k5 = 1; k5 < 5; ++k5) { o += redo[(k5 * 4 + dt) * 64 + lane]; l += redl[k5 * 64 + lane]; }
            l += __shfl_xor(l, 16); l += __shfl_xor(l, 32);
            const float rl = __builtin_amdgcn_rcpf(l + __builtin_amdgcn_exp2f(a.sinks[hq] * LOG2E - mq));
            const u32x2 zz = *(const u32x2*)(U + (size_t)(Rs + tq) * UW + C_ZA + 64 * hq + 16 * dt + 4 * grp);
            u32x2 ov; ov.x = pk2(o[0] * rl * silu_f(bflo(zz.x)), o[1] * rl * silu_f(bfhi(zz.x))); ov.y = pk2(o[2] * rl * silu_f(bflo(zz.y)), o[3] * rl * silu_f(bfhi(zz.y)));
            if (!dry || ov.x == 0x12345678u) *(u32x2*)(U + (size_t)(Rs + tq) * UW + C_Q + 64 * hq + 16 * dt + 4 * grp) = ov;
        }
        item = nxt;
    }
}
__device__ __forceinline__ void cache_shift_copy(const Args& a, int it, int tid) {
    const int b = it >> 1; const float* src = (it & 1) ? a.cache_v : a.cache_k; float* dst = a.out + ((it & 1) ? O_VS : O_KS);
    const f32x4* s4 = (const f32x4*)(src + (size_t)(b * 128 + 4) * 256); f32x4* d4 = (f32x4*)(dst + (size_t)(b * 128) * 256);
#pragma unroll 8
    for (int i = tid; i < 124 * 64; i += NT) __builtin_nontemporal_store(__builtin_nontemporal_load(s4 + i), d4 + i);
}

__device__ __forceinline__ void conv_out_item(const Args& a, int item, int tid) {
    const bf16_t* U = (const bf16_t*)(a.ws + WS_U);
    for (int i = tid; i < 3 * CONVD; i += NT) {
        const int r = i / CONVD, ch = i % CONVD;
        if (item < NB) a.out[O_CP + (size_t)item * 3 * CONVD + i] = bf2f(((const bf16_t*)(a.ws + WS_HALO))[(size_t)((item * 64 + 63) * 3 + r) * CONVD + ch]);
        else { const int b = item - NB; a.out[O_CS + (size_t)b * 3 * CONVD + i] = bf2f(U[(size_t)(MP + 4 * b + 1 + r) * UW + C_X + ch]); }
    }
}

__device__ __forceinline__ void samp_outproj_tile(const Args& a, LAS unsigned char* lds, int it, int tid, int wave, int lane) {
    const bf16_t* U = (const bf16_t*)(a.ws + WS_U); const bf16_t* Wt = (const bf16_t*)(a.ws + WS_WOUT);
    LAS bf16_t* T = (LAS bf16_t*)lds;
    LAS f32x4* red = (LAS f32x4*)(lds + 131584);
    const int r0 = 32 * (it >> 4), c0 = 64 * (it & 15);
    const int fr = lane & 15, grp = lane >> 4, kh = wave >> 2, cg = wave & 3;
    __syncthreads();
    {   u32x4 tv[16];
#pragma unroll
        for (int i = 0; i < 16; ++i) { const int ci = tid + NT * i, row = ci >> 8, k = 8 * (ci & 255);
            tv[i] = *(const u32x4*)(U + (size_t)(MP + r0 + row) * UW + (k < 1024 ? C_Z + k : C_Q + (k - 1024))); }
#pragma unroll
        for (int i = 0; i < 16; ++i) { const int ci = tid + NT * i, row = ci >> 8, k = 8 * (ci & 255); *(LAS u32x4*)(T + row * 2056 + k) = tv[i]; }
    }
    const bf16_t* wp = Wt + (size_t)(c0 + 16 * cg + fr) * 2048 + 1024 * kh + 8 * grp;
    const LAS bf16_t* tp = T + fr * 2056 + 1024 * kh + 8 * grp;
    f32x4 acc0 = (f32x4){0.f, 0.f, 0.f, 0.f}, acc1 = (f32x4){0.f, 0.f, 0.f, 0.f};
    bf16x8 wf[8];
#pragma unroll
    for (int i = 0; i < 8; ++i) wf[i] = *(const bf16x8*)(wp + 32 * i);
    __syncthreads();
#pragma unroll
    for (int kb = 0; kb < 4; ++kb) {
        bf16x8 wc[8];
#pragma unroll
        for (int i = 0; i < 8; ++i) wc[i] = wf[i];
        if (kb < 3) {
#pragma unroll
            for (int i = 0; i < 8; ++i) wf[i] = *(const bf16x8*)(wp + 32 * (8 * (kb + 1) + i)); }
#pragma unroll
        for (int i = 0; i < 8; ++i) { const int ks = 8 * kb + i;
            const bf16x8 t0 = *(const LAS bf16x8*)(tp + 32 * ks), t1 = *(const LAS bf16x8*)(tp + 16 * 2056 + 32 * ks);
            acc0 = mfma16(wc[i], t0, acc0); acc1 = mfma16(wc[i], t1, acc1); }
    }
    if (kh) { red[(cg * 2 + 0) * 64 + lane] = acc0; red[(cg * 2 + 1) * 64 + lane] = acc1; }
    __syncthreads();
    if (!kh) {
        acc0 += red[(cg * 2 + 0) * 64 + lane]; acc1 += red[(cg * 2 + 1) * 64 + lane];
        const size_t o0 = (size_t)(r0 + fr) * DM + c0 + 16 * cg + 4 * grp, o1 = o0 + (size_t)16 * DM;
        *(f32x4*)(a.out + O_YS + o0) = *(const f32x4*)(a.x_sample + o0) + acc0;
        *(f32x4*)(a.out + O_YS + o1) = *(const f32x4*)(a.x_sample + o1) + acc1;
    }
}

__global__ void __launch_bounds__(NT, 2) mk_fwd(Args args) {
    extern __shared__ __attribute__((aligned(16))) unsigned char lds_raw[];
    LAS unsigned char* lds = (LAS unsigned char*)lds_raw;
    volatile LAS unsigned* MISC = (volatile LAS unsigned*)(lds + MISC_OFF);
    const int tid = threadIdx.x, lane = tid & 63, wave = __builtin_amdgcn_readfirstlane(tid >> 6);
    const int G = gridDim.x; const int bx = blockIdx.x; const int vcu = (G % 8 == 0) ? (bx % 8) * (G / 8) + bx / 8 : bx;
    gu32* ctl = (gu32*)(args.ws + WS_CTL);
    for (int u = tid; u < 512 / 4; u += NT) ((LAS unsigned*)(lds + MISC_OFF))[u] = 0u;
    __syncthreads();
    XcdBarrier bar; bar.bar = (unsigned*)(ctl + CW_BAR); bar.x = 0; bar.st = nullptr;
    if (MK_N_LAUNCHES == 1) bar = xcd_barrier_post((unsigned*)(ctl + CW_BAR), MISC + 8);
    const int lo = args.ph_lo, hi = args.ph_hi;
#define IN(k) (lo <= (k) && (k) < hi)
#define GRID_BAR() do { if (MK_N_LAUNCHES == 1) xcd_barrier(bar); } while (0)

    const bool dry = (args.dry != 0);
    unsigned long long amp_t = 0ull, amp_d = 0ull;
#define AMP_BEGIN(k) do { if (MK_AMP == (k)) amp_t = __builtin_amdgcn_s_memrealtime(); } while (0)
#define AMP_END(k) do { if (MK_AMP == (k)) amp_d += __builtin_amdgcn_s_memrealtime() - amp_t; } while (0)
    AMP_BEGIN(0);
    if (IN(0)) { p0_prologue(args, lds, vcu, G, wave, lane, amp_d); AMP_BEGIN(102); GRID_BAR(); AMP_END(102); }
    AMP_END(0);

    AMP_BEGIN(1);
    if (IN(1)) {
        pg8::Gemm g{(const bf16_t*)(args.ws + WS_H), (const bf16_t*)(args.ws + WS_WIN), MT, NINP, DM, DM, 1 << 20, 0};
        pg8::StaticOrder S; S.init(MT, NINP, G, bx);
        pg8::EpiU E{(bf16_t*)(args.ws + WS_U), (float*)(args.ws + WS_DT), (bf16_t*)(args.ws + WS_HALO)};
        pg8::gemm_phase<pg8::EpiU, pg8::StaticOrder, true>(lds, g, S, E);
        AMP_BEGIN(15);
        { const int rem = S.nwg % G;
          if (rem == 0) { for (int it = bx; it < 2 * DB; it += G) cache_shift_copy(args, it, tid); }
          else if (bx >= rem) { for (int it = bx - rem; it < 2 * DB; it += G - rem) cache_shift_copy(args, it, tid); } }
        AMP_END(15);
        AMP_BEGIN(14); GRID_BAR(); AMP_END(14);
    }
    AMP_END(1);

    AMP_BEGIN(2);
    if (IN(2)) {
        float bmax2; const float m2 = attn_shift(args, lane, bmax2);
        const int sub = args.sub;
#define P2_PROMPT() do { AMP_BEGIN(20); if (sub & 1) for (int it = bx; it < 256; it += G) ssd_state_item(args, lds, it, tid, wave, lane); AMP_END(20); \
        AMP_BEGIN(21); if (sub & 2) attn_phase(args, lds, bx, G, tid, wave, lane, m2, dry, amp_d); AMP_END(21); } while (0)
#define P2_SAMPLE() do { AMP_BEGIN(22); if (sub & 4) for (int it = bx; it < 256; it += G) samp_ssm_item(args, lds, it, tid, wave, lane, dry); AMP_END(22); \
        AMP_BEGIN(23); if (sub & 8) samp_attn_phase(args, lds, bx, G, tid, wave, lane, dry, bmax2); AMP_END(23); } while (0)
        if (bx & 1) { P2_SAMPLE(); P2_PROMPT(); } else { P2_PROMPT(); P2_SAMPLE(); }
#undef P2_PROMPT
#undef P2_SAMPLE
        if (sub & 16) for (int it = bx; it < NB + DB; it += G) conv_out_item(args, it, tid);
        if (MK_AMP == 200) { const bool dr = (args.ph_hi < 1000); __syncthreads(); AMP_BEGIN(200); for (int it = bx; it < 256; it += G) ssd_state_item(args, lds, it, tid, wave, lane, dr); AMP_END(200); }
        if (MK_AMP == 212) { const bool dr = (args.ph_hi < 1000); __syncthreads(); AMP_BEGIN(212); attn_phase(args, lds, bx, G, tid, wave, lane, m2, dr, amp_d); AMP_END(212); }
        AMP_BEGIN(24); GRID_BAR(); AMP_END(24);
    }
    AMP_END(2);

    AMP_BEGIN(3);
    if (IN(3)) { ssd_scan(args, lds, bx, G, tid, wave, lane, dry); AMP_BEGIN(34); GRID_BAR(); AMP_END(34); }
    AMP_END(3);

    AMP_BEGIN(4);
    if (IN(4)) {
        for (int it = bx; it < 256; it += G) ssd_out_item(args, lds, it, tid, wave, lane, dry);
        if (MK_AMP == 400) { const bool dr = (args.ph_hi < 1000); __syncthreads(); AMP_BEGIN(400); for (int it = bx; it < 256; it += G) ssd_out_item(args, lds, it, tid, wave, lane, dr); AMP_END(400); }
        AMP_BEGIN(44); GRID_BAR(); AMP_END(44);
    }
    AMP_END(4);

    AMP_BEGIN(5);
    if (IN(5)) {
        pg8::Gemm g{(const bf16_t*)(args.ws + WS_U), (const bf16_t*)(args.ws + WS_WOUT), MP, DM, 2048, UW, 16, (size_t)(C_Q - 1024) * 2};
        pg8::StaticOrder S; S.init(MP, DM, G, bx);
        pg8::EpiOut E{args.x_prompt, args.x_sample, args.out};
        if (bx & 1) { for (int it = bx; it < 256; it += G) samp_outproj_tile(args, lds, it, tid, wave, lane); __syncthreads(); }
        pg8::gemm_phase<pg8::EpiOut, pg8::StaticOrder, true>(lds, g, S, E);
        if (!(bx & 1)) { for (int it = bx; it < 256; it += G) samp_outproj_tile(args, lds, it, tid, wave, lane); }
    }
    AMP_END(5);
    if (MK_AMP >= 0 && bx == MK_AMPBLK && tid == 0) {
        const unsigned long long t0 = __builtin_amdgcn_s_memrealtime();
        while (__builtin_amdgcn_s_memrealtime() - t0 < 4ull * amp_d) __builtin_amdgcn_s_sleep(8);
    }
#undef AMP_BEGIN
#undef AMP_END
#undef IN
#undef GRID_BAR
}

extern "C" void kernel_launch(void* const* d_in, const int* in_sizes, int n_in, void* d_out, int out_size, void* d_ws, size_t ws_size, hipStream_t stream) {
    static int grid = 0;
    if (grid == 0) {
        if (n_in != 19 || (size_t)out_size != O_END || ws_size < WS_END) { fprintf(stderr, "kernel_launch: unexpected shapes (n_in %d, out %d, ws %zu)\n", n_in, out_size, ws_size); grid = -1; return; }
        int dev = 0, cus = 0;
        if (hipGetDevice(&dev) != hipSuccess || hipDeviceGetAttribute(&cus, hipDeviceAttributeMultiprocessorCount, dev) != hipSuccess) { grid = -1; return; }
        if (hipFuncSetAttribute((const void*)mk_fwd, hipFuncAttributeMaxDynamicSharedMemorySize, LDS_BYTES) != hipSuccess) { fprintf(stderr, "kernel_launch: hipFuncSetAttribute failed\n"); grid = -1; return; }
        int per_cu = 0;
        if (hipOccupancyMaxActiveBlocksPerMultiprocessor(&per_cu, (const void*)mk_fwd, NT, LDS_BYTES) != hipSuccess || per_cu < 1) fprintf(stderr, "kernel_launch: occupancy query reports %d blocks per CU\n", per_cu);
        (void)hipGetLastError();
        grid = cus;
    }
    if (grid < 0) return;
    (void)hipMemsetAsync((char*)d_ws + WS_CTL, 0, CTL_ZERO_BYTES, stream);
    Args a{};
    const float** ap = (const float**)&a;
    for (int i = 0; i < 19; ++i) ap[i] = (const float*)d_in[i];
    a.out = (float*)d_out; a.ws = (unsigned char*)d_ws;
    a.sub = 31; a.dry = 0;
    if (MK_N_LAUNCHES == 1) { a.ph_lo = 0; a.ph_hi = 6; hipLaunchKernelGGL(mk_fwd, dim3(grid), dim3(NT), LDS_BYTES, stream, a); }
    else for (int ph = 0; ph < 6; ++ph) {
        a.ph_lo = ph; a.ph_hi = ph + 1; a.sub = 31; a.dry = 0;
        hipLaunchKernelGGL(mk_fwd, dim3(grid), dim3(NT), LDS_BYTES, stream, a);
        if (MK_DUP == ph) { a.dry = 1; hipLaunchKernelGGL(mk_fwd, dim3(grid), dim3(NT), LDS_BYTES, stream, a); }
        if (ph == 2 && MK_DUP >= 20 && MK_DUP < 24) { a.sub = 1 << (MK_DUP - 20); a.dry = 1; hipLaunchKernelGGL(mk_fwd, dim3(grid), dim3(NT), LDS_BYTES, stream, a); }
    }
}
```

```cpp
#include <hip/hip_runtime.h>
#include <cstdio>
#include <cstdint>

#ifndef MK_N_LAUNCHES
#define MK_N_LAUNCHES 1
#endif

#ifndef MK_AMP
#define MK_AMP (-1)
#endif
#ifndef MK_ABL
#define MK_ABL 0
#endif
#ifndef MK_AMPBLK
#define MK_AMPBLK 0
#endif
#ifndef MK_DUP
#define MK_DUP (-1)
#endif
#define LAS __attribute__((address_space(3)))
#define GAS __attribute__((address_space(1)))
typedef unsigned short bf16_t;
typedef short bf16x8 __attribute__((ext_vector_type(8)));
typedef short bf16x4 __attribute__((ext_vector_type(4)));
typedef float f32x4 __attribute__((ext_vector_type(4)));
typedef float f32x2 __attribute__((ext_vector_type(2)));
typedef unsigned u32x4 __attribute__((ext_vector_type(4)));
typedef unsigned u32x2 __attribute__((ext_vector_type(2)));

constexpr int DM = 1024, SEQ = 8192, NB = 2, MP = NB * SEQ;
constexpr int DB = 128, DL = 4, MS = DB * DL, MT = MP + MS;
constexpr int NIN = 5136, NINP = 5376;
constexpr int UW = 5120;
constexpr int C_Z = 0, C_X = 1024, C_B = 2048, C_C = 2304, C_Q = 2560, C_K = 3584, C_V = 3840, C_ZA = 4096;
constexpr int CONVD = 1536;
constexpr float EPS = 1e-6f;
constexpr float LOG2E = 1.4426950408889634f;

constexpr size_t MiB = 1u << 20;
constexpr size_t WS_CTL = 0, CTL_ZERO_BYTES = 32768;
constexpr size_t WS_WIN = 1 * MiB;
constexpr size_t WS_WOUT = 12 * MiB;
constexpr size_t WS_DT = 16 * MiB;
constexpr size_t WS_DEC = 17 * MiB + 512 * 1024;
constexpr size_t WS_U = 18 * MiB;
constexpr size_t WS_H = 183 * MiB;
constexpr size_t WS_ST = 183 * MiB;
constexpr size_t WS_HALO = 247 * MiB;
constexpr size_t WS_DTA = 249 * MiB;
constexpr size_t WS_END = 251 * MiB;
constexpr int CW_BAR = 4096;

constexpr size_t O_YP = 0, O_YS = 16777216, O_KP = 17301504, O_VP = 17367040, O_SP = 17432576, O_CP = 17694720,
                 O_KS = 17703936, O_VS = 21898240, O_SS = 26092544, O_CS = 42869760, O_END = 43459584;

typedef __bf16 hwbf16x2 __attribute__((ext_vector_type(2)));
__device__ __forceinline__ unsigned pk2(float lo, float hi) { const f32x2 v = {lo, hi}; return __builtin_bit_cast(unsigned, __builtin_convertvector(v, hwbf16x2)); }
__device__ __forceinline__ unsigned f2bf(float f) { return pk2(f, 0.f) & 0xffffu; }
__device__ __forceinline__ float bf2f(unsigned v) { return __builtin_bit_cast(float, v << 16); }
__device__ __forceinline__ float bflo(unsigned w) { return __builtin_bit_cast(float, w << 16); }
__device__ __forceinline__ float bfhi(unsigned w) { return __builtin_bit_cast(float, w & 0xffff0000u); }
__device__ __forceinline__ float silu_f(float x) { return x * __builtin_amdgcn_rcpf(1.0f + __expf(-x)); }
__device__ __forceinline__ float softplus_f(float x) { return fmaxf(x, 0.f) + log1pf(__expf(-fabsf(x))); }
__device__ __forceinline__ float wave_sum(float v) {
#pragma unroll
    for (int o = 1; o < 64; o <<= 1) v += __shfl_xor(v, o);
    return v;
}
__device__ __forceinline__ f32x4 mfma16(bf16x8 a, bf16x8 b, f32x4 c) { return __builtin_amdgcn_mfma_f32_16x16x32_bf16(a, b, c, 0, 0, 0); }
__device__ __forceinline__ void st_wt16(void* p, u32x4 v) { asm volatile("global_store_dwordx4 %0, %1, off sc1\n\ts_nop 1" :: "v"(p), "v"(v) : "memory"); }
__device__ __forceinline__ void st_wt8(void* p, u32x2 v) { asm volatile("global_store_dwordx2 %0, %1, off sc1\n\ts_nop 1" :: "v"(p), "v"(v) : "memory"); }
#define LDS_WAIT() asm volatile("s_waitcnt lgkmcnt(0)" ::: "memory")
#define VM_WAIT() asm volatile("s_waitcnt vmcnt(0)" ::: "memory")

namespace pg8 {
constexpr int BM = 256, BK = 64, HALF = 128, HTB = HALF * BK * 2, STAGE_BYTES = 8 * HTB, NXCD = 8, WGM = 8;
__host__ __device__ __forceinline__ int lds_byte(int r, int c) { const int st = (r >> 4) * 2 + (c >> 5), rr = r & 15, cc = c & 31, ob = rr * 64 + cc * 2; return st * 1024 + (ob ^ (((ob >> 9) & 1) << 5)); }
__host__ __device__ __forceinline__ void stage_rc(int b, int& R, int& C) { const int st = b / 1024, sb = b % 1024, swz = sb ^ (((sb >> 9) & 1) << 5); R = (st >> 1) * 16 + swz / 64; C = (st & 1) * 32 + (swz % 64) / 2; }
__host__ __device__ __forceinline__ int perm32(int rho) { const int n = rho >> 4, i = rho & 15; return 8 * (i >> 2) + 4 * n + (i & 3); }

struct Unit { int pm, pn; };
struct Gemm { const bf16_t* A; const bf16_t* Bt; int M, N, K, lda, kseg; size_t segskip; };

struct StaticOrder {
    int nM, nN, nwg, G, c;
    __host__ __device__ void init(int M, int N, int G_, int c_) { nM = M / BM; nN = N / BM; nwg = nM * nN; G = G_; c = c_; }
    __host__ __device__ bool next(int i, Unit& u) const {
        const long L = (long)i * G + c; if (L >= nwg) return false;
        int wgid = (int)L; { const int q = nwg / NXCD, r = nwg % NXCD, xcd = wgid % NXCD, off = wgid / NXCD; wgid = (xcd < r ? xcd * (q + 1) : r * (q + 1) + (xcd - r) * q) + off; }
        const int nig = WGM * nN, gid = wgid / nig, fm = gid * WGM, gsz = (nM - fm) < WGM ? (nM - fm) : WGM;
        u.pm = fm + ((wgid % nig) % gsz); u.pn = (wgid % nig) / gsz; return true;
    }
};

__device__ __forceinline__ unsigned cvt_pk_bf16(float lo, float hi) { unsigned r; asm volatile("v_cvt_pk_bf16_f32 %0, %1, %2" : "=v"(r) : "v"(lo), "v"(hi)); return r; }

struct EpiU {
    static constexpr bool PERM = true;
    bf16_t* U; float* DT; bf16_t* HALO;
    __device__ __forceinline__ void operator()(const f32x4 (&acc)[2][2][4][2], const Unit& u, int wr, int wc, int fr, int fq) const {
        const int row0 = u.pm * BM + wr * 64 + fr;
        if (u.pn < 20) {
            const bool halo = (u.pn >= 4) && (u.pn < 10) && (u.pm < MP / BM) && (wr == 1) && (fr >= 13);
            const int col0 = u.pn * BM + wc * 32 + 8 * fq;
#pragma unroll
            for (int ai = 0; ai < 2; ++ai)
#pragma unroll
                for (int m = 0; m < 4; ++m) { bf16_t* rowp = U + (size_t)(row0 + ai * HALF + m * 16) * UW + col0;
#pragma unroll
                    for (int bj = 0; bj < 2; ++bj) { const f32x4 v0 = acc[ai][bj][m][0], v1 = acc[ai][bj][m][1];
                        u32x4 w; w.x = cvt_pk_bf16(v0[0], v0[1]); w.y = cvt_pk_bf16(v0[2], v0[3]); w.z = cvt_pk_bf16(v1[0], v1[1]); w.w = cvt_pk_bf16(v1[2], v1[3]);
                        *(u32x4*)(rowp + bj * HALF) = w;
                        if (m == 3 && halo) *(u32x4*)(HALO + (size_t)((u.pm * 2 + ai) * 3 + (fr - 13)) * CONVD + (col0 - C_X) + bj * HALF) = w; } }
        } else if (wc == 0 && fq < 2) {
#pragma unroll
            for (int ai = 0; ai < 2; ++ai)
#pragma unroll
                for (int m = 0; m < 4; ++m) { float* rowp = DT + (size_t)(row0 + ai * HALF + m * 16) * 16 + 8 * fq;
                    *(f32x4*)(rowp) = acc[ai][0][m][0]; *(f32x4*)(rowp + 4) = acc[ai][0][m][1]; }
        }
    }
};
struct EpiOut {
    static constexpr bool PERM = false;
    const float* xp; const float* xs; float* out;
    __device__ __forceinline__ void operator()(const f32x4 (&acc)[2][2][4][2], const Unit& u, int wr, int wc, int fr, int fq) const {
        const int col0 = u.pn * BM + wc * 32 + 4 * fq;
#pragma unroll
        for (int ai = 0; ai < 2; ++ai)
#pragma unroll
            for (int m = 0; m < 4; ++m) { const int row = u.pm * BM + ai * HALF + wr * 64 + m * 16 + fr;
                const float* xb = (row < MP) ? xp + (size_t)row * DM : xs + (size_t)(row - MP) * DM; float* ob = out + (size_t)row * DM;
#pragma unroll
                for (int bj = 0; bj < 2; ++bj)
#pragma unroll
                    for (int n = 0; n < 2; ++n) { const int c = col0 + bj * HALF + n * 16; const f32x4 xv = __builtin_nontemporal_load((const f32x4*)(xb + c)); __builtin_nontemporal_store(xv + acc[ai][bj][m][n], (f32x4*)(ob + c)); } }
    }
};

template <class Epi, class Sched, bool ALIGN_EPI>
__device__ __forceinline__ void gemm_phase(LAS unsigned char* lds, const Gemm g, const Sched& S, const Epi& E) {
    int tid_ = threadIdx.x; asm volatile("" : "+v"(tid_));
    const int tid = tid_, wid = __builtin_amdgcn_readfirstlane(tid >> 6), lane = tid & 63, wr = wid >> 2, wc = wid & 3, fr = lane & 15, fq = lane >> 4;
    const int K = g.K, nt = K / BK, lda = g.lda, kseg = g.kseg;
    unsigned voffA[2], voffB[2];
#pragma unroll
    for (int i = 0; i < 2; ++i) { int R, C; stage_rc(tid * 16 + i * 8192, R, C); const int Rb = Epi::PERM ? ((R & ~31) + perm32(R & 31)) : R;
        voffA[i] = (unsigned)(R * lda + C) * 2u; voffB[i] = (unsigned)(Rb * K + C) * 2u; }
    const size_t kstep = (size_t)(BK * 2);
    const size_t hstepA = (size_t)HALF * lda * 2, tstepA = 2 * hstepA;
    const size_t hstepB = (size_t)HALF * K * 2, tstepB = 2 * hstepB;
    const size_t segskip = g.segskip;
#define KOFFA(t) ((size_t)(t) * kstep + (((t) >= kseg) ? segskip : (size_t)0))
    const unsigned ldsw = (unsigned)wid * 1024u;
    const int aoff = lds_byte(wr * 64 + fr, fq * 8), boff = lds_byte(wc * 32 + fr, fq * 8);
#define PG8_SA(b, h) (((b) * 2 + (h)) * HTB)
#define PG8_SB(b, h) ((4 + (b) * 2 + (h)) * HTB)
#define PG8_STAGE(bufoff, gbase, voff) do { _Pragma("unroll") for (int _i = 0; _i < 2; ++_i) \
        __builtin_amdgcn_global_load_lds((const unsigned*)((const char*)(gbase) + (voff)[_i]), (LAS unsigned*)(lds + (bufoff) + ldsw + _i * 8192), 16, 0, 0); } while (0)
#define PG8_LDA(dst, b, h) do { _Pragma("unroll") for (int m = 0; m < 4; ++m) _Pragma("unroll") for (int k = 0; k < 2; ++k) dst[m][k] = *(const LAS bf16x8*)(lds + PG8_SA(b, h) + aoff + m * 2048 + k * 1024); } while (0)
#define PG8_LDB(dst, b, h) do { _Pragma("unroll") for (int n = 0; n < 2; ++n) _Pragma("unroll") for (int k = 0; k < 2; ++k) dst[n][k] = *(const LAS bf16x8*)(lds + PG8_SB(b, h) + boff + n * 2048 + k * 1024); } while (0)
#define PG8_MMA(ai, bj, At, Bt) do { __builtin_amdgcn_s_setprio(1); _Pragma("unroll") for (int m = 0; m < 4; ++m) _Pragma("unroll") for (int n = 0; n < 2; ++n) _Pragma("unroll") for (int k = 0; k < 2; ++k) \
        acc[ai][bj][m][n] = __builtin_amdgcn_mfma_f32_16x16x32_bf16(Bt[n][k], At[m][k], acc[ai][bj][m][n], 0, 0, 0); __builtin_amdgcn_s_setprio(0); } while (0)
#define PG8_WAIT_V(n) asm volatile("s_waitcnt vmcnt(" #n ")" ::: "memory")
#define PG8_WAIT_L(n) asm volatile("s_waitcnt lgkmcnt(" #n ")" ::: "memory")
#define PG8_BAR __builtin_amdgcn_s_barrier()
#define PG8_SCHED __builtin_amdgcn_sched_barrier(0)
    Unit cur, nxt; int ui = 0;
    if (!S.next(0, cur)) return;
    f32x4 acc[2][2][4][2];
#pragma unroll
    for (int a = 0; a < 2; ++a)
#pragma unroll
        for (int b = 0; b < 2; ++b)
#pragma unroll
            for (int m = 0; m < 4; ++m)
#pragma unroll
                for (int n = 0; n < 2; ++n) acc[a][b][m][n] = (f32x4){0.f, 0.f, 0.f, 0.f};
    bf16x8 At[4][2], B0[2][2], B1[2][2];
    const char* cA = (const char*)g.A + (size_t)cur.pm * tstepA; const char* cB = (const char*)g.Bt + (size_t)cur.pn * tstepB;
    PG8_STAGE(PG8_SB(0, 0), cB, voffB); PG8_STAGE(PG8_SB(0, 1), cB + hstepB, voffB); PG8_STAGE(PG8_SA(0, 0), cA, voffA); PG8_STAGE(PG8_SA(0, 1), cA + hstepA, voffA);
    if (wr == 1) PG8_BAR;
    PG8_WAIT_V(2); PG8_BAR;
    PG8_STAGE(PG8_SB(1, 0), cB + kstep, voffB); PG8_STAGE(PG8_SA(1, 0), cA + KOFFA(1), voffA); PG8_STAGE(PG8_SB(1, 1), cB + hstepB + kstep, voffB);
    PG8_WAIT_V(6); PG8_BAR;
    for (;;) {
        const bool has_next = S.next(ui + 1, nxt);
        const char* nA = has_next ? (const char*)g.A + (size_t)nxt.pm * tstepA : cA; const char* nB = has_next ? (const char*)g.Bt + (size_t)nxt.pn * tstepB : cB;
        for (int t = 0; t < nt; t += 2) {
            const bool last = (t == nt - 2);
            const char* a1 = cA + KOFFA(t + 1);
            const char* a2 = last ? nA : cA + KOFFA(t + 2); const char* b2 = last ? nB : cB + (size_t)(t + 2) * kstep;
            const char* a3 = last ? nA + KOFFA(1) : cA + KOFFA(t + 3); const char* b3 = b2 + kstep;
            PG8_LDB(B0, 0, 0); PG8_LDB(B1, 0, 1); PG8_SCHED; PG8_LDA(At, 0, 0); PG8_STAGE(PG8_SA(1, 1), a1 + hstepA, voffA);
            PG8_WAIT_V(8); PG8_WAIT_L(0); PG8_BAR; PG8_MMA(0, 0, At, B0); PG8_MMA(0, 1, At, B1); PG8_BAR; PG8_SCHED;
            PG8_LDA(At, 0, 1); PG8_STAGE(PG8_SB(0, 0), b2, voffB); PG8_STAGE(PG8_SB(0, 1), b2 + hstepB, voffB); PG8_STAGE(PG8_SA(0, 0), a2, voffA);
            PG8_WAIT_V(8); PG8_WAIT_L(0); PG8_BAR; PG8_MMA(1, 0, At, B0); PG8_MMA(1, 1, At, B1); PG8_BAR; PG8_SCHED;
            PG8_LDB(B0, 1, 0); PG8_LDB(B1, 1, 1); PG8_SCHED; PG8_LDA(At, 1, 0); PG8_STAGE(PG8_SA(0, 1), a2 + hstepA, voffA);
            PG8_WAIT_V(8); PG8_WAIT_L(0); PG8_BAR; PG8_MMA(0, 0, At, B0); PG8_MMA(0, 1, At, B1); PG8_BAR; PG8_SCHED;
            PG8_LDA(At, 1, 1); PG8_STAGE(PG8_SB(1, 0), b3, voffB); PG8_STAGE(PG8_SB(1, 1), b3 + hstepB, voffB); PG8_STAGE(PG8_SA(1, 0), a3, voffA);
            PG8_WAIT_V(8); PG8_WAIT_L(0); PG8_BAR; PG8_MMA(1, 0, At, B0); PG8_MMA(1, 1, At, B1); PG8_BAR; PG8_SCHED;
        }
        if constexpr (ALIGN_EPI) { if (wr == 0) PG8_BAR; }
        E(acc, cur, wr, wc, fr, fq);
        if (!has_next) break;
#pragma unroll
        for (int a = 0; a < 2; ++a)
#pragma unroll
            for (int b = 0; b < 2; ++b)
#pragma unroll
                for (int m = 0; m < 4; ++m)
#pragma unroll
                    for (int n = 0; n < 2; ++n) acc[a][b][m][n] = (f32x4){0.f, 0.f, 0.f, 0.f};
        cur = nxt; cA = nA; cB = nB; ++ui;
        if constexpr (ALIGN_EPI) { if (wr == 1) PG8_BAR; }
    }
    PG8_WAIT_V(0);
    if constexpr (!ALIGN_EPI) { if (wr == 0) PG8_BAR; }
    PG8_BAR;
#undef KOFFA
#undef PG8_SA
#undef PG8_SB
#undef PG8_STAGE
#undef PG8_LDA
#undef PG8_LDB
#undef PG8_MMA
#undef PG8_WAIT_V
#undef PG8_WAIT_L
#undef PG8_BAR
#undef PG8_SCHED
}
}

typedef GAS unsigned gu32;
#define RLX_AGENT __ATOMIC_RELAXED, __HIP_MEMORY_SCOPE_AGENT
#define XB_TMO      128
#define XB_XCNT(j)  (256  + 64 * (j))
#define XB_XSUB(j)  (1280 + 64 * (j))
#define XB_XGEN(j)  (2304 + 64 * (j))
#define XB_TOP      3328
#define XB_TOPGEN   3392
#define XCD_BAR_WORDS 3456
#define XB_SPIN_CAP (1u << 18)
__device__ __forceinline__ unsigned xb_ld(unsigned* p)              { return __hip_atomic_load(p, __ATOMIC_RELAXED, __HIP_MEMORY_SCOPE_AGENT); }
__device__ __forceinline__ unsigned xb_add(unsigned* p, unsigned v) { return __hip_atomic_fetch_add(p, v, __ATOMIC_RELAXED, __HIP_MEMORY_SCOPE_AGENT); }
__device__ __forceinline__ unsigned xb_xcc_id() { return (unsigned)__builtin_amdgcn_s_getreg((3 << 11) | 20) & 0xFu; }
#define XB_SPIN(cond, bar) do { unsigned _sp = 0; while (cond) { __builtin_amdgcn_s_sleep(1); \
    if ((++_sp & 255u) == 0u) { if (xb_ld(&(bar)[XB_TMO])) break; if (_sp > XB_SPIN_CAP) { atomicAdd(&(bar)[XB_TMO], 1u); break; } } } } while (0)
struct XcdBarrier { unsigned* bar; unsigned x; volatile LAS unsigned* st; };
__device__ __forceinline__ XcdBarrier xcd_barrier_post(unsigned* bar, volatile LAS unsigned* st) {
    XcdBarrier b; b.bar = bar; b.x = xb_xcc_id(); b.st = st;
    if (threadIdx.x == 0) (void)xb_add(&bar[XB_XCNT(b.x)], 1u);
    return b;
}
__device__ __forceinline__ void xcd_barrier_complete(unsigned* bar, unsigned x, unsigned& nloc, unsigned& nx) {
    const unsigned G = gridDim.x * gridDim.y * gridDim.z;
    unsigned sum, cnt, mine, sp = 0u;
    for (;;) {
        sum = 0u; cnt = 0u; mine = 0u;
#pragma unroll
        for (unsigned j = 0; j < 16; ++j) { const unsigned c = xb_ld(&bar[XB_XCNT(j)]); sum += c; cnt += (c > 0u) ? 1u : 0u; mine = (j == x) ? c : mine; }
        if (sum == G) break;
        __builtin_amdgcn_s_sleep(1);
        if ((++sp & 255u) == 0u) { if (xb_ld(&bar[XB_TMO])) break; if (sp > XB_SPIN_CAP) { atomicAdd(&bar[XB_TMO], 1u); break; } }
    }
    nloc = mine > 0u ? mine : 1u; nx = cnt > 0u ? cnt : 1u;
}
__device__ __forceinline__ void xcd_barrier(const XcdBarrier& b) {
    asm volatile("s_waitcnt vmcnt(0)" ::: "memory");
    __syncthreads();
    if (threadIdx.x == 0) {
        unsigned* bar = b.bar;
        __builtin_amdgcn_s_waitcnt(0);
        unsigned nloc = b.st[0], nx = b.st[1];
        if (nloc == 0u) { xcd_barrier_complete(bar, b.x, nloc, nx); b.st[0] = nloc; b.st[1] = nx; }
        const unsigned old = xb_add(&bar[XB_XSUB(b.x)], 1u);
        const unsigned gen = old / nloc;
        if (old + 1u == (gen + 1u) * nloc) {
            __builtin_amdgcn_fence(__ATOMIC_RELEASE, "agent");
            asm volatile("s_waitcnt vmcnt(0)" ::: "memory");
            const unsigned og = xb_add(&bar[XB_TOP], 1u);
            const unsigned tg = og / nx;
            if (og + 1u == (tg + 1u) * nx) xb_add(&bar[XB_TOPGEN], 1u);
            else XB_SPIN(xb_ld(&bar[XB_TOPGEN]) == tg, bar);
            __builtin_amdgcn_fence(__ATOMIC_ACQUIRE, "agent");
            xb_add(&bar[XB_XGEN(b.x)], 1u);
            asm volatile("s_waitcnt vmcnt(0)" ::: "memory");
        } else {
            XB_SPIN(xb_ld(&bar[XB_XGEN(b.x)]) == gen, bar);
            __builtin_amdgcn_fence(__ATOMIC_ACQUIRE, "agent");
            asm volatile("s_waitcnt vmcnt(0)" ::: "memory");
        }
    }
    __syncthreads();
}

__device__ __forceinline__ void xcd_arrive(const XcdBarrier& b) {
    asm volatile("s_waitcnt vmcnt(0)" ::: "memory");
    __syncthreads();
    if (threadIdx.x == 0) {
        unsigned* bar = b.bar;
        __builtin_amdgcn_s_waitcnt(0);
        unsigned nloc = b.st[0], nx = b.st[1];
        if (nloc == 0u) { xcd_barrier_complete(bar, b.x, nloc, nx); b.st[0] = nloc; b.st[1] = nx; }
        const unsigned old = xb_add(&bar[XB_XSUB(b.x)], 1u);
        if ((old + 1u) % nloc == 0u) {
            __builtin_amdgcn_fence(__ATOMIC_RELEASE, "agent");
            asm volatile("s_waitcnt vmcnt(0)" ::: "memory");
            (void)xb_add(&bar[XB_TOP], 1u);
        }
    }
}
__device__ __forceinline__ void xcd_wait(const XcdBarrier& b, unsigned k) {
    if (threadIdx.x == 0) {
        unsigned* bar = b.bar;
        const unsigned want = b.st[1] * k;
        XB_SPIN(xb_ld(&bar[XB_TOP]) < want, bar);
        __builtin_amdgcn_fence(__ATOMIC_ACQUIRE, "agent");
        asm volatile("s_waitcnt vmcnt(0)" ::: "memory");
    }
    __syncthreads();
}

struct Args {
    const float *x_prompt, *x_sample, *cache_k, *cache_v, *state_ssm, *state_conv, *norm_w, *w_in, *conv_w, *conv_b,
                *dt_bias, *a_log, *d_skip, *ssm_norm_w, *q_norm_w, *k_norm_w, *sinks, *rel_table, *w_out;
    float* out; unsigned char* ws; int ph_lo, ph_hi, sub, dry;
};
constexpr int NWAVES = 8, NT = 512;
constexpr int RING_BYTES = 131072, LDS_BYTES = 147456, MISC_OFF = LDS_BYTES - 512;

template <bool REMAP>
__device__ __forceinline__ void p0_transpose_item(const float* W, int K, int N, bf16_t* WT, LAS bf16_t* scr, int item, int lane) {
    const int nblk = (N + 63) / 64, kb = item / nblk, nb = item % nblk, k0 = 64 * kb, n0 = 64 * nb;
    const bool nok = (n0 + lane) < N;
    const float* wp = W + (size_t)k0 * N + n0 + (nok ? lane : 0);
    float v[64];
#pragma unroll
    for (int kk = 0; kk < 64; ++kk) v[kk] = __builtin_nontemporal_load(wp + (size_t)kk * N);
#pragma unroll
    for (int kk = 0; kk < 64; kk += 2) *(LAS unsigned*)(scr + lane * 68 + kk) = pk2(v[kk], v[kk + 1]);
    LDS_WAIT(); asm volatile("" ::: "memory");
    const int c = lane & 7;
#pragma unroll
    for (int j = 0; j < 8; ++j) { const int n = (lane >> 3) + 8 * j;
        const u32x2 lo = *(const LAS u32x2*)(scr + n * 68 + 8 * c), hi = *(const LAS u32x2*)(scr + n * 68 + 8 * c + 4);
        u32x4 o; o.x = lo.x; o.y = lo.y; o.z = hi.x; o.w = hi.y;
        int ng = n0 + n;
        if (ng < N) { if (REMAP) ng = (ng < 2560) ? ng : (ng < 2576 ? ng + 2560 : ng - 16);
            st_wt16(WT + (size_t)ng * K + k0 + 8 * c, o); } }
    LDS_WAIT(); asm volatile("" ::: "memory");
}
__device__ __forceinline__ void p0_prologue(const Args& a, LAS unsigned char* lds, int vcu, int G, int wave, int lane, unsigned long long& amp_d) {
    unsigned long long amp_t = 0ull;
#define AMPB(k) do { if (MK_AMP == (k)) amp_t = __builtin_amdgcn_s_memrealtime(); } while (0)
#define AMPE(k) do { if (MK_AMP == (k)) { __syncthreads(); amp_d += __builtin_amdgcn_s_memrealtime() - amp_t; } } while (0)
    AMPB(100);
    LAS bf16_t* scr = (LAS bf16_t*)(lds + wave * 16384);
    bf16_t* WinT = (bf16_t*)(a.ws + WS_WIN); bf16_t* WoutT = (bf16_t*)(a.ws + WS_WOUT); bf16_t* H = (bf16_t*)(a.ws + WS_H);
    const int gw = vcu * NWAVES + wave, NGW = G * NWAVES;
    constexpr int I_IN = (DM / 64) * ((NIN + 63) / 64), I_OUT = (2048 / 64) * (DM / 64);
    for (int it = gw; it < I_IN + I_OUT; it += NGW) {
        if (it < I_IN) p0_transpose_item<true>(a.w_in, DM, NIN, WinT, scr, it, lane);
        else p0_transpose_item<false>(a.w_out, 2048, DM, WoutT, scr, it - I_IN, lane);
    }
    AMPE(100); AMPB(101);
    for (int r = gw; r < NINP - NIN; r += NGW) { u32x4* p = (u32x4*)(WinT + (size_t)(NIN + r) * DM); p[lane] = (u32x4){0u, 0u, 0u, 0u}; p[lane + 64] = (u32x4){0u, 0u, 0u, 0u}; }
    f32x4 nw[4];
#pragma unroll
    for (int j = 0; j < 4; ++j) nw[j] = ((const f32x4*)a.norm_w)[lane + 64 * j];
    f32x4 vn[4][4];
#define P0_LOAD(dst, mb) do { _Pragma("unroll") for (int r = 0; r < 4; ++r) { const int m = (mb) + r * NGW; \
        if (m < MT) { const float* xrow = (m < MP) ? a.x_prompt + (size_t)m * DM : a.x_sample + (size_t)(m - MP) * DM; const f32x4* xr = (const f32x4*)xrow + lane; \
            _Pragma("unroll") for (int j = 0; j < 4; ++j) dst[r][j] = __builtin_nontemporal_load(xr + 64 * j); } } } while (0)
    P0_LOAD(vn, gw);
    for (int m0 = gw; m0 < MT; m0 += 4 * NGW) {
        f32x4 v[4][4];
#pragma unroll
        for (int r = 0; r < 4; ++r)
#pragma unroll
            for (int j = 0; j < 4; ++j) v[r][j] = vn[r][j];
        if (m0 + 4 * NGW < MT) P0_LOAD(vn, m0 + 4 * NGW);
#pragma unroll
        for (int r = 0; r < 4; ++r) { const int m = m0 + r * NGW;
            if (m < MT) { float s = 0.f;
#pragma unroll
                for (int j = 0; j < 4; ++j) s += (v[r][j].x * v[r][j].x + v[r][j].y * v[r][j].y) + (v[r][j].z * v[r][j].z + v[r][j].w * v[r][j].w);
                const float rstd = __builtin_amdgcn_rsqf(wave_sum(s) * (1.f / DM) + EPS);
                unsigned long long* o8 = (unsigned long long*)(H + (size_t)m * DM) + lane;
#pragma unroll
                for (int j = 0; j < 4; ++j) { const f32x4 h = v[r][j] * rstd * nw[j]; u32x2 hw; hw.x = pk2(h.x, h.y); hw.y = pk2(h.z, h.w); st_wt8(o8 + 64 * j, hw); } } }
    }
#undef P0_LOAD
    AMPE(101);
#undef AMPB
#undef AMPE
}

__device__ __forceinline__ float ssd_dt_scan(const float* DT, int R0, int h, int e, int lane, const float* dt_bias, const float* a_log, LAS float* dtv, LAS float* acum, float& d0o, float& d1o, float& c0o, float& c1o) {
    const float bias = dt_bias[h]; const float A = -expf(a_log[h]);
    const int l0 = 2 * lane;
    const float d0 = softplus_f(DT[(size_t)(R0 + l0) * 16 + h] + bias), d1 = softplus_f(DT[(size_t)(R0 + l0 + 1) * 16 + h] + bias);
    const float a0 = d0 * A, a1 = d1 * A; float s = a0 + a1;
#pragma unroll
    for (int o = 1; o < 64; o <<= 1) { const float t = __shfl_up(s, o); if (lane >= o) s += t; }
    const float excl = s - (a0 + a1);
    const float c0 = excl + a0, c1 = excl + a0 + a1;
    dtv[e * 128 + l0] = d0; dtv[e * 128 + l0 + 1] = d1; acum[e * 128 + l0] = c0; acum[e * 128 + l0 + 1] = c1;
    d0o = d0; d1o = d1; c0o = c0; c1o = c1;
    return __shfl(s, 63);
}

typedef short v4i16_t __attribute__((ext_vector_type(4)));
__device__ __forceinline__ u32x2 lds_tr16(const LAS bf16_t* p) { return __builtin_bit_cast(u32x2, __builtin_amdgcn_ds_read_tr16_b64_v4i16((LAS v4i16_t*)p)); }
struct ConvRaw { u32x4 r[5]; };
__device__ __forceinline__ void conv_load(const bf16_t* U, const bf16_t* HALO, int R0, int gc, int c, int chb, int tid, ConvRaw& o) {
    const int q = tid & 7, r = tid >> 3;
#pragma unroll
    for (int i = 0; i < 5; ++i) {
        const int rr = 2 * r - 3 + i;
        u32x4 v = (u32x4){0u, 0u, 0u, 0u};
        if (rr >= 0) v = *(const u32x4*)(U + (size_t)(R0 + rr) * UW + C_X + chb + 8 * q);
        else if (c > 0) v = *(const u32x4*)(HALO + (size_t)((gc - 1) * 3 + 3 + rr) * CONVD + chb + 8 * q);
        o.r[i] = v;
    }
}
__device__ __forceinline__ void conv_apply(const ConvRaw& in, const LAS float* cw, int lc, float (&o0)[8], float (&o1)[8]) {
    float x[5][8];
#pragma unroll
    for (int i = 0; i < 5; ++i) { const u32x4 v = in.r[i]; x[i][0] = bflo(v.x); x[i][1] = bfhi(v.x); x[i][2] = bflo(v.y); x[i][3] = bfhi(v.y); x[i][4] = bflo(v.z); x[i][5] = bfhi(v.z); x[i][6] = bflo(v.w); x[i][7] = bfhi(v.w); }
    float w[5][8];
#pragma unroll
    for (int t = 0; t < 5; ++t) { const f32x4 a0 = *(const LAS f32x4*)(cw + t * 768 + lc), a1 = *(const LAS f32x4*)(cw + t * 768 + lc + 4);
        w[t][0] = a0.x; w[t][1] = a0.y; w[t][2] = a0.z; w[t][3] = a0.w; w[t][4] = a1.x; w[t][5] = a1.y; w[t][6] = a1.z; w[t][7] = a1.w; }
#pragma unroll
    for (int i = 0; i < 8; ++i) {
        o0[i] = silu_f(w[4][i] + w[0][i] * x[0][i] + w[1][i] * x[1][i] + w[2][i] * x[2][i] + w[3][i] * x[3][i]);
        o1[i] = silu_f(w[4][i] + w[0][i] * x[1][i] + w[1][i] * x[2][i] + w[2][i] * x[3][i] + w[3][i] * x[4][i]);
    }
}
__device__ __forceinline__ u32x4 pack8(const float (&v)[8]) { u32x4 w; w.x = pk2(v[0], v[1]); w.y = pk2(v[2], v[3]); w.z = pk2(v[4], v[5]); w.w = pk2(v[6], v[7]); return w; }

__device__ __forceinline__ void ssd_state_item(const Args& a, LAS unsigned char* lds, int item, int tid, int wave, int lane, const bool dry = false) {
    const int b = item >> 7, c = (item >> 1) & 63, g = item & 1, gc = b * 64 + c;
    const int R0 = b * SEQ + c * 128;
    bf16_t* U = (bf16_t*)(a.ws + WS_U); const float* DT = (const float*)(a.ws + WS_DT); const bf16_t* HALO = (const bf16_t*)(a.ws + WS_HALO);
    bf16_t* ST = (bf16_t*)(a.ws + WS_ST); float* DEC = (float*)(a.ws + WS_DEC);
    LAS bf16_t* Bn = (LAS bf16_t*)lds;
    LAS bf16_t* Xw0 = (LAS bf16_t*)(lds + 34816);
    LAS float* dtv = (LAS float*)(lds + 71680); LAS float* acum = dtv + 1024; LAS float* wv = acum + 1024;
    LAS float* cw = (LAS float*)(lds + 83968);
    auto blk_chb = [&](int k) -> int { return (k < 2) ? (1024 + 128 * g + 64 * k) : (k < 4) ? (1280 + 128 * g + 64 * (k - 2)) : (512 * g + 64 * (k - 4)); };
    auto blk_lc = [&](int k) -> int { return (k < 2) ? (512 + 64 * k) : (k < 4) ? (640 + 64 * (k - 2)) : (64 * (k - 4)); };
    ConvRaw raw; conv_load(U, HALO, R0, gc, c, blk_chb(0), tid, raw);
    for (int i = tid; i < 5 * 768; i += NT) { const int t = i / 768, lc = i % 768; const int ch = (lc < 512) ? (512 * g + lc) : (lc < 640) ? (1024 + 128 * g + (lc - 512)) : (1280 + 128 * g + (lc - 640));
        cw[i] = (t < 4) ? a.conv_w[t * CONVD + ch] : a.conv_b[ch]; }
    {
        float d0, d1, c0, c1; const int h = 8 * g + wave;
        const float aend = ssd_dt_scan(DT, R0, h, wave, lane, a.dt_bias, a.a_log, dtv, acum, d0, d1, c0, c1);
        wv[wave * 128 + 2 * lane] = d0 * __expf(aend - c0); wv[wave * 128 + 2 * lane + 1] = d1 * __expf(aend - c1);
        if (lane == 0 && !dry) DEC[gc * 16 + h] = __expf(aend);
    }
    __syncthreads();
    if (!dry) ((f32x4*)(a.ws + WS_DTA))[(size_t)item * 512 + tid] = ((const LAS f32x4*)dtv)[tid];
    const int fr = lane & 15, grp = lane >> 4, q = tid & 7, r = tid >> 3;
#pragma unroll 1
    for (int k = 0; k < 12; ++k) {
        ConvRaw cur = raw;
        if (k + 1 < 12) conv_load(U, HALO, R0, gc, c, blk_chb(k + 1), tid, raw);
        float o0[8], o1[8];
        if (dry && MK_ABL == 22) {
#pragma unroll
            for (int i = 0; i < 8; ++i) { o0[i] = bflo(cur.r[0].x) + i; o1[i] = bfhi(cur.r[4].w) + i; } }
        else conv_apply(cur, cw, blk_lc(k) + 8 * q, o0, o1);
        const u32x4 p0 = pack8(o0), p1 = pack8(o1);
        __syncthreads();
        bf16_t* up = U + (size_t)(R0 + 2 * r) * UW + C_X + blk_chb(k) + 8 * q;
        if (!dry || p0.x == 0x12345678u) { *(u32x4*)up = p0; *(u32x4*)(up + UW) = p1; }
        if (k < 2) { *(LAS u32x4*)(Bn + (2 * r) * 136 + 64 * k + 8 * q) = p0; *(LAS u32x4*)(Bn + (2 * r + 1) * 136 + 64 * k + 8 * q) = p1; }
        if (k >= 4) {
            const int e = k - 4, h = 8 * g + e;
            LAS bf16_t* Xw = Xw0 + (e & 1) * (128 * 72);
            const float w0 = wv[e * 128 + 2 * r], w1 = wv[e * 128 + 2 * r + 1];
#pragma unroll
            for (int i = 0; i < 8; ++i) { o0[i] *= w0; o1[i] *= w1; }
            *(LAS u32x4*)(Xw + (2 * r) * 72 + 8 * q) = pack8(o0); *(LAS u32x4*)(Xw + (2 * r + 1) * 72 + 8 * q) = pack8(o1);
            __syncthreads();
            if (dry && MK_ABL == 21) continue;
            f32x4 acc[4];
#pragma unroll
            for (int pt = 0; pt < 4; ++pt) acc[pt] = (f32x4){0.f, 0.f, 0.f, 0.f};
#pragma unroll
            for (int ks = 0; ks < 4; ++ks) {
                const int l0 = 32 * ks + 8 * grp + (fr >> 2);
                const u32x2 a0 = lds_tr16(Bn + l0 * 136 + 16 * wave + 4 * (fr & 3)), a1 = lds_tr16(Bn + (l0 + 4) * 136 + 16 * wave + 4 * (fr & 3));
                u32x2 b0[4], b1[4];
#pragma unroll
                for (int pt = 0; pt < 4; ++pt) { b0[pt] = lds_tr16(Xw + l0 * 72 + 16 * pt + 4 * (fr & 3)); b1[pt] = lds_tr16(Xw + (l0 + 4) * 72 + 16 * pt + 4 * (fr & 3)); }
                __builtin_amdgcn_sched_barrier(0);
                u32x4 aw; aw.x = a0.x; aw.y = a0.y; aw.z = a1.x; aw.w = a1.y;
#pragma unroll
                for (int pt = 0; pt < 4; ++pt) {
                    u32x4 bw; bw.x = b0[pt].x; bw.y = b0[pt].y; bw.z = b1[pt].x; bw.w = b1[pt].y;
                    acc[pt] = mfma16(__builtin_bit_cast(bf16x8, aw), __builtin_bit_cast(bf16x8, bw), acc[pt]);
                }
            }
            bf16_t* stp = ST + ((size_t)(gc * 16 + h) * 64) * 128 + 16 * wave + 4 * grp;
#pragma unroll
            for (int pt = 0; pt < 4; ++pt) { u32x2 o; o.x = pk2(acc[pt][0], acc[pt][1]); o.y = pk2(acc[pt][2], acc[pt][3]); if (!dry || o.x == 0x12345678u) *(u32x2*)(stp + (size_t)(16 * pt + fr) * 128) = o; }
        }
    }
    __syncthreads();
}

__device__ __forceinline__ void ssd_scan(const Args& a, LAS unsigned char* lds, int bx, int G, int tid, int wave, int lane, const bool dry) {
    u32x4* ST = (u32x4*)(a.ws + WS_ST); const float* DEC = (const float*)(a.ws + WS_DEC);
    LAS float* agg = (LAS float*)lds;
    const int seg = wave >> 1, gl = (wave & 1) * 64 + lane;
    for (int blk = bx; blk < NB * 16 * 8; blk += G) {
        const int bh = blk >> 3, b = bh >> 4, h = bh & 15, g8 = (blk & 7) * 128 + gl;
        u32x4* p = ST + ((size_t)(b * 64 + 16 * seg) * 16 + h) * 1024 + g8;
        const float* dp = DEC + (b * 64) * 16 + h;
        u32x4 v[16]; float d[16];
#pragma unroll
        for (int c = 0; c < 16; ++c) v[c] = p[(size_t)c * 16 * 1024];
        float pr[4];
#pragma unroll
        for (int s4 = 0; s4 < 4; ++s4) { float q = 1.f;
#pragma unroll
            for (int c = 0; c < 16; ++c) { const float dd = dp[(16 * s4 + c) * 16]; q *= dd; if (s4 == seg) d[c] = dd; }
            pr[s4] = q; }
        float cr[8];
#pragma unroll
        for (int i = 0; i < 8; ++i) cr[i] = 0.f;
#pragma unroll
        for (int c = 0; c < 16; ++c) { const u32x4 w = v[c]; const float f[8] = {bflo(w.x), bfhi(w.x), bflo(w.y), bfhi(w.y), bflo(w.z), bfhi(w.z), bflo(w.w), bfhi(w.w)};
#pragma unroll
            for (int i = 0; i < 8; ++i) cr[i] = cr[i] * d[c] + f[i]; }
        __syncthreads();
        *(LAS f32x4*)(agg + (seg * 128 + gl) * 8) = (f32x4){cr[0], cr[1], cr[2], cr[3]}; *(LAS f32x4*)(agg + (seg * 128 + gl) * 8 + 4) = (f32x4){cr[4], cr[5], cr[6], cr[7]};
        __syncthreads();
        float cin[8];
#pragma unroll
        for (int i = 0; i < 8; ++i) cin[i] = 0.f;
#pragma unroll
        for (int s4 = 0; s4 < 3; ++s4) if (s4 < seg) { const f32x4 a0 = *(const LAS f32x4*)(agg + (s4 * 128 + gl) * 8), a1 = *(const LAS f32x4*)(agg + (s4 * 128 + gl) * 8 + 4);
            const float av[8] = {a0.x, a0.y, a0.z, a0.w, a1.x, a1.y, a1.z, a1.w};
#pragma unroll
            for (int i = 0; i < 8; ++i) cin[i] = cin[i] * pr[s4] + av[i]; }
#pragma unroll
        for (int c = 0; c < 16; ++c) { const u32x4 w = v[c]; const float f[8] = {bflo(w.x), bfhi(w.x), bflo(w.y), bfhi(w.y), bflo(w.z), bfhi(w.z), bflo(w.w), bfhi(w.w)};
            u32x4 o; o.x = pk2(cin[0], cin[1]); o.y = pk2(cin[2], cin[3]); o.z = pk2(cin[4], cin[5]); o.w = pk2(cin[6], cin[7]);
            if (!dry) p[(size_t)c * 16 * 1024] = o;
#pragma unroll
            for (int i = 0; i < 8; ++i) cin[i] = cin[i] * d[c] + f[i]; }
        if (seg == 3 && (!dry || cin[0] == 12345.678f)) { float* o = a.out + O_SP + (size_t)bh * 8192 + 8 * g8;
            *(f32x4*)o = (f32x4){cin[0], cin[1], cin[2], cin[3]}; *(f32x4*)(o + 4) = (f32x4){cin[4], cin[5], cin[6], cin[7]}; }
    }
}

struct HeadRegs { u32x4 x[2], s[2]; u32x2 z[4]; };
__device__ __forceinline__ void ssd_out_load(const bf16_t* U, const bf16_t* ST, int R0, int gc, int h, int tid, int l, int grp, HeadRegs& o) {
#pragma unroll
    for (int i = 0; i < 2; ++i) { const int ci = tid + NT * i;
        o.x[i] = *(const u32x4*)(U + (size_t)(R0 + (ci >> 3)) * UW + C_X + 64 * h + 8 * (ci & 7));
        o.s[i] = *(const u32x4*)(ST + ((size_t)(gc * 16 + h) * 64 + (ci >> 4)) * 128 + 8 * (ci & 15)); }
    const bf16_t* zrow = U + (size_t)(R0 + l) * UW + C_Z + 64 * h + 4 * grp;
#pragma unroll
    for (int pt = 0; pt < 4; ++pt) o.z[pt] = *(const u32x2*)(zrow + 16 * pt);
}
__device__ __forceinline__ void ssd_out_stage(const HeadRegs& in, LAS bf16_t* X, LAS bf16_t* St, int tid) {
#pragma unroll
    for (int i = 0; i < 2; ++i) { const int ci = tid + NT * i;
        *(LAS u32x4*)(X + (ci >> 3) * 72 + 8 * (ci & 7)) = in.x[i];
        *(LAS u32x4*)(St + (ci >> 4) * 136 + 8 * (ci & 15)) = in.s[i]; }
}
__device__ __forceinline__ void ssd_out_item(const Args& a, LAS unsigned char* lds, int item, int tid, int wave, int lane, const bool dry) {
    const int b = item >> 7, c = (item >> 1) & 63, g = item & 1, gc = b * 64 + c;
    const int R0 = b * SEQ + c * 128;
    bf16_t* U = (bf16_t*)(a.ws + WS_U); const float* DT = (const float*)(a.ws + WS_DT); const bf16_t* ST = (const bf16_t*)(a.ws + WS_ST);
    LAS bf16_t* Cn = (LAS bf16_t*)lds;
    LAS bf16_t* setA = (LAS bf16_t*)(lds + 34816);
    LAS bf16_t* setB = (LAS bf16_t*)(lds + 70656);
    LAS bf16_t* Bn = setB;
    LAS float* dtv = (LAS float*)(lds + 106496); LAS float* acum = dtv + 1024;
    const int fr = lane & 15, grp = lane >> 4;
    const int l = 16 * wave + fr;
    HeadRegs hr; ssd_out_load(U, ST, R0, gc, 8 * g, tid, l, grp, hr);
    {
        u32x4 bv[4], cv[4];
#pragma unroll
        for (int i = 0; i < 4; ++i) { const int ci = tid + NT * i; const bf16_t* rp = U + (size_t)(R0 + (ci >> 4)) * UW + 128 * g + 8 * (ci & 15); bv[i] = *(const u32x4*)(rp + C_B); cv[i] = *(const u32x4*)(rp + C_C); }
        const f32x4 dta = ((const f32x4*)(a.ws + WS_DTA))[(size_t)item * 512 + tid];
#pragma unroll
        for (int i = 0; i < 4; ++i) { const int ci = tid + NT * i; *(LAS u32x4*)(Bn + (ci >> 4) * 136 + 8 * (ci & 15)) = bv[i]; *(LAS u32x4*)(Cn + (ci >> 4) * 136 + 8 * (ci & 15)) = cv[i]; }
        ((LAS f32x4*)dtv)[tid] = dta;
    }
    ssd_out_stage(hr, setA, setA + 128 * 72, tid);
    u32x2 zc[4];
#pragma unroll
    for (int pt = 0; pt < 4; ++pt) zc[pt] = hr.z[pt];
    __syncthreads();
    f32x4 cb[8];
#pragma unroll
    for (int st = 0; st < 8; ++st) cb[st] = (f32x4){0.f, 0.f, 0.f, 0.f};
#pragma unroll
    for (int ks = 0; ks < 4; ++ks) {
        const bf16x8 cf = *(const LAS bf16x8*)(Cn + (16 * wave + fr) * 136 + 32 * ks + 8 * grp);
#pragma unroll
        for (int st = 0; st < 8; ++st) if (st <= wave) { const bf16x8 bfm = *(const LAS bf16x8*)(Bn + (16 * st + fr) * 136 + 32 * ks + 8 * grp); cb[st] = mfma16(bfm, cf, cb[st]); }
    }
    __syncthreads();
    float ssq = 0.f;
    LAS bf16_t* stg = (LAS bf16_t*)(lds + 114688) + wave * (16 * 64);
    bf16_t* yb = U + (size_t)(R0 + 16 * wave) * UW + C_Z + 512 * g;
    const int e_n = (dry && MK_ABL == 13) ? 0 : 8;
#pragma unroll 1
    for (int e = 0; e < e_n; ++e) {
        const int h = 8 * g + e;
        LAS bf16_t* X = (e & 1) ? setB : setA; LAS bf16_t* St = X + 128 * 72;
        if (e < 7) ssd_out_load(U, ST, R0, gc, h + 1, tid, l, grp, hr);
        f32x4 accd[4], acco[4];
#pragma unroll
        for (int pt = 0; pt < 4; ++pt) { accd[pt] = (f32x4){0.f, 0.f, 0.f, 0.f}; acco[pt] = (f32x4){0.f, 0.f, 0.f, 0.f}; }
        const float al = acum[e * 128 + l];
#pragma unroll
        for (int ks = 0; ks < 4; ++ks) {
            if (dry && MK_ABL == 11) break;
            const int sA = 32 * ks + 4 * grp, sB = sA + 16;
            const bool diag = (2 * ks <= wave);
            const bf16x8 cf = *(const LAS bf16x8*)(Cn + (16 * wave + fr) * 136 + 32 * ks + 8 * grp);
            bf16x8 sf[4];
#pragma unroll
            for (int pt = 0; pt < 4; ++pt) sf[pt] = *(const LAS bf16x8*)(St + (16 * pt + fr) * 136 + 32 * ks + 8 * grp);
            f32x4 acA = (f32x4){0.f, 0.f, 0.f, 0.f}, acB = acA, dtA = acA, dtB = acA; u32x2 xlo[4], xhi[4];
            if (diag) {
                acA = *(const LAS f32x4*)(acum + e * 128 + sA); acB = *(const LAS f32x4*)(acum + e * 128 + sB);
                dtA = *(const LAS f32x4*)(dtv + e * 128 + sA); dtB = *(const LAS f32x4*)(dtv + e * 128 + sB);
#pragma unroll
                for (int pt = 0; pt < 4; ++pt) { xlo[pt] = lds_tr16(X + (sA + (fr >> 2)) * 72 + 16 * pt + 4 * (fr & 3)); xhi[pt] = lds_tr16(X + (sB + (fr >> 2)) * 72 + 16 * pt + 4 * (fr & 3)); }
            }
            __builtin_amdgcn_sched_barrier(0);
            if (diag) {
                float m[8];
#pragma unroll
                for (int j = 0; j < 4; ++j) {
                    const float va = cb[2 * ks][j] * dtA[j] * __expf(al - acA[j]); m[j] = (sA + j <= l) ? va : 0.f;
                    const float vb = cb[2 * ks + 1][j] * dtB[j] * __expf(al - acB[j]); m[4 + j] = (sB + j <= l) ? vb : 0.f;
                }
                u32x4 mw; mw.x = pk2(m[0], m[1]); mw.y = pk2(m[2], m[3]); mw.z = pk2(m[4], m[5]); mw.w = pk2(m[6], m[7]);
                const bf16x8 mf = __builtin_bit_cast(bf16x8, mw);
#pragma unroll
                for (int pt = 0; pt < 4; ++pt) {
                    u32x4 aw; aw.x = xlo[pt].x; aw.y = xlo[pt].y; aw.z = xhi[pt].x; aw.w = xhi[pt].y;
                    accd[pt] = mfma16(__builtin_bit_cast(bf16x8, aw), mf, accd[pt]);
                }
            }
#pragma unroll
            for (int pt = 0; pt < 4; ++pt) acco[pt] = mfma16(sf[pt], cf, acco[pt]);
        }
        const float eal = __expf(al), dsk = a.d_skip[h];
#pragma unroll
        for (int pt = 0; pt < 4; ++pt) {
            if (dry && MK_ABL == 12) break;
            const u32x2 zz = zc[pt];
            const u32x2 xx = *(const LAS u32x2*)(X + l * 72 + 16 * pt + 4 * grp);
            const float z[4] = {bflo(zz.x), bfhi(zz.x), bflo(zz.y), bfhi(zz.y)};
            const float xv[4] = {bflo(xx.x), bfhi(xx.x), bflo(xx.y), bfhi(xx.y)};
            float gy[4];
#pragma unroll
            for (int r = 0; r < 4; ++r) {
                const float y = accd[pt][r] + eal * acco[pt][r] + dsk * xv[r];
                gy[r] = y * silu_f(z[r]); ssq += gy[r] * gy[r];
            }
            u32x2 o; o.x = pk2(gy[0], gy[1]); o.y = pk2(gy[2], gy[3]);
            *(LAS u32x2*)(stg + fr * 64 + 8 * ((2 * pt + (grp >> 1)) ^ (fr & 7)) + 4 * (grp & 1)) = o;
        }
        LDS_WAIT(); asm volatile("" ::: "memory");
#pragma unroll
        for (int i = 0; i < 2; ++i) { const int row = 8 * i + (lane >> 3), ch = lane & 7;
            const u32x4 v = *(const LAS u32x4*)(stg + row * 64 + 8 * (ch ^ (row & 7)));
            if (!dry) *(u32x4*)(yb + (size_t)row * UW + 64 * e + 8 * ch) = v; }
        if (e < 7) {
            ssd_out_stage(hr, (e & 1) ? setA : setB, ((e & 1) ? setA : setB) + 128 * 72, tid);
#pragma unroll
            for (int pt = 0; pt < 4; ++pt) zc[pt] = hr.z[pt]; }
        __syncthreads();
    }
    ssq += __shfl_xor(ssq, 16); ssq += __shfl_xor(ssq, 32);
    const float rstd = __builtin_amdgcn_rsqf(ssq * (1.f / 512.f) + EPS);
    LAS float* rsw = (LAS float*)stg;
    if (grp == 0) rsw[fr] = rstd;
    LDS_WAIT(); asm volatile("" ::: "memory");
    const float rs0 = rsw[lane >> 3], rs1 = rsw[8 + (lane >> 3)];
#pragma unroll 2
    for (int e = 0; e < 8; ++e) {
        const int ch = lane & 7;
        const f32x4 nwa = *(const f32x4*)(a.ssm_norm_w + 512 * g + 64 * e + 8 * ch), nwb = *(const f32x4*)(a.ssm_norm_w + 512 * g + 64 * e + 8 * ch + 4);
#pragma unroll
        for (int i = 0; i < 2; ++i) { const int row = 8 * i + (lane >> 3); const float rs = i ? rs1 : rs0;
            bf16_t* p = yb + (size_t)row * UW + 64 * e + 8 * ch;
            const u32x4 v = *(const u32x4*)p;
            u32x4 o; o.x = pk2(bflo(v.x) * rs * nwa.x, bfhi(v.x) * rs * nwa.y); o.y = pk2(bflo(v.y) * rs * nwa.z, bfhi(v.y) * rs * nwa.w);
            o.z = pk2(bflo(v.z) * rs * nwb.x, bfhi(v.z) * rs * nwb.y); o.w = pk2(bflo(v.w) * rs * nwb.z, bfhi(v.w) * rs * nwb.w);
            if (!dry || o.x == 0x12345678u) *(u32x4*)p = o; }
    }
    __syncthreads();
}

__device__ __forceinline__ int rel_bucket(int d) {
    if (d < 16) return d;
    const int lg = 16 + (int)(logf((float)d * (1.0f / 16.0f)) * (16.0f / 2.0794415416798357f));
    return lg < 31 ? lg : 31;
}
struct AttnKV { u32x4 k[4], v[4]; };
__device__ __forceinline__ void attn_load_kv(const bf16_t* U, int unit, int tid, AttnKV& r) {
    const int b = unit >> 8, blk = (unit >> 2) & 63, kvh = unit & 3; const int R0 = b * SEQ + blk * 128;
    const int j = tid >> 1, hf = tid & 1;
    const bool z = (blk == 0 && j < 128);
    const bf16_t* rp = U + (size_t)(R0 - 128 + (z ? 128 : j)) * UW + 64 * kvh + 32 * hf;
    const u32x4* kp = (const u32x4*)(rp + C_K); const u32x4* vp = (const u32x4*)(rp + C_V);
#pragma unroll
    for (int i = 0; i < 4; ++i) { r.k[i] = kp[i]; r.v[i] = vp[i]; }
}
typedef float f32x16 __attribute__((ext_vector_type(16)));
__device__ __forceinline__ f32x16 mfma32(bf16x8 a, bf16x8 b, f32x16 c) { return __builtin_amdgcn_mfma_f32_32x32x16_bf16(a, b, c, 0, 0, 0); }
__device__ __forceinline__ void attn_phase(const Args& a, LAS unsigned char* lds, int unit0, int unit_end, int G, int tid, int wave, int lane, float m2, const bool dry, unsigned long long& amp_d) {
    unsigned long long amp_t = 0ull;
#define AMPB(k) do { if (MK_AMP == (k)) amp_t = __builtin_amdgcn_s_memrealtime(); } while (0)
#define AMPE(k) do { if (MK_AMP == (k)) amp_d += __builtin_amdgcn_s_memrealtime() - amp_t; } while (0)
    AMPB(210);
    bf16_t* U = (bf16_t*)(a.ws + WS_U);
    LAS bf16_t* Kn = (LAS bf16_t*)lds;
    LAS bf16_t* Vn = (LAS bf16_t*)(lds + 41472);
    LAS float* bias2 = (LAS float*)(lds + 82944);
    LAS float* qnw = (LAS float*)(lds + 95232);
    int unit = unit0; if (unit >= unit_end) return;
    AttnKV kv; attn_load_kv(U, unit, tid, kv);
    __syncthreads();
    for (int i = tid; i < 16 * 192; i += NT) { const int hh = i / 192, t = i % 192, d = 128 - (t - 32); bias2[i] = (d >= 0 && d <= 128) ? a.rel_table[rel_bucket(d) * 16 + hh] * LOG2E - m2 : -1e30f; }
    if (tid < 288) { *(LAS u32x4*)(Kn + 256 * 72 + tid * 8) = (u32x4){0u, 0u, 0u, 0u}; *(LAS u32x4*)(Vn + 256 * 72 + tid * 8) = (u32x4){0u, 0u, 0u, 0u}; }
    if (tid < 64) qnw[tid] = a.q_norm_w[tid] * (0.125f * LOG2E);
    const int r32 = lane & 31, hh = lane >> 5;
    while (unit < unit_end) {
        const int b = unit >> 8, blk = (unit >> 2) & 63, kvh = unit & 3;
        const int R0 = b * SEQ + blk * 128;
        const int gq = wave >> 1, hq = 4 * kvh + gq;
        u32x4 qraw[2][4];
#pragma unroll
        for (int qt = 0; qt < 2; ++qt) {
            const bf16_t* qrow = U + (size_t)(R0 + 64 * (wave & 1) + 32 * qt + r32) * UW + C_Q + 64 * hq + 8 * hh;
#pragma unroll
            for (int ks = 0; ks < 4; ++ks) qraw[qt][ks] = *(const u32x4*)(qrow + 16 * ks);
        }
        {
            const int j = tid >> 1, hf = tid & 1;
            const bool zero = (blk == 0 && j < 128);
            f32x4 kf[8];
#pragma unroll
            for (int i = 0; i < 4; ++i) { const u32x4 w = kv.k[i]; kf[2 * i] = (f32x4){bflo(w.x), bfhi(w.x), bflo(w.y), bfhi(w.y)}; kf[2 * i + 1] = (f32x4){bflo(w.z), bfhi(w.z), bflo(w.w), bfhi(w.w)}; }
            float ss = 0.f;
#pragma unroll
            for (int i = 0; i < 8; ++i) ss += (kf[i].x * kf[i].x + kf[i].y * kf[i].y) + (kf[i].z * kf[i].z + kf[i].w * kf[i].w);
            ss += __shfl_xor(ss, 1);
            const float rstd = zero ? 0.f : __builtin_amdgcn_rsqf(ss * (1.f / 64.f) + EPS);
#pragma unroll
            for (int i = 0; i < 8; ++i) { const f32x4 w = *(const f32x4*)(a.k_norm_w + 32 * hf + 4 * i); kf[i] = kf[i] * rstd * w; }
#pragma unroll
            for (int i = 0; i < 4; ++i) { u32x4 w; w.x = pk2(kf[2 * i].x, kf[2 * i].y); w.y = pk2(kf[2 * i].z, kf[2 * i].w); w.z = pk2(kf[2 * i + 1].x, kf[2 * i + 1].y); w.w = pk2(kf[2 * i + 1].z, kf[2 * i + 1].w);
                *(LAS u32x4*)(Kn + j * 72 + 32 * hf + 8 * i) = w;
                u32x4 vw = kv.v[i]; if (zero) vw = (u32x4){0u, 0u, 0u, 0u};
                *(LAS u32x4*)(Vn + j * 72 + 32 * hf + 8 * i) = vw; }
            if (blk == 63 && j >= 128 && !dry) {
                float* ok = a.out + O_KP + ((size_t)(b * 128 + (j - 128)) * 4 + kvh) * 64 + 32 * hf; float* ov = a.out + O_VP + ((size_t)(b * 128 + (j - 128)) * 4 + kvh) * 64 + 32 * hf;
#pragma unroll
                for (int i = 0; i < 8; ++i) *(f32x4*)(ok + 4 * i) = kf[i];
#pragma unroll
                for (int i = 0; i < 4; ++i) { const u32x4 w = kv.v[i]; *(f32x4*)(ov + 8 * i) = (f32x4){bflo(w.x), bfhi(w.x), bflo(w.y), bfhi(w.y)}; *(f32x4*)(ov + 8 * i + 4) = (f32x4){bflo(w.z), bfhi(w.z), bflo(w.w), bfhi(w.w)}; }
            }
        }
        const int nxt = unit + G;
        if (nxt < unit_end) attn_load_kv(U, nxt, tid, kv);
        __syncthreads();
        AMPE(210); AMPB(211);
        const float sink2 = a.sinks[hq] * LOG2E;
#pragma unroll
        for (int qt = 0; qt < 2; ++qt) {
            if (dry && MK_ABL == 2) break;
            const int i0 = 64 * (wave & 1) + 32 * qt, iq = i0 + r32;
            bf16_t* qrow = U + (size_t)(R0 + iq) * UW + C_Q + 64 * hq;
            u32x2 zraw[8];
            { const bf16_t* zrow = U + (size_t)(R0 + iq) * UW + C_ZA + 64 * hq + 4 * hh;
#pragma unroll
              for (int i = 0; i < 8; ++i) zraw[i] = *(const u32x2*)(zrow + 8 * i); }
            bf16x8 qf[4];
            {
                float qv[4][8]; float ss = 0.f;
#pragma unroll
                for (int ks = 0; ks < 4; ++ks) { const u32x4 w = qraw[qt][ks];
                    qv[ks][0] = bflo(w.x); qv[ks][1] = bfhi(w.x); qv[ks][2] = bflo(w.y); qv[ks][3] = bfhi(w.y); qv[ks][4] = bflo(w.z); qv[ks][5] = bfhi(w.z); qv[ks][6] = bflo(w.w); qv[ks][7] = bfhi(w.w);
#pragma unroll
                    for (int i = 0; i < 8; ++i) ss += qv[ks][i] * qv[ks][i]; }
                ss += __shfl_xor(ss, 32);
                const float rs = __builtin_amdgcn_rsqf(ss * (1.f / 64.f) + EPS);
#pragma unroll
                for (int ks = 0; ks < 4; ++ks) { const f32x4 w0 = *(const LAS f32x4*)(qnw + 16 * ks + 8 * hh), w1 = *(const LAS f32x4*)(qnw + 16 * ks + 8 * hh + 4);
                    u32x4 p; p.x = pk2(qv[ks][0] * rs * w0.x, qv[ks][1] * rs * w0.y); p.y = pk2(qv[ks][2] * rs * w0.z, qv[ks][3] * rs * w0.w);
                    p.z = pk2(qv[ks][4] * rs * w1.x, qv[ks][5] * rs * w1.y); p.w = pk2(qv[ks][6] * rs * w1.z, qv[ks][7] * rs * w1.w);
                    qf[ks] = __builtin_bit_cast(bf16x8, p); }
            }
            f32x16 oacc[2];
#pragma unroll
            for (int dt = 0; dt < 2; ++dt)
#pragma unroll
                for (int r = 0; r < 16; ++r) oacc[dt][r] = 0.f;
            float lsum = 0.f;
            const int kk_n = (dry && MK_ABL == 1) ? 0 : 5;
#pragma unroll 1
            for (int kk = 0; kk < kk_n; ++kk) {
                const int j0 = i0 + 32 * kk;
                bf16x8 kfr[4]; u32x2 vfr[2][2][2]; float btv[16];
#pragma unroll
                for (int ks = 0; ks < 4; ++ks) kfr[ks] = *(const LAS bf16x8*)(Kn + (j0 + r32) * 72 + 16 * ks + 8 * hh);
                const LAS float* bt = bias2 + hq * 192 + (32 * kk + 4 * hh - r32 + 32);
#pragma unroll
                for (int r = 0; r < 16; ++r) btv[r] = bt[(r & 3) + 8 * (r >> 2)];
                {   const int i16 = lane & 15, dsub = ((lane >> 4) & 1) * 16;
                    const LAS bf16_t* vb = Vn + (j0 + 4 * hh + (i16 >> 2)) * 72 + dsub + 4 * (i16 & 3);
#pragma unroll
                    for (int s2 = 0; s2 < 2; ++s2)
#pragma unroll
                        for (int dt = 0; dt < 2; ++dt) { vfr[s2][dt][0] = lds_tr16(vb + (16 * s2) * 72 + 32 * dt); vfr[s2][dt][1] = lds_tr16(vb + (16 * s2 + 8) * 72 + 32 * dt); }
                }
                __builtin_amdgcn_sched_barrier(0);
                f32x16 sacc;
#pragma unroll
                for (int r = 0; r < 16; ++r) sacc[r] = 0.f;
#pragma unroll
                for (int ks = 0; ks < 4; ++ks) sacc = mfma32(kfr[ks], qf[ks], sacc);
                float p[16];
#pragma unroll
                for (int r = 0; r < 16; ++r) p[r] = __builtin_amdgcn_exp2f(sacc[r] + btv[r]);
                if (blk == 0) {
#pragma unroll
                    for (int r = 0; r < 16; ++r) if (j0 + (r & 3) + 8 * (r >> 2) + 4 * hh < 128) p[r] = 0.f;
                }
#pragma unroll
                for (int r = 0; r < 16; ++r) lsum += p[r];
                u32x4 pw0, pw1;
                pw0.x = pk2(p[0], p[1]); pw0.y = pk2(p[2], p[3]); pw0.z = pk2(p[4], p[5]); pw0.w = pk2(p[6], p[7]);
                pw1.x = pk2(p[8], p[9]); pw1.y = pk2(p[10], p[11]); pw1.z = pk2(p[12], p[13]); pw1.w = pk2(p[14], p[15]);
                const bf16x8 pf0 = __builtin_bit_cast(bf16x8, pw0), pf1 = __builtin_bit_cast(bf16x8, pw1);
#pragma unroll
                for (int dt = 0; dt < 2; ++dt) {
                    u32x4 a0; a0.x = vfr[0][dt][0].x; a0.y = vfr[0][dt][0].y; a0.z = vfr[0][dt][1].x; a0.w = vfr[0][dt][1].y;
                    u32x4 a1; a1.x = vfr[1][dt][0].x; a1.y = vfr[1][dt][0].y; a1.z = vfr[1][dt][1].x; a1.w = vfr[1][dt][1].y;
                    oacc[dt] = mfma32(__builtin_bit_cast(bf16x8, a0), pf0, oacc[dt]);
                    oacc[dt] = mfma32(__builtin_bit_cast(bf16x8, a1), pf1, oacc[dt]);
                }
            }
            lsum += __shfl_xor(lsum, 32);
            const float rl = __builtin_amdgcn_rcpf(lsum + __builtin_amdgcn_exp2f(sink2 - m2));
#pragma unroll
            for (int dt = 0; dt < 2; ++dt)
#pragma unroll
                for (int g4 = 0; g4 < 4; ++g4) {
                    const u32x2 zz = zraw[4 * dt + g4];
                    u32x2 o; o.x = pk2(oacc[dt][4 * g4] * rl * silu_f(bflo(zz.x)), oacc[dt][4 * g4 + 1] * rl * silu_f(bfhi(zz.x))); o.y = pk2(oacc[dt][4 * g4 + 2] * rl * silu_f(bflo(zz.y)), oacc[dt][4 * g4 + 3] * rl * silu_f(bfhi(zz.y)));
                    if (!dry || o.x == 0x12345678u) *(u32x2*)(qrow + 32 * dt + 8 * g4 + 4 * hh) = o;
                }
        }
        unit = nxt;
        __syncthreads();
        AMPE(211); AMPB(210);
    }
#undef AMPB
#undef AMPE
}
__device__ __forceinline__ float attn_shift(const Args& a, int lane, float& bmax2) {
    float wq = fabsf(a.q_norm_w[lane]), wk = fabsf(a.k_norm_w[lane]);
    float rb = 0.f;
    for (int i = lane; i < 512; i += 64) rb = fmaxf(rb, fabsf(a.rel_table[i]));
    if (lane < 16) rb = fmaxf(rb, fabsf(a.sinks[lane]));
#pragma unroll
    for (int o = 1; o < 64; o <<= 1) { wq = fmaxf(wq, __shfl_xor(wq, o)); wk = fmaxf(wk, __shfl_xor(wk, o)); rb = fmaxf(rb, __shfl_xor(rb, o)); }
    bmax2 = rb * LOG2E;
    return (8.0f * wq * wk + rb) * LOG2E;
}

__device__ __forceinline__ void samp_ssm_item(const Args& a, LAS unsigned char* lds, int item, int tid, int wave, int lane, const bool dry) {
    const int b = item >> 1, g = item & 1;
    const int Rs = MP + 4 * b;
    bf16_t* U = (bf16_t*)(a.ws + WS_U); const float* DT = (const float*)(a.ws + WS_DT);
    LAS float* xs = (LAS float*)lds;
    LAS float* Bs = xs + 2048;
    LAS float* Cs = Bs + 512;
    LAS float* gy = Cs + 512;
    LAS float* dts = gy + 2048;
    LAS float* avs = dts + 32;
    LAS float* rstd_s = avs + 32;
    __syncthreads();
    for (int cc = tid; cc < 768; cc += NT) {
        int ch; LAS float* dst;
        if (cc < 512) { ch = 512 * g + cc; dst = xs + cc; } else if (cc < 640) { ch = 1024 + 128 * g + (cc - 512); dst = Bs + (cc - 512); } else { ch = 1280 + 128 * g + (cc - 640); dst = Cs + (cc - 640); }
        const int stride = (cc < 512) ? 512 : 128;
        const float w0 = a.conv_w[ch], w1 = a.conv_w[CONVD + ch], w2 = a.conv_w[2 * CONVD + ch], w3 = a.conv_w[3 * CONVD + ch], cb = a.conv_b[ch];
        const float* sc = a.state_conv + (size_t)b * 3 * CONVD + ch;
        float f[7]; f[0] = sc[0]; f[1] = sc[CONVD]; f[2] = sc[2 * CONVD];
#pragma unroll
        for (int t = 0; t < 4; ++t) f[3 + t] = bf2f(U[(size_t)(Rs + t) * UW + C_X + ch]);
#pragma unroll
        for (int t = 0; t < 4; ++t) dst[t * stride] = silu_f(cb + w0 * f[t] + w1 * f[t + 1] + w2 * f[t + 2] + w3 * f[t + 3]);
    }
    if (tid < 32) { const int e = tid >> 2, t = tid & 3, h = 8 * g + e; const float d = softplus_f(DT[(size_t)(Rs + t) * 16 + h] + a.dt_bias[h]); dts[tid] = d; avs[tid] = d * (-expf(a.a_log[h])); }
    __syncthreads();
    const int p = tid >> 3, nq = tid & 7;
    f32x4 Sn[4];
    { const float* sp0 = a.state_ssm + ((size_t)(b * 16 + 8 * g) * 64 + p) * 128 + 4 * nq;
#pragma unroll
      for (int i = 0; i < 4; ++i) Sn[i] = __builtin_nontemporal_load((const f32x4*)(sp0 + 32 * i)); }
#pragma unroll 1
    for (int e = 0; e < 8; ++e) {
        const int h = 8 * g + e;
        f32x4 S[4];
#pragma unroll
        for (int i = 0; i < 4; ++i) S[i] = Sn[i];
        if (e < 7) { const float* sp = a.state_ssm + ((size_t)(b * 16 + h + 1) * 64 + p) * 128 + 4 * nq;
#pragma unroll
            for (int i = 0; i < 4; ++i) Sn[i] = __builtin_nontemporal_load((const f32x4*)(sp + 32 * i)); }
        float yv[4];
#pragma unroll
        for (int t = 0; t < 4; ++t) {
            const float dA = __expf(avs[e * 4 + t]); const float coef = dts[e * 4 + t] * xs[t * 512 + 64 * e + p];
            float acc = 0.f;
#pragma unroll
            for (int i = 0; i < 4; ++i) { const f32x4 Bv = *(const LAS f32x4*)(Bs + t * 128 + 4 * nq + 32 * i), Cv = *(const LAS f32x4*)(Cs + t * 128 + 4 * nq + 32 * i);
                S[i] = S[i] * dA + coef * Bv; acc += (Cv.x * S[i].x + Cv.y * S[i].y) + (Cv.z * S[i].z + Cv.w * S[i].w); }
            acc += __shfl_xor(acc, 1); acc += __shfl_xor(acc, 2); acc += __shfl_xor(acc, 4);
            yv[t] = acc;
        }
        float* op = a.out + O_SS + ((size_t)(b * 16 + h) * 64 + p) * 128 + 4 * nq;
#pragma unroll
        for (int i = 0; i < 4; ++i) if (!dry || S[i].x == 12345.678f) __builtin_nontemporal_store(S[i], (f32x4*)(op + 32 * i));
        if (nq < 4) { const int t = nq; const float xv = xs[t * 512 + 64 * e + p];
            const float yt = (nq == 0) ? yv[0] : (nq == 1) ? yv[1] : (nq == 2) ? yv[2] : yv[3];
            const float y = yt + a.d_skip[h] * xv; const float z = bf2f(U[(size_t)(Rs + t) * UW + C_Z + 64 * h + p]);
            gy[t * 512 + 64 * e + p] = y * silu_f(z); }
    }
    __syncthreads();
    if (wave < 4) { float s = 0.f;
#pragma unroll
        for (int i = 0; i < 8; ++i) { const float v = gy[wave * 512 + lane + 64 * i]; s += v * v; }
        s = wave_sum(s); if (lane == 0) rstd_s[wave] = __builtin_amdgcn_rsqf(s * (1.f / 512.f) + EPS); }
    __syncthreads();
    for (int i = tid; i < 2048; i += NT) { const int t = i >> 9, ch = i & 511;
        const unsigned ov = f2bf(gy[i] * rstd_s[t] * a.ssm_norm_w[512 * g + ch]); if (!dry || ov == 0x12345u) U[(size_t)(Rs + t) * UW + C_Z + 512 * g + ch] = (bf16_t)ov; }
}

struct SampAttnRegs { f32x4 k[4], v[4]; unsigned kx, vx, q0, q1; };
__device__ __forceinline__ void samp_attn_load(const Args& a, const bf16_t* U, int item, int tid, int wave, int lane, SampAttnRegs& r) {
    const int b = item >> 2, kvh = item & 3, Rs = MP + 4 * b;
    const int w = tid >> 2, qd = tid & 3;
    const float* kp = a.cache_k + ((size_t)(b * 128 + w) * 4 + kvh) * 64 + 16 * qd; const float* vp = a.cache_v + ((size_t)(b * 128 + w) * 4 + kvh) * 64 + 16 * qd;
#pragma unroll
    for (int i = 0; i < 4; ++i) { r.k[i] = __builtin_nontemporal_load((const f32x4*)(kp + 4 * i)); r.v[i] = __builtin_nontemporal_load((const f32x4*)(vp + 4 * i)); }
    const int t = wave & 3;
    r.kx = U[(size_t)(Rs + t) * UW + C_K + 64 * kvh + lane]; r.vx = U[(size_t)(Rs + t) * UW + C_V + 64 * kvh + lane];
    { const int qi = 2 * wave, gq = qi >> 2, tt = qi & 3; r.q0 = U[(size_t)(Rs + tt) * UW + C_Q + 64 * (4 * kvh + gq) + lane]; }
    { const int qi = 2 * wave + 1, gq = qi >> 2, tt = qi & 3; r.q1 = U[(size_t)(Rs + tt) * UW + C_Q + 64 * (4 * kvh + gq) + lane]; }
}
__device__ __forceinline__ void samp_attn_phase(const Args& a, LAS unsigned char* lds, int bx, int G, int tid, int wave, int lane, const bool dry, float bmax2) {
    bf16_t* U = (bf16_t*)(a.ws + WS_U);
    LAS bf16_t* Kn = (LAS bf16_t*)lds;
    LAS bf16_t* Vn = (LAS bf16_t*)(lds + 23040);
    LAS float* tb = (LAS float*)(lds + 46080);
    LAS f32x4* redo = (LAS f32x4*)(lds + 49152);
    LAS float* redl = (LAS float*)(lds + 69632);
    LAS unsigned* kmx = (LAS unsigned*)(lds + 70912);
    int item = bx; if (item >= 512) return;
    SampAttnRegs rg; samp_attn_load(a, U, item, tid, wave, lane, rg);
    __syncthreads();
    for (int i = tid; i < 28 * 72 / 8; i += NT) { *(LAS u32x4*)(Kn + 132 * 72 + 8 * i) = (u32x4){0u, 0u, 0u, 0u}; *(LAS u32x4*)(Vn + 132 * 72 + 8 * i) = (u32x4){0u, 0u, 0u, 0u}; }
    const int fr = lane & 15, grp = lane >> 4;
    while (item < 512) {
        const int b = item >> 2, kvh = item & 3;
        const int Rs = MP + 4 * b;
        if (tid == 0) kmx[0] = 0u;
        for (int i = tid; i < 4 * 168; i += NT) { const int gq = i / 168, u = (i % 168) - 3, d = 128 - u; tb[i] = (d >= 0 && d <= 128) ? a.rel_table[rel_bucket(d) * 16 + 4 * kvh + gq] * LOG2E : -1e30f; }
        __syncthreads();
        float k2 = 0.f;
        {
            const int w = tid >> 2, qd = tid & 3;
#pragma unroll
            for (int i = 0; i < 4; ++i) k2 += (rg.k[i].x * rg.k[i].x + rg.k[i].y * rg.k[i].y) + (rg.k[i].z * rg.k[i].z + rg.k[i].w * rg.k[i].w);
            u32x4 k0, k1, v0, v1;
            k0.x = pk2(rg.k[0].x, rg.k[0].y); k0.y = pk2(rg.k[0].z, rg.k[0].w); k0.z = pk2(rg.k[1].x, rg.k[1].y); k0.w = pk2(rg.k[1].z, rg.k[1].w);
            k1.x = pk2(rg.k[2].x, rg.k[2].y); k1.y = pk2(rg.k[2].z, rg.k[2].w); k1.z = pk2(rg.k[3].x, rg.k[3].y); k1.w = pk2(rg.k[3].z, rg.k[3].w);
            v0.x = pk2(rg.v[0].x, rg.v[0].y); v0.y = pk2(rg.v[0].z, rg.v[0].w); v0.z = pk2(rg.v[1].x, rg.v[1].y); v0.w = pk2(rg.v[1].z, rg.v[1].w);
            v1.x = pk2(rg.v[2].x, rg.v[2].y); v1.y = pk2(rg.v[2].z, rg.v[2].w); v1.z = pk2(rg.v[3].x, rg.v[3].y); v1.w = pk2(rg.v[3].z, rg.v[3].w);
            *(LAS u32x4*)(Kn + w * 72 + 16 * qd) = k0; *(LAS u32x4*)(Kn + w * 72 + 16 * qd + 8) = k1;
            *(LAS u32x4*)(Vn + w * 72 + 16 * qd) = v0; *(LAS u32x4*)(Vn + w * 72 + 16 * qd + 8) = v1;
            k2 += __shfl_xor(k2, 1); k2 += __shfl_xor(k2, 2);
        }
        if (wave < 4) {
            const int t = wave;
            const float kx = bf2f(rg.kx), vx = bf2f(rg.vx);
            const float ss = wave_sum(kx * kx); const float kn = kx * __builtin_amdgcn_rsqf(ss * (1.f / 64.f) + EPS) * a.k_norm_w[lane];
            Kn[(128 + t) * 72 + lane] = (bf16_t)f2bf(kn); Vn[(128 + t) * 72 + lane] = (bf16_t)rg.vx;
            k2 = fmaxf(k2, wave_sum(kn * kn));
            if (!dry) { a.out[O_KS + ((size_t)(b * 128 + 124 + t) * 4 + kvh) * 64 + lane] = kn; a.out[O_VS + ((size_t)(b * 128 + 124 + t) * 4 + kvh) * 64 + lane] = vx; }
        }
#pragma unroll
        for (int o = 1; o < 64; o <<= 1) k2 = fmaxf(k2, __shfl_xor(k2, o));
        if (lane == 0) (void)__hip_atomic_fetch_max(kmx, __builtin_bit_cast(unsigned, k2), __ATOMIC_RELAXED, __HIP_MEMORY_SCOPE_WORKGROUP);
        bf16x8 qf[2]; float qn2 = 0.f;
        const int tq = fr & 3, hq = 4 * kvh + (fr >> 2);
        if (wave < 5) {
            const bf16_t* qrow = U + (size_t)(Rs + tq) * UW + C_Q + 64 * hq + 8 * grp;
            const u32x4 w0 = *(const u32x4*)(qrow), w1 = *(const u32x4*)(qrow + 32);
            float qv[16] = {bflo(w0.x), bfhi(w0.x), bflo(w0.y), bfhi(w0.y), bflo(w0.z), bfhi(w0.z), bflo(w0.w), bfhi(w0.w),
                            bflo(w1.x), bfhi(w1.x), bflo(w1.y), bfhi(w1.y), bflo(w1.z), bfhi(w1.z), bflo(w1.w), bfhi(w1.w)};
            float ss = 0.f;
#pragma unroll
            for (int i = 0; i < 16; ++i) ss += qv[i] * qv[i];
            ss += __shfl_xor(ss, 16); ss += __shfl_xor(ss, 32);
            const float rs = (0.125f * LOG2E) * __builtin_amdgcn_rsqf(ss * (1.f / 64.f) + EPS);
#pragma unroll
            for (int i = 0; i < 16; ++i) { qv[i] *= rs * a.q_norm_w[(i < 8 ? 0 : 32) + 8 * grp + (i & 7)]; qn2 += qv[i] * qv[i]; }
            qn2 += __shfl_xor(qn2, 16); qn2 += __shfl_xor(qn2, 32);
            u32x4 p0, p1;
            p0.x = pk2(qv[0], qv[1]); p0.y = pk2(qv[2], qv[3]); p0.z = pk2(qv[4], qv[5]); p0.w = pk2(qv[6], qv[7]);
            p1.x = pk2(qv[8], qv[9]); p1.y = pk2(qv[10], qv[11]); p1.z = pk2(qv[12], qv[13]); p1.w = pk2(qv[14], qv[15]);
            qf[0] = __builtin_bit_cast(bf16x8, p0); qf[1] = __builtin_bit_cast(bf16x8, p1);
        }
        const int nxt = item + G;
        if (nxt < 512) samp_attn_load(a, U, nxt, tid, wave, lane, rg);
        __syncthreads();
        const float mq = sqrtf(qn2 * __builtin_bit_cast(float, kmx[0])) + bmax2;
        if (wave < 5) {
            const int j0 = 32 * wave;
            bf16x8 kfr[2][2]; u32x2 vlo[4], vhi[4]; float btv[8];
#pragma unroll
            for (int ks = 0; ks < 2; ++ks) { kfr[0][ks] = *(const LAS bf16x8*)(Kn + (j0 + fr) * 72 + 32 * ks + 8 * grp); kfr[1][ks] = *(const LAS bf16x8*)(Kn + (j0 + 16 + fr) * 72 + 32 * ks + 8 * grp); }
            const LAS float* bt = tb + (fr >> 2) * 168 + (j0 + 4 * grp - tq + 3);
#pragma unroll
            for (int r = 0; r < 4; ++r) { btv[r] = bt[r]; btv[4 + r] = bt[16 + r]; }
#pragma unroll
            for (int dt = 0; dt < 4; ++dt) { vlo[dt] = lds_tr16(Vn + (j0 + 4 * grp + (fr >> 2)) * 72 + 16 * dt + 4 * (fr & 3)); vhi[dt] = lds_tr16(Vn + (j0 + 16 + 4 * grp + (fr >> 2)) * 72 + 16 * dt + 4 * (fr & 3)); }
            __builtin_amdgcn_sched_barrier(0);
            f32x4 s0 = (f32x4){0.f, 0.f, 0.f, 0.f}, s1 = (f32x4){0.f, 0.f, 0.f, 0.f};
#pragma unroll
            for (int ks = 0; ks < 2; ++ks) { s0 = mfma16(kfr[0][ks], qf[ks], s0); s1 = mfma16(kfr[1][ks], qf[ks], s1); }
            float p[8]; float lsum = 0.f;
#pragma unroll
            for (int r = 0; r < 4; ++r) { p[r] = __builtin_amdgcn_exp2f(s0[r] + btv[r] - mq); p[4 + r] = __builtin_amdgcn_exp2f(s1[r] + btv[4 + r] - mq); }
#pragma unroll
            for (int r = 0; r < 8; ++r) lsum += p[r];
            u32x4 pw; pw.x = pk2(p[0], p[1]); pw.y = pk2(p[2], p[3]); pw.z = pk2(p[4], p[5]); pw.w = pk2(p[6], p[7]);
            const bf16x8 pf = __builtin_bit_cast(bf16x8, pw);
#pragma unroll
            for (int dt = 0; dt < 4; ++dt) {
                u32x4 aw; aw.x = vlo[dt].x; aw.y = vlo[dt].y; aw.z = vhi[dt].x; aw.w = vhi[dt].y;
                redo[(wave * 4 + dt) * 64 + lane] = mfma16(__builtin_bit_cast(bf16x8, aw), pf, (f32x4){0.f, 0.f, 0.f, 0.f});
            }
            redl[wave * 64 + lane] = lsum;
        }
        __syncthreads();
        if (wave < 4) {
            const int dt = wave;
            f32x4 o = redo[(0 * 4 + dt) * 64 + lane]; float l = redl[lane];
#pragma unroll
            for (int k5 = 1; k5 < 5; ++k5) { o += redo[(k5 * 4 + dt) * 64 + lane]; l += redl[k5 * 64 + lane]; }
            l += __shfl_xor(l, 16); l += __shfl_xor(l, 32);
            const float rl = __builtin_amdgcn_rcpf(l + __builtin_amdgcn_exp2f(a.sinks[hq] * LOG2E - mq));
            const u32x2 zz = *(const u32x2*)(U + (size_t)(Rs + tq) * UW + C_ZA + 64 * hq + 16 * dt + 4 * grp);
            u32x2 ov; ov.x = pk2(o[0] * rl * silu_f(bflo(zz.x)), o[1] * rl * silu_f(bfhi(zz.x))); ov.y = pk2(o[2] * rl * silu_f(bflo(zz.y)), o[3] * rl * silu_f(bfhi(zz.y)));
            if (!dry || ov.x == 0x12345678u) *(u32x2*)(U + (size_t)(Rs + tq) * UW + C_Q + 64 * hq + 16 * dt + 4 * grp) = ov;
        }
        item = nxt;
    }
}
__device__ __forceinline__ void cache_shift_copy(const Args& a, int it, int tid) {
    const int b = it >> 1; const float* src = (it & 1) ? a.cache_v : a.cache_k; float* dst = a.out + ((it & 1) ? O_VS : O_KS);
    const f32x4* s4 = (const f32x4*)(src + (size_t)(b * 128 + 4) * 256); f32x4* d4 = (f32x4*)(dst + (size_t)(b * 128) * 256);
#pragma unroll 8
    for (int i = tid; i < 124 * 64; i += NT) __builtin_nontemporal_store(__builtin_nontemporal_load(s4 + i), d4 + i);
}

__device__ __forceinline__ void conv_out_item(const Args& a, int item, int tid) {
    const bf16_t* U = (const bf16_t*)(a.ws + WS_U);
    for (int i = tid; i < 3 * CONVD; i += NT) {
        const int r = i / CONVD, ch = i % CONVD;
        if (item < NB) a.out[O_CP + (size_t)item * 3 * CONVD + i] = bf2f(((const bf16_t*)(a.ws + WS_HALO))[(size_t)((item * 64 + 63) * 3 + r) * CONVD + ch]);
        else { const int b = item - NB; a.out[O_CS + (size_t)b * 3 * CONVD + i] = bf2f(U[(size_t)(MP + 4 * b + 1 + r) * UW + C_X + ch]); }
    }
}

__device__ __forceinline__ void samp_outproj_tile(const Args& a, LAS unsigned char* lds, int it, int tid, int wave, int lane) {
    const bf16_t* U = (const bf16_t*)(a.ws + WS_U); const bf16_t* Wt = (const bf16_t*)(a.ws + WS_WOUT);
    LAS bf16_t* T = (LAS bf16_t*)lds;
    LAS f32x4* red = (LAS f32x4*)(lds + 131584);
    const int r0 = 32 * (it >> 4), c0 = 64 * (it & 15);
    const int fr = lane & 15, grp = lane >> 4, kh = wave >> 2, cg = wave & 3;
    __syncthreads();
    {   u32x4 tv[16];
#pragma unroll
        for (int i = 0; i < 16; ++i) { const int ci = tid + NT * i, row = ci >> 8, k = 8 * (ci & 255);
            tv[i] = *(const u32x4*)(U + (size_t)(MP + r0 + row) * UW + (k < 1024 ? C_Z + k : C_Q + (k - 1024))); }
#pragma unroll
        for (int i = 0; i < 16; ++i) { const int ci = tid + NT * i, row = ci >> 8, k = 8 * (ci & 255); *(LAS u32x4*)(T + row * 2056 + k) = tv[i]; }
    }
    const bf16_t* wp = Wt + (size_t)(c0 + 16 * cg + fr) * 2048 + 1024 * kh + 8 * grp;
    const LAS bf16_t* tp = T + fr * 2056 + 1024 * kh + 8 * grp;
    f32x4 acc0 = (f32x4){0.f, 0.f, 0.f, 0.f}, acc1 = (f32x4){0.f, 0.f, 0.f, 0.f};
    bf16x8 wf[8];
#pragma unroll
    for (int i = 0; i < 8; ++i) wf[i] = *(const bf16x8*)(wp + 32 * i);
    __syncthreads();
#pragma unroll
    for (int kb = 0; kb < 4; ++kb) {
        bf16x8 wc[8];
#pragma unroll
        for (int i = 0; i < 8; ++i) wc[i] = wf[i];
        if (kb < 3) {
#pragma unroll
            for (int i = 0; i < 8; ++i) wf[i] = *(const bf16x8*)(wp + 32 * (8 * (kb + 1) + i)); }
#pragma unroll
        for (int i = 0; i < 8; ++i) { const int ks = 8 * kb + i;
            const bf16x8 t0 = *(const LAS bf16x8*)(tp + 32 * ks), t1 = *(const LAS bf16x8*)(tp + 16 * 2056 + 32 * ks);
            acc0 = mfma16(wc[i], t0, acc0); acc1 = mfma16(wc[i], t1, acc1); }
    }
    if (kh) { red[(cg * 2 + 0) * 64 + lane] = acc0; red[(cg * 2 + 1) * 64 + lane] = acc1; }
    __syncthreads();
    if (!kh) {
        acc0 += red[(cg * 2 + 0) * 64 + lane]; acc1 += red[(cg * 2 + 1) * 64 + lane];
        const size_t o0 = (size_t)(r0 + fr) * DM + c0 + 16 * cg + 4 * grp, o1 = o0 + (size_t)16 * DM;
        *(f32x4*)(a.out + O_YS + o0) = *(const f32x4*)(a.x_sample + o0) + acc0;
        *(f32x4*)(a.out + O_YS + o1) = *(const f32x4*)(a.x_sample + o1) + acc1;
    }
}

__global__ void __launch_bounds__(NT, 2) mk_fwd(Args args) {
    extern __shared__ __attribute__((aligned(16))) unsigned char lds_raw[];
    LAS unsigned char* lds = (LAS unsigned char*)lds_raw;
    volatile LAS unsigned* MISC = (volatile LAS unsigned*)(lds + MISC_OFF);
    const int tid = threadIdx.x, lane = tid & 63, wave = __builtin_amdgcn_readfirstlane(tid >> 6);
    const int G = gridDim.x; const int bx = blockIdx.x; const int vcu = (G % 8 == 0) ? (bx % 8) * (G / 8) + bx / 8 : bx;
    gu32* ctl = (gu32*)(args.ws + WS_CTL);
    for (int u = tid; u < 512 / 4; u += NT) ((LAS unsigned*)(lds + MISC_OFF))[u] = 0u;
    __syncthreads();
    XcdBarrier bar; bar.bar = (unsigned*)(ctl + CW_BAR); bar.x = 0; bar.st = nullptr;
    if (MK_N_LAUNCHES == 1) bar = xcd_barrier_post((unsigned*)(ctl + CW_BAR), MISC + 8);
    const int lo = args.ph_lo, hi = args.ph_hi;
#define IN(k) (lo <= (k) && (k) < hi)
#define GRID_BAR() do { if (MK_N_LAUNCHES == 1) xcd_barrier(bar); } while (0)

    const bool dry = (args.dry != 0);
    unsigned long long amp_t = 0ull, amp_d = 0ull;
#define AMP_BEGIN(k) do { if (MK_AMP == (k)) amp_t = __builtin_amdgcn_s_memrealtime(); } while (0)
#define AMP_END(k) do { if (MK_AMP == (k)) amp_d += __builtin_amdgcn_s_memrealtime() - amp_t; } while (0)
    AMP_BEGIN(0);
    p0_prologue(args, lds, vcu, G, wave, lane, amp_d);
    AMP_BEGIN(102); xcd_arrive(bar); xcd_wait(bar, 1u); AMP_END(102);
    AMP_END(0);

    AMP_BEGIN(1);
    {
        pg8::Gemm g{(const bf16_t*)(args.ws + WS_H), (const bf16_t*)(args.ws + WS_WIN), MT, NINP, DM, DM, 1 << 20, 0};
        pg8::StaticOrder S; S.init(MT, NINP, G, bx);
        pg8::EpiU E{(bf16_t*)(args.ws + WS_U), (float*)(args.ws + WS_DT), (bf16_t*)(args.ws + WS_HALO)};
        pg8::gemm_phase<pg8::EpiU, pg8::StaticOrder, true>(lds, g, S, E);
        xcd_arrive(bar);
        for (int it = bx; it < 2 * DB; it += G) cache_shift_copy(args, it, tid);
        AMP_BEGIN(14); xcd_wait(bar, 2u); AMP_END(14);
    }
    AMP_END(1);

    AMP_BEGIN(2);
    float bmax2; const float m2 = attn_shift(args, lane, bmax2);
    AMP_BEGIN(20); for (int it = bx; it < 256; it += G) ssd_state_item(args, lds, it, tid, wave, lane); AMP_END(20);
    xcd_arrive(bar);
    AMP_BEGIN(21); attn_phase(args, lds, bx, 512, G, tid, wave, lane, m2, dry, amp_d); AMP_END(21);
    AMP_BEGIN(22); for (int it = bx; it < 256; it += G) samp_ssm_item(args, lds, it, tid, wave, lane, dry); AMP_END(22);
    AMP_BEGIN(23); samp_attn_phase(args, lds, bx, G, tid, wave, lane, dry, bmax2); AMP_END(23);
    for (int it = bx; it < NB + DB; it += G) conv_out_item(args, it, tid);
    AMP_BEGIN(24); xcd_wait(bar, 3u); AMP_END(24);
    AMP_END(2);

    AMP_BEGIN(3);
    ssd_scan(args, lds, bx, G, tid, wave, lane, dry);
    AMP_BEGIN(34); xcd_arrive(bar); xcd_wait(bar, 4u); AMP_END(34);
    AMP_END(3);

    AMP_BEGIN(4);
    for (int it = bx; it < 256; it += G) ssd_out_item(args, lds, it, tid, wave, lane, dry);
    xcd_arrive(bar);
    AMP_BEGIN(50); for (int it = bx; it < 256; it += G) samp_outproj_tile(args, lds, it, tid, wave, lane); AMP_END(50);
    AMP_BEGIN(44); xcd_wait(bar, 5u); AMP_END(44);
    AMP_END(4);

    AMP_BEGIN(5);
    {
        pg8::Gemm g{(const bf16_t*)(args.ws + WS_U), (const bf16_t*)(args.ws + WS_WOUT), MP, DM, 2048, UW, 16, (size_t)(C_Q - 1024) * 2};
        pg8::StaticOrder S; S.init(MP, DM, G, bx);
        pg8::EpiOut E{args.x_prompt, args.x_sample, args.out};
        pg8::gemm_phase<pg8::EpiOut, pg8::StaticOrder, true>(lds, g, S, E);
    }
    AMP_END(5);
    if (MK_AMP >= 0 && bx == MK_AMPBLK && tid == 0) {
        const unsigned long long t0 = __builtin_amdgcn_s_memrealtime();
        while (__builtin_amdgcn_s_memrealtime() - t0 < 4ull * amp_d) __builtin_amdgcn_s_sleep(8);
    }
#undef AMP_BEGIN
#undef AMP_END
#undef IN
#undef GRID_BAR
}

extern "C" void kernel_launch(void* const* d_in, const int* in_sizes, int n_in, void* d_out, int out_size, void* d_ws, size_t ws_size, hipStream_t stream) {
    static int grid = 0;
    if (grid == 0) {
        if (n_in != 19 || (size_t)out_size != O_END || ws_size < WS_END) { fprintf(stderr, "kernel_launch: unexpected shapes (n_in %d, out %d, ws %zu)\n", n_in, out_size, ws_size); grid = -1; return; }
        int dev = 0, cus = 0;
        if (hipGetDevice(&dev) != hipSuccess || hipDeviceGetAttribute(&cus, hipDeviceAttributeMultiprocessorCount, dev) != hipSuccess) { grid = -1; return; }
        if (hipFuncSetAttribute((const void*)mk_fwd, hipFuncAttributeMaxDynamicSharedMemorySize, LDS_BYTES) != hipSuccess) { fprintf(stderr, "kernel_launch: hipFuncSetAttribute failed\n"); grid = -1; return; }
        int per_cu = 0;
        if (hipOccupancyMaxActiveBlocksPerMultiprocessor(&per_cu, (const void*)mk_fwd, NT, LDS_BYTES) != hipSuccess || per_cu < 1) fprintf(stderr, "kernel_launch: occupancy query reports %d blocks per CU\n", per_cu);
        (void)hipGetLastError();
        grid = cus;
    }
    if (grid < 0) return;
    (void)hipMemsetAsync((char*)d_ws + WS_CTL, 0, CTL_ZERO_BYTES, stream);
    Args a{};
    const float** ap = (const float**)&a;
    for (int i = 0; i < 19; ++i) ap[i] = (const float*)d_in[i];
    a.out = (float*)d_out; a.ws = (unsigned char*)d_ws;
    a.sub = 31; a.dry = 0;
    if (MK_N_LAUNCHES == 1) { a.ph_lo = 0; a.ph_hi = 6; hipLaunchKernelGGL(mk_fwd, dim3(grid), dim3(NT), LDS_BYTES, stream, a); }
    else for (int ph = 0; ph < 6; ++ph) {
        a.ph_lo = ph; a.ph_hi = ph + 1; a.sub = 31; a.dry = 0;
        hipLaunchKernelGGL(mk_fwd, dim3(grid), dim3(NT), LDS_BYTES, stream, a);
        if (MK_DUP == ph) { a.dry = 1; hipLaunchKernelGGL(mk_fwd, dim3(grid), dim3(NT), LDS_BYTES, stream, a); }
        if (ph == 2 && MK_DUP >= 20 && MK_DUP < 24) { a.sub = 1 << (MK_DUP - 20); a.dry = 1; hipLaunchKernelGGL(mk_fwd, dim3(grid), dim3(NT), LDS_BYTES, stream, a); }
    }
}
```

```cpp
#include <hip/hip_runtime.h>
#include <cstdio>
#include <cstdint>

#ifndef MK_N_LAUNCHES
#define MK_N_LAUNCHES 1
#endif

#ifndef MK_AMP
#define MK_AMP (-1)
#endif
#ifndef MK_ABL
#define MK_ABL 0
#endif
#ifndef MK_AMPBLK
#define MK_AMPBLK 0
#endif
#ifndef MK_DUP
#define MK_DUP (-1)
#endif
#define LAS __attribute__((address_space(3)))
#define GAS __attribute__((address_space(1)))
typedef unsigned short bf16_t;
typedef short bf16x8 __attribute__((ext_vector_type(8)));
typedef short bf16x4 __attribute__((ext_vector_type(4)));
typedef float f32x4 __attribute__((ext_vector_type(4)));
typedef float f32x2 __attribute__((ext_vector_type(2)));
typedef unsigned u32x4 __attribute__((ext_vector_type(4)));
typedef unsigned u32x2 __attribute__((ext_vector_type(2)));

constexpr int DM = 1024, SEQ = 8192, NB = 2, MP = NB * SEQ;
constexpr int DB = 128, DL = 4, MS = DB * DL, MT = MP + MS;
constexpr int NIN = 5136, NINP = 5376;
constexpr int UW = 5120;
__host__ __device__ __forceinline__ size_t uoff(int row, int col) { return ((size_t)(col >> 6) * 16896 + (size_t)row) * 64 + (size_t)(col & 63); }
constexpr int C_Z = 0, C_X = 1024, C_B = 2048, C_C = 2304, C_Q = 2560, C_K = 3584, C_V = 3840, C_ZA = 4096;
constexpr int CONVD = 1536;
constexpr float EPS = 1e-6f;
constexpr float LOG2E = 1.4426950408889634f;

constexpr size_t MiB = 1u << 20;
constexpr size_t WS_CTL = 0, CTL_ZERO_BYTES = 32768;
constexpr size_t WS_WIN = 1 * MiB;
constexpr size_t WS_WOUT = 12 * MiB;
constexpr size_t WS_DT = 16 * MiB;
constexpr size_t WS_DEC = 17 * MiB + 512 * 1024;
constexpr size_t WS_U = 18 * MiB;
constexpr size_t WS_H = 183 * MiB;
constexpr size_t WS_ST = 183 * MiB;
constexpr size_t WS_HALO = 247 * MiB;
constexpr size_t WS_DTA = 249 * MiB;
constexpr size_t WS_RS = 251 * MiB;
constexpr size_t WS_END = 252 * MiB;
constexpr int CW_BAR = 4096;

constexpr size_t O_YP = 0, O_YS = 16777216, O_KP = 17301504, O_VP = 17367040, O_SP = 17432576, O_CP = 17694720,
                 O_KS = 17703936, O_VS = 21898240, O_SS = 26092544, O_CS = 42869760, O_END = 43459584;

typedef __bf16 hwbf16x2 __attribute__((ext_vector_type(2)));
__device__ __forceinline__ unsigned pk2(float lo, float hi) { const f32x2 v = {lo, hi}; return __builtin_bit_cast(unsigned, __builtin_convertvector(v, hwbf16x2)); }
__device__ __forceinline__ unsigned f2bf(float f) { return pk2(f, 0.f) & 0xffffu; }
__device__ __forceinline__ float bf2f(unsigned v) { return __builtin_bit_cast(float, v << 16); }
__device__ __forceinline__ float bflo(unsigned w) { return __builtin_bit_cast(float, w << 16); }
__device__ __forceinline__ float bfhi(unsigned w) { return __builtin_bit_cast(float, w & 0xffff0000u); }
__device__ __forceinline__ float silu_f(float x) { return x * __builtin_amdgcn_rcpf(1.0f + __expf(-x)); }
__device__ __forceinline__ float softplus_f(float x) { return fmaxf(x, 0.f) + log1pf(__expf(-fabsf(x))); }
__device__ __forceinline__ float wave_sum(float v) {
#pragma unroll
    for (int o = 1; o < 64; o <<= 1) v += __shfl_xor(v, o);
    return v;
}
__device__ __forceinline__ f32x4 mfma16(bf16x8 a, bf16x8 b, f32x4 c) { return __builtin_amdgcn_mfma_f32_16x16x32_bf16(a, b, c, 0, 0, 0); }
__device__ __forceinline__ void st_wt16(void* p, u32x4 v) { asm volatile("global_store_dwordx4 %0, %1, off sc1\n\ts_nop 1" :: "v"(p), "v"(v) : "memory"); }
__device__ __forceinline__ void st_wt8(void* p, u32x2 v) { asm volatile("global_store_dwordx2 %0, %1, off sc1\n\ts_nop 1" :: "v"(p), "v"(v) : "memory"); }
#define LDS_WAIT() asm volatile("s_waitcnt lgkmcnt(0)" ::: "memory")
#define VM_WAIT() asm volatile("s_waitcnt vmcnt(0)" ::: "memory")

namespace pg8 {
constexpr int FAC_OFF = 131072;
constexpr int BM = 256, BK = 64, HALF = 128, HTB = HALF * BK * 2, STAGE_BYTES = 8 * HTB, NXCD = 8, WGM = 8;
__host__ __device__ __forceinline__ int lds_byte(int r, int c) { const int st = (r >> 4) * 2 + (c >> 5), rr = r & 15, cc = c & 31, ob = rr * 64 + cc * 2; return st * 1024 + (ob ^ (((ob >> 9) & 1) << 5)); }
__host__ __device__ __forceinline__ void stage_rc(int b, int& R, int& C) { const int st = b / 1024, sb = b % 1024, swz = sb ^ (((sb >> 9) & 1) << 5); R = (st >> 1) * 16 + swz / 64; C = (st & 1) * 32 + (swz % 64) / 2; }
__host__ __device__ __forceinline__ int perm32(int rho) { const int n = rho >> 4, i = rho & 15; return 8 * (i >> 2) + 4 * n + (i & 3); }

struct Unit { int pm, pn; };
struct Gemm { const bf16_t* A; const bf16_t* Bt; int M, N, K, lda, kseg; size_t segskip, kstepA; };

struct StaticOrder {
    int nM, nN, nwg, G, c;
    __host__ __device__ void init(int M, int N, int G_, int c_) { nM = M / BM; nN = N / BM; nwg = nM * nN; G = G_; c = c_; }
    __host__ __device__ bool next(int i, Unit& u) const {
        const long L = (long)i * G + c; if (L >= nwg) return false;
        int wgid = (int)L; { const int q = nwg / NXCD, r = nwg % NXCD, xcd = wgid % NXCD, off = wgid / NXCD; wgid = (xcd < r ? xcd * (q + 1) : r * (q + 1) + (xcd - r) * q) + off; }
        const int nig = WGM * nN, gid = wgid / nig, fm = gid * WGM, gsz = (nM - fm) < WGM ? (nM - fm) : WGM;
        u.pm = fm + ((wgid % nig) % gsz); u.pn = (wgid % nig) / gsz; return true;
    }
};

__device__ __forceinline__ unsigned cvt_pk_bf16(float lo, float hi) { unsigned r; asm volatile("v_cvt_pk_bf16_f32 %0, %1, %2" : "=v"(r) : "v"(lo), "v"(hi)); return r; }

struct EpiU {
    static constexpr bool PERM = true, SCALE = false;
    bf16_t* U; float* DT; bf16_t* HALO;
    __device__ __forceinline__ void operator()(const f32x4 (&acc)[2][2][4][2], const Unit& u, int wr, int wc, int fr, int fq) const {
        const int row0 = u.pm * BM + wr * 64 + fr;
        if (u.pn < 20) {
            const bool halo = (u.pn >= 4) && (u.pn < 10) && (u.pm < MP / BM) && (wr == 1) && (fr >= 13);
            const int col0 = u.pn * BM + wc * 32 + 8 * fq;
#pragma unroll
            for (int ai = 0; ai < 2; ++ai)
#pragma unroll
                for (int m = 0; m < 4; ++m) { const int urow = row0 + ai * HALF + m * 16;
#pragma unroll
                    for (int bj = 0; bj < 2; ++bj) { const f32x4 v0 = acc[ai][bj][m][0], v1 = acc[ai][bj][m][1];
                        u32x4 w; w.x = cvt_pk_bf16(v0[0], v0[1]); w.y = cvt_pk_bf16(v0[2], v0[3]); w.z = cvt_pk_bf16(v1[0], v1[1]); w.w = cvt_pk_bf16(v1[2], v1[3]);
                        *(u32x4*)(U + uoff(urow, col0 + bj * HALF)) = w;
                        if (m == 3 && halo) *(u32x4*)(HALO + (size_t)((u.pm * 2 + ai) * 3 + (fr - 13)) * CONVD + (col0 - C_X) + bj * HALF) = w; } }
        } else if (wc == 0 && fq < 2) {
#pragma unroll
            for (int ai = 0; ai < 2; ++ai)
#pragma unroll
                for (int m = 0; m < 4; ++m) { float* rowp = DT + (size_t)(row0 + ai * HALF + m * 16) * 16 + 8 * fq;
                    *(f32x4*)(rowp) = acc[ai][0][m][0]; *(f32x4*)(rowp + 4) = acc[ai][0][m][1]; }
        }
    }
};
struct EpiOut {
    static constexpr bool PERM = false, SCALE = true;
    const float* xp; const float* xs; float* out; const float* RS;
    __device__ __forceinline__ float factor(const Unit& u, int tid) const { const int r = u.pm * BM + (tid & 255); const float r0 = RS[r], r1 = RS[MP + r]; return (tid >> 8) ? r1 : r0 / r1; }
    __device__ __forceinline__ void operator()(const f32x4 (&acc)[2][2][4][2], const Unit& u, int wr, int wc, int fr, int fq) const {
        const int col0 = u.pn * BM + wc * 32 + 4 * fq;
#pragma unroll
        for (int ai = 0; ai < 2; ++ai) {
            f32x4 xv[4][2][2];
#pragma unroll
            for (int m = 0; m < 4; ++m) { const int row = u.pm * BM + ai * HALF + wr * 64 + m * 16 + fr;
                const float* xb = (row < MP) ? xp + (size_t)row * DM : xs + (size_t)(row - MP) * DM;
#pragma unroll
                for (int bj = 0; bj < 2; ++bj)
#pragma unroll
                    for (int n = 0; n < 2; ++n) xv[m][bj][n] = __builtin_nontemporal_load((const f32x4*)(xb + col0 + bj * HALF + n * 16)); }
            __builtin_amdgcn_sched_barrier(0);
#pragma unroll
            for (int m = 0; m < 4; ++m) { const int row = u.pm * BM + ai * HALF + wr * 64 + m * 16 + fr; float* ob = out + (size_t)row * DM;
#pragma unroll
                for (int bj = 0; bj < 2; ++bj)
#pragma unroll
                    for (int n = 0; n < 2; ++n) __builtin_nontemporal_store(xv[m][bj][n] + acc[ai][bj][m][n], (f32x4*)(ob + col0 + bj * HALF + n * 16)); }
        }
    }
};

template <class Epi, class Sched, bool ALIGN_EPI>
__device__ __forceinline__ void gemm_phase(LAS unsigned char* lds, const Gemm g, const Sched& S, const Epi& E) {
    int tid_ = threadIdx.x; asm volatile("" : "+v"(tid_));
    const int tid = tid_, wid = __builtin_amdgcn_readfirstlane(tid >> 6), lane = tid & 63, wr = wid >> 2, wc = wid & 3, fr = lane & 15, fq = lane >> 4;
    const int K = g.K, nt = K / BK, lda = g.lda, kseg = g.kseg;
    unsigned voffA[2], voffB[2];
#pragma unroll
    for (int i = 0; i < 2; ++i) { int R, C; stage_rc(tid * 16 + i * 8192, R, C); const int Rb = Epi::PERM ? ((R & ~31) + perm32(R & 31)) : R;
        voffA[i] = (unsigned)(R * lda + C) * 2u; voffB[i] = (unsigned)(Rb * K + C) * 2u; }
    const size_t kstep = (size_t)(BK * 2);
    const size_t hstepA = (size_t)HALF * lda * 2, tstepA = 2 * hstepA;
    const size_t hstepB = (size_t)HALF * K * 2, tstepB = 2 * hstepB;
    const size_t segskip = g.segskip, kstepA = g.kstepA;
#define KOFFA(t) ((size_t)(t) * kstepA + (((t) >= kseg) ? segskip : (size_t)0))
    const unsigned ldsw = (unsigned)wid * 1024u;
    const int aoff = lds_byte(wr * 64 + fr, fq * 8), boff = lds_byte(wc * 32 + fr, fq * 8);
#define PG8_SA(b, h) (((b) * 2 + (h)) * HTB)
#define PG8_SB(b, h) ((4 + (b) * 2 + (h)) * HTB)
#define PG8_STAGE(bufoff, gbase, voff) do { _Pragma("unroll") for (int _i = 0; _i < 2; ++_i) \
        __builtin_amdgcn_global_load_lds((const unsigned*)((const char*)(gbase) + (voff)[_i]), (LAS unsigned*)(lds + (bufoff) + ldsw + _i * 8192), 16, 0, 0); } while (0)
#define PG8_LDA(dst, b, h) do { _Pragma("unroll") for (int m = 0; m < 4; ++m) _Pragma("unroll") for (int k = 0; k < 2; ++k) dst[m][k] = *(const LAS bf16x8*)(lds + PG8_SA(b, h) + aoff + m * 2048 + k * 1024); } while (0)
#define PG8_LDB(dst, b, h) do { _Pragma("unroll") for (int n = 0; n < 2; ++n) _Pragma("unroll") for (int k = 0; k < 2; ++k) dst[n][k] = *(const LAS bf16x8*)(lds + PG8_SB(b, h) + boff + n * 2048 + k * 1024); } while (0)
#define PG8_MMA(ai, bj, At, Bt) do { __builtin_amdgcn_s_setprio(1); _Pragma("unroll") for (int m = 0; m < 4; ++m) _Pragma("unroll") for (int n = 0; n < 2; ++n) _Pragma("unroll") for (int k = 0; k < 2; ++k) \
        acc[ai][bj][m][n] = __builtin_amdgcn_mfma_f32_16x16x32_bf16(Bt[n][k], At[m][k], acc[ai][bj][m][n], 0, 0, 0); __builtin_amdgcn_s_setprio(0); } while (0)
#define PG8_WAIT_V(n) asm volatile("s_waitcnt vmcnt(" #n ")" ::: "memory")
#define PG8_WAIT_L(n) asm volatile("s_waitcnt lgkmcnt(" #n ")" ::: "memory")
#define PG8_BAR __builtin_amdgcn_s_barrier()
#define PG8_SCHED __builtin_amdgcn_sched_barrier(0)
    Unit cur, nxt; int ui = 0;
    if (!S.next(0, cur)) return;
    f32x4 acc[2][2][4][2];
#pragma unroll
    for (int a = 0; a < 2; ++a)
#pragma unroll
        for (int b = 0; b < 2; ++b)
#pragma unroll
            for (int m = 0; m < 4; ++m)
#pragma unroll
                for (int n = 0; n < 2; ++n) acc[a][b][m][n] = (f32x4){0.f, 0.f, 0.f, 0.f};
    bf16x8 At[4][2], B0[2][2], B1[2][2];
    float fsc = 0.f;
    if constexpr (Epi::SCALE) fsc = E.factor(cur, tid);
    const char* cA = (const char*)g.A + (size_t)cur.pm * tstepA; const char* cB = (const char*)g.Bt + (size_t)cur.pn * tstepB;
    PG8_STAGE(PG8_SB(0, 0), cB, voffB); PG8_STAGE(PG8_SB(0, 1), cB + hstepB, voffB); PG8_STAGE(PG8_SA(0, 0), cA, voffA); PG8_STAGE(PG8_SA(0, 1), cA + hstepA, voffA);
    if (wr == 1) PG8_BAR;
    PG8_WAIT_V(2); PG8_BAR;
    if constexpr (Epi::SCALE) *(LAS float*)(lds + FAC_OFF + tid * 4) = fsc;
    PG8_STAGE(PG8_SB(1, 0), cB + kstep, voffB); PG8_STAGE(PG8_SA(1, 0), cA + KOFFA(1), voffA); PG8_STAGE(PG8_SB(1, 1), cB + hstepB + kstep, voffB);
    PG8_WAIT_V(6); PG8_BAR;
    for (;;) {
        const bool has_next = S.next(ui + 1, nxt);
        const char* nA = has_next ? (const char*)g.A + (size_t)nxt.pm * tstepA : cA; const char* nB = has_next ? (const char*)g.Bt + (size_t)nxt.pn * tstepB : cB;
        for (int t = 0; t < nt; t += 2) {
            const bool last = (t == nt - 2);
            if constexpr (Epi::SCALE) { if (t == 8 || t == 16) {
                const LAS float* fp = (const LAS float*)(lds + FAC_OFF) + (t == 16 ? 256 : 0) + wr * 64 + fr;
                float f[2][4];
                _Pragma("unroll") for (int a = 0; a < 2; ++a) _Pragma("unroll") for (int m = 0; m < 4; ++m) f[a][m] = fp[a * HALF + m * 16];
                _Pragma("unroll") for (int a = 0; a < 2; ++a) _Pragma("unroll") for (int b = 0; b < 2; ++b) _Pragma("unroll") for (int m = 0; m < 4; ++m) _Pragma("unroll") for (int n = 0; n < 2; ++n) acc[a][b][m][n] *= f[a][m];
            } }
            const char* a1 = cA + KOFFA(t + 1);
            const char* a2 = last ? nA : cA + KOFFA(t + 2); const char* b2 = last ? nB : cB + (size_t)(t + 2) * kstep;
            const char* a3 = last ? nA + KOFFA(1) : cA + KOFFA(t + 3); const char* b3 = b2 + kstep;
            PG8_LDB(B0, 0, 0); PG8_LDB(B1, 0, 1); PG8_SCHED; PG8_LDA(At, 0, 0); PG8_STAGE(PG8_SA(1, 1), a1 + hstepA, voffA);
            PG8_WAIT_V(8); PG8_WAIT_L(0); PG8_BAR; PG8_MMA(0, 0, At, B0); PG8_MMA(0, 1, At, B1); PG8_BAR; PG8_SCHED;
            PG8_LDA(At, 0, 1); PG8_STAGE(PG8_SB(0, 0), b2, voffB); PG8_STAGE(PG8_SB(0, 1), b2 + hstepB, voffB); PG8_STAGE(PG8_SA(0, 0), a2, voffA);
            PG8_WAIT_V(8); PG8_WAIT_L(0); PG8_BAR; PG8_MMA(1, 0, At, B0); PG8_MMA(1, 1, At, B1); PG8_BAR; PG8_SCHED;
            PG8_LDB(B0, 1, 0); PG8_LDB(B1, 1, 1); PG8_SCHED; PG8_LDA(At, 1, 0); PG8_STAGE(PG8_SA(0, 1), a2 + hstepA, voffA);
            PG8_WAIT_V(8); PG8_WAIT_L(0); PG8_BAR; PG8_MMA(0, 0, At, B0); PG8_MMA(0, 1, At, B1); PG8_BAR; PG8_SCHED;
            PG8_LDA(At, 1, 1); PG8_STAGE(PG8_SB(1, 0), b3, voffB); PG8_STAGE(PG8_SB(1, 1), b3 + hstepB, voffB); PG8_STAGE(PG8_SA(1, 0), a3, voffA);
            PG8_WAIT_V(8); PG8_WAIT_L(0); PG8_BAR; PG8_MMA(1, 0, At, B0); PG8_MMA(1, 1, At, B1); PG8_BAR; PG8_SCHED;
        }
        if constexpr (ALIGN_EPI) { if (wr == 0) PG8_BAR; }
        E(acc, cur, wr, wc, fr, fq);
        if (!has_next) break;
#pragma unroll
        for (int a = 0; a < 2; ++a)
#pragma unroll
            for (int b = 0; b < 2; ++b)
#pragma unroll
                for (int m = 0; m < 4; ++m)
#pragma unroll
                    for (int n = 0; n < 2; ++n) acc[a][b][m][n] = (f32x4){0.f, 0.f, 0.f, 0.f};
        cur = nxt; cA = nA; cB = nB; ++ui;
        if constexpr (Epi::SCALE) { fsc = E.factor(cur, tid); *(LAS float*)(lds + FAC_OFF + tid * 4) = fsc; }
        if constexpr (ALIGN_EPI) { if (wr == 1) PG8_BAR; }
    }
    PG8_WAIT_V(0);
    if constexpr (!ALIGN_EPI) { if (wr == 0) PG8_BAR; }
    PG8_BAR;
#undef KOFFA
#undef PG8_SA
#undef PG8_SB
#undef PG8_STAGE
#undef PG8_LDA
#undef PG8_LDB
#undef PG8_MMA
#undef PG8_WAIT_V
#undef PG8_WAIT_L
#undef PG8_BAR
#undef PG8_SCHED
}
}

typedef GAS unsigned gu32;
#define RLX_AGENT __ATOMIC_RELAXED, __HIP_MEMORY_SCOPE_AGENT
#define XB_TMO      128
#define XB_XCNT(j)  (256  + 64 * (j))
#define XB_XSUB(j)  (1280 + 64 * (j))
#define XB_XGEN(j)  (2304 + 64 * (j))
#define XB_TOP      3328
#define XB_TOPGEN   3392
#define XCD_BAR_WORDS 3456
#define XB_SPIN_CAP (1u << 18)
__device__ __forceinline__ unsigned xb_ld(unsigned* p)              { return __hip_atomic_load(p, __ATOMIC_RELAXED, __HIP_MEMORY_SCOPE_AGENT); }
__device__ __forceinline__ unsigned xb_add(unsigned* p, unsigned v) { return __hip_atomic_fetch_add(p, v, __ATOMIC_RELAXED, __HIP_MEMORY_SCOPE_AGENT); }
__device__ __forceinline__ unsigned xb_xcc_id() { return (unsigned)__builtin_amdgcn_s_getreg((3 << 11) | 20) & 0xFu; }
#define XB_SPIN(cond, bar) do { unsigned _sp = 0; while (cond) { __builtin_amdgcn_s_sleep(1); \
    if ((++_sp & 255u) == 0u) { if (xb_ld(&(bar)[XB_TMO])) break; if (_sp > XB_SPIN_CAP) { atomicAdd(&(bar)[XB_TMO], 1u); break; } } } } while (0)
struct XcdBarrier { unsigned* bar; unsigned x; volatile LAS unsigned* st; };
__device__ __forceinline__ XcdBarrier xcd_barrier_post(unsigned* bar, volatile LAS unsigned* st) {
    XcdBarrier b; b.bar = bar; b.x = xb_xcc_id(); b.st = st;
    if (threadIdx.x == 0) (void)xb_add(&bar[XB_XCNT(b.x)], 1u);
    return b;
}
__device__ __forceinline__ void xcd_barrier_complete(unsigned* bar, unsigned x, unsigned& nloc, unsigned& nx) {
    const unsigned G = gridDim.x * gridDim.y * gridDim.z;
    unsigned sum, cnt, mine, sp = 0u;
    for (;;) {
        sum = 0u; cnt = 0u; mine = 0u;
#pragma unroll
        for (unsigned j = 0; j < 16; ++j) { const unsigned c = xb_ld(&bar[XB_XCNT(j)]); sum += c; cnt += (c > 0u) ? 1u : 0u; mine = (j == x) ? c : mine; }
        if (sum == G) break;
        __builtin_amdgcn_s_sleep(1);
        if ((++sp & 255u) == 0u) { if (xb_ld(&bar[XB_TMO])) break; if (sp > XB_SPIN_CAP) { atomicAdd(&bar[XB_TMO], 1u); break; } }
    }
    nloc = mine > 0u ? mine : 1u; nx = cnt > 0u ? cnt : 1u;
}
__device__ __forceinline__ void xcd_barrier(const XcdBarrier& b) {
    asm volatile("s_waitcnt vmcnt(0)" ::: "memory");
    __syncthreads();
    if (threadIdx.x == 0) {
        unsigned* bar = b.bar;
        __builtin_amdgcn_s_waitcnt(0);
        unsigned nloc = b.st[0], nx = b.st[1];
        if (nloc == 0u) { xcd_barrier_complete(bar, b.x, nloc, nx); b.st[0] = nloc; b.st[1] = nx; }
        const unsigned old = xb_add(&bar[XB_XSUB(b.x)], 1u);
        const unsigned gen = old / nloc;
        if (old + 1u == (gen + 1u) * nloc) {
            __builtin_amdgcn_fence(__ATOMIC_RELEASE, "agent");
            asm volatile("s_waitcnt vmcnt(0)" ::: "memory");
            const unsigned og = xb_add(&bar[XB_TOP], 1u);
            const unsigned tg = og / nx;
            if (og + 1u == (tg + 1u) * nx) xb_add(&bar[XB_TOPGEN], 1u);
            else XB_SPIN(xb_ld(&bar[XB_TOPGEN]) == tg, bar);
            __builtin_amdgcn_fence(__ATOMIC_ACQUIRE, "agent");
            xb_add(&bar[XB_XGEN(b.x)], 1u);
            asm volatile("s_waitcnt vmcnt(0)" ::: "memory");
        } else {
            XB_SPIN(xb_ld(&bar[XB_XGEN(b.x)]) == gen, bar);
            __builtin_amdgcn_fence(__ATOMIC_ACQUIRE, "agent");
            asm volatile("s_waitcnt vmcnt(0)" ::: "memory");
        }
    }
    __syncthreads();
}

__device__ __forceinline__ void xcd_arrive(const XcdBarrier& b) {
    asm volatile("s_waitcnt vmcnt(0)" ::: "memory");
    __syncthreads();
    if (threadIdx.x == 0) {
        unsigned* bar = b.bar;
        __builtin_amdgcn_s_waitcnt(0);
        unsigned nloc = b.st[0], nx = b.st[1];
        if (nloc == 0u) { xcd_barrier_complete(bar, b.x, nloc, nx); b.st[0] = nloc; b.st[1] = nx; }
        const unsigned old = xb_add(&bar[XB_XSUB(b.x)], 1u);
        if ((old + 1u) % nloc == 0u) {
            __builtin_amdgcn_fence(__ATOMIC_RELEASE, "agent");
            asm volatile("s_waitcnt vmcnt(0)" ::: "memory");
            (void)xb_add(&bar[XB_TOP], 1u);
        }
    }
}
constexpr unsigned XB_NONE = 0xffffffffu;
__device__ __forceinline__ unsigned xcd_arrive_begin(const XcdBarrier& b) {
    asm volatile("s_waitcnt vmcnt(0)" ::: "memory");
    __syncthreads();
    unsigned old = XB_NONE;
    if (threadIdx.x == 0) {
        unsigned* bar = b.bar;
        unsigned nloc = b.st[0], nx = b.st[1];
        if (nloc == 0u) { xcd_barrier_complete(bar, b.x, nloc, nx); b.st[0] = nloc; b.st[1] = nx; }
        old = atomicInc(&bar[XB_XSUB(b.x)], 0xffffffffu);
    }
    return old;
}
__device__ __forceinline__ void xcd_arrive_end(const XcdBarrier& b, unsigned old) {
    asm volatile("" : "+v"(old) :: "memory");
    if (threadIdx.x == 0 && old != XB_NONE) {
        if ((old + 1u) % b.st[0] == 0u) {
            __builtin_amdgcn_fence(__ATOMIC_RELEASE, "agent");
            asm volatile("s_waitcnt vmcnt(0)" ::: "memory");
            (void)xb_add(&b.bar[XB_TOP], 1u);
        }
    }
}
__device__ __forceinline__ void xcd_wait(const XcdBarrier& b, unsigned k) {
    if (threadIdx.x == 0) {
        unsigned* bar = b.bar;
        const unsigned want = b.st[1] * k;
        XB_SPIN(xb_ld(&bar[XB_TOP]) < want, bar);
        __builtin_amdgcn_fence(__ATOMIC_ACQUIRE, "agent");
        asm volatile("s_waitcnt vmcnt(0)" ::: "memory");
    }
    __syncthreads();
}

struct Args {
    const float *x_prompt, *x_sample, *cache_k, *cache_v, *state_ssm, *state_conv, *norm_w, *w_in, *conv_w, *conv_b,
                *dt_bias, *a_log, *d_skip, *ssm_norm_w, *q_norm_w, *k_norm_w, *sinks, *rel_table, *w_out;
    float* out; unsigned char* ws; int ph_lo, ph_hi, sub, dry;
};
constexpr int NWAVES = 8, NT = 512;
constexpr int RING_BYTES = 131072, LDS_BYTES = 147456, MISC_OFF = LDS_BYTES - 512;

template <bool REMAP>
__device__ __forceinline__ void p0_transpose_item(const float* W, int K, int N, bf16_t* WT, LAS bf16_t* scr, int item, int lane, const float* ksc = nullptr) {
    const int nblk = (N + 63) / 64, kb = item / nblk, nb = item % nblk, k0 = 64 * kb, n0 = 64 * nb;
    const bool nok = (n0 + lane) < N;
    const float* wp = W + (size_t)k0 * N + n0 + (nok ? lane : 0);
    float v[64];
#pragma unroll
    for (int kk = 0; kk < 64; ++kk) v[kk] = __builtin_nontemporal_load(wp + (size_t)kk * N);
    if (ksc) {
#pragma unroll
        for (int kk = 0; kk < 64; ++kk) v[kk] *= ksc[k0 + kk]; }
#pragma unroll
    for (int kk = 0; kk < 64; kk += 2) *(LAS unsigned*)(scr + lane * 68 + kk) = pk2(v[kk], v[kk + 1]);
    LDS_WAIT(); asm volatile("" ::: "memory");
    const int c = lane & 7;
#pragma unroll
    for (int j = 0; j < 8; ++j) { const int n = (lane >> 3) + 8 * j;
        const u32x2 lo = *(const LAS u32x2*)(scr + n * 68 + 8 * c), hi = *(const LAS u32x2*)(scr + n * 68 + 8 * c + 4);
        u32x4 o; o.x = lo.x; o.y = lo.y; o.z = hi.x; o.w = hi.y;
        int ng = n0 + n;
        if (ng < N) { if (REMAP) ng = (ng < 2560) ? ng : (ng < 2576 ? ng + 2560 : ng - 16);
            st_wt16(WT + (size_t)ng * K + k0 + 8 * c, o); } }
    LDS_WAIT(); asm volatile("" ::: "memory");
}
__device__ __forceinline__ void p0_prologue(const Args& a, LAS unsigned char* lds, int vcu, int G, int wave, int lane, unsigned long long& amp_d) {
    unsigned long long amp_t = 0ull;
#define AMPB(k) do { if (MK_AMP == (k)) amp_t = __builtin_amdgcn_s_memrealtime(); } while (0)
#define AMPE(k) do { if (MK_AMP == (k)) { __syncthreads(); amp_d += __builtin_amdgcn_s_memrealtime() - amp_t; } } while (0)
    AMPB(100);
    LAS bf16_t* scr = (LAS bf16_t*)(lds + wave * 16384);
    bf16_t* WinT = (bf16_t*)(a.ws + WS_WIN); bf16_t* WoutT = (bf16_t*)(a.ws + WS_WOUT); bf16_t* H = (bf16_t*)(a.ws + WS_H);
    const int gw = vcu * NWAVES + wave, NGW = G * NWAVES;
    constexpr int I_IN = (DM / 64) * ((NIN + 63) / 64), I_OUT = (2048 / 64) * (DM / 64);
    for (int it = gw; it < I_IN + I_OUT; it += NGW) {
        if (it < I_IN) p0_transpose_item<true>(a.w_in, DM, NIN, WinT, scr, it, lane);
        else { const int io = it - I_IN; p0_transpose_item<false>(a.w_out, 2048, DM, WoutT, scr, io, lane, (io / (DM / 64)) < 16 ? a.ssm_norm_w : nullptr); }
    }
    AMPE(100); AMPB(101);
    for (int r = gw; r < NINP - NIN; r += NGW) { u32x4* p = (u32x4*)(WinT + (size_t)(NIN + r) * DM); p[lane] = (u32x4){0u, 0u, 0u, 0u}; p[lane + 64] = (u32x4){0u, 0u, 0u, 0u}; }
    f32x4 nw[4];
#pragma unroll
    for (int j = 0; j < 4; ++j) nw[j] = ((const f32x4*)a.norm_w)[lane + 64 * j];
    f32x4 vn[4][4];
#define P0_LOAD(dst, mb) do { _Pragma("unroll") for (int r = 0; r < 4; ++r) { const int m = (mb) + r * NGW; \
        if (m < MT) { const float* xrow = (m < MP) ? a.x_prompt + (size_t)m * DM : a.x_sample + (size_t)(m - MP) * DM; const f32x4* xr = (const f32x4*)xrow + lane; \
            _Pragma("unroll") for (int j = 0; j < 4; ++j) dst[r][j] = __builtin_nontemporal_load(xr + 64 * j); } } } while (0)
    P0_LOAD(vn, gw);
    for (int m0 = gw; m0 < MT; m0 += 4 * NGW) {
        f32x4 v[4][4];
#pragma unroll
        for (int r = 0; r < 4; ++r)
#pragma unroll
            for (int j = 0; j < 4; ++j) v[r][j] = vn[r][j];
        if (m0 + 4 * NGW < MT) P0_LOAD(vn, m0 + 4 * NGW);
#pragma unroll
        for (int r = 0; r < 4; ++r) { const int m = m0 + r * NGW;
            if (m < MT) { float s = 0.f;
#pragma unroll
                for (int j = 0; j < 4; ++j) s += (v[r][j].x * v[r][j].x + v[r][j].y * v[r][j].y) + (v[r][j].z * v[r][j].z + v[r][j].w * v[r][j].w);
                const float rstd = __builtin_amdgcn_rsqf(wave_sum(s) * (1.f / DM) + EPS);
                unsigned long long* o8 = (unsigned long long*)(H + (size_t)m * DM) + lane;
#pragma unroll
                for (int j = 0; j < 4; ++j) { const f32x4 h = v[r][j] * rstd * nw[j]; u32x2 hw; hw.x = pk2(h.x, h.y); hw.y = pk2(h.z, h.w); st_wt8(o8 + 64 * j, hw); } } }
    }
#undef P0_LOAD
    AMPE(101);
#undef AMPB
#undef AMPE
}

__device__ __forceinline__ float ssd_dt_scan(const float* DT, int R0, int h, int e, int lane, const float* dt_bias, const float* a_log, LAS float* dtv, LAS float* acum, float& d0o, float& d1o, float& c0o, float& c1o) {
    const float bias = dt_bias[h]; const float A = -expf(a_log[h]);
    const int l0 = 2 * lane;
    const float d0 = softplus_f(DT[(size_t)(R0 + l0) * 16 + h] + bias), d1 = softplus_f(DT[(size_t)(R0 + l0 + 1) * 16 + h] + bias);
    const float a0 = d0 * A, a1 = d1 * A; float s = a0 + a1;
#pragma unroll
    for (int o = 1; o < 64; o <<= 1) { const float t = __shfl_up(s, o); if (lane >= o) s += t; }
    const float excl = s - (a0 + a1);
    const float c0 = excl + a0, c1 = excl + a0 + a1;
    dtv[e * 128 + l0] = d0; dtv[e * 128 + l0 + 1] = d1; acum[e * 128 + l0] = c0; acum[e * 128 + l0 + 1] = c1;
    d0o = d0; d1o = d1; c0o = c0; c1o = c1;
    return __shfl(s, 63);
}

typedef short v4i16_t __attribute__((ext_vector_type(4)));
__device__ __forceinline__ u32x2 lds_tr16(const LAS bf16_t* p) { return __builtin_bit_cast(u32x2, __builtin_amdgcn_ds_read_tr16_b64_v4i16((LAS v4i16_t*)p)); }
struct ConvRaw { u32x4 r[5]; };
__device__ __forceinline__ void conv_load(const bf16_t* U, const bf16_t* HALO, int R0, int gc, int c, int chb, int tid, ConvRaw& o) {
    const int q = tid & 7, r = tid >> 3;
#pragma unroll
    for (int i = 0; i < 5; ++i) {
        const int rr = 2 * r - 3 + i;
        u32x4 v = (u32x4){0u, 0u, 0u, 0u};
        if (rr >= 0) v = *(const u32x4*)(U + uoff(R0 + rr, C_X + chb + 8 * q));
        else if (c > 0) v = *(const u32x4*)(HALO + (size_t)((gc - 1) * 3 + 3 + rr) * CONVD + chb + 8 * q);
        o.r[i] = v;
    }
}
template <int CS = 768>
__device__ __forceinline__ void conv_apply(const ConvRaw& in, const LAS float* cw, int lc, float (&o0)[8], float (&o1)[8]) {
    float x[5][8];
#pragma unroll
    for (int i = 0; i < 5; ++i) { const u32x4 v = in.r[i]; x[i][0] = bflo(v.x); x[i][1] = bfhi(v.x); x[i][2] = bflo(v.y); x[i][3] = bfhi(v.y); x[i][4] = bflo(v.z); x[i][5] = bfhi(v.z); x[i][6] = bflo(v.w); x[i][7] = bfhi(v.w); }
    float w[5][8];
#pragma unroll
    for (int t = 0; t < 5; ++t) { const f32x4 a0 = *(const LAS f32x4*)(cw + t * CS + lc), a1 = *(const LAS f32x4*)(cw + t * CS + lc + 4);
        w[t][0] = a0.x; w[t][1] = a0.y; w[t][2] = a0.z; w[t][3] = a0.w; w[t][4] = a1.x; w[t][5] = a1.y; w[t][6] = a1.z; w[t][7] = a1.w; }
#pragma unroll
    for (int i = 0; i < 8; ++i) {
        o0[i] = silu_f(w[4][i] + w[0][i] * x[0][i] + w[1][i] * x[1][i] + w[2][i] * x[2][i] + w[3][i] * x[3][i]);
        o1[i] = silu_f(w[4][i] + w[0][i] * x[1][i] + w[1][i] * x[2][i] + w[2][i] * x[3][i] + w[3][i] * x[4][i]);
    }
}
__device__ __forceinline__ u32x4 pack8(const float (&v)[8]) { u32x4 w; w.x = pk2(v[0], v[1]); w.y = pk2(v[2], v[3]); w.z = pk2(v[4], v[5]); w.w = pk2(v[6], v[7]); return w; }

__device__ __forceinline__ void ssd_state_item(const Args& a, LAS unsigned char* lds, int item, int tid, int wave, int lane, const bool dry = false) {
    asm volatile("" : "+v"(tid), "+v"(lane));
    const int b = item >> 7, c = (item >> 1) & 63, g = item & 1, gc = b * 64 + c;
    const int R0 = b * SEQ + c * 128;
    bf16_t* U = (bf16_t*)(a.ws + WS_U); const float* DT = (const float*)(a.ws + WS_DT); const bf16_t* HALO = (const bf16_t*)(a.ws + WS_HALO);
    bf16_t* ST = (bf16_t*)(a.ws + WS_ST); float* DEC = (float*)(a.ws + WS_DEC);
    LAS bf16_t* Bn = (LAS bf16_t*)lds;
    LAS bf16_t* Xw0 = (LAS bf16_t*)(lds + 34816);
    LAS float* dtv = (LAS float*)(lds + 71680); LAS float* acum = dtv + 1024; LAS float* wv = acum + 1024;
    LAS float* cw = (LAS float*)(lds + 83968);
    auto blk_chb = [&](int k) -> int { return (k < 2) ? (1024 + 128 * g + 64 * k) : (k < 4) ? (1280 + 128 * g + 64 * (k - 2)) : (512 * g + 64 * (k - 4)); };
    auto blk_lc = [&](int k) -> int { return (k < 2) ? (512 + 64 * k) : (k < 4) ? (640 + 64 * (k - 2)) : (64 * (k - 4)); };
    ConvRaw raw; conv_load(U, HALO, R0, gc, c, blk_chb(0), tid, raw);
    {   float cwv[8];
#pragma unroll
        for (int j = 0; j < 8; ++j) { const int i = tid + NT * j; const int t = i / 768, lc = i % 768; const int ch = (lc < 512) ? (512 * g + lc) : (lc < 640) ? (1024 + 128 * g + (lc - 512)) : (1280 + 128 * g + (lc - 640));
            cwv[j] = (i < 5 * 768) ? ((t < 4) ? a.conv_w[t * CONVD + ch] : a.conv_b[ch]) : 0.f; }
#pragma unroll
        for (int j = 0; j < 8; ++j) { const int i = tid + NT * j; if (i < 5 * 768) cw[i] = cwv[j]; } }
    {
        float d0, d1, c0, c1; const int h = 8 * g + wave;
        const float aend = ssd_dt_scan(DT, R0, h, wave, lane, a.dt_bias, a.a_log, dtv, acum, d0, d1, c0, c1);
        wv[wave * 128 + 2 * lane] = d0 * __expf(aend - c0); wv[wave * 128 + 2 * lane + 1] = d1 * __expf(aend - c1);
        if (lane == 0 && !dry) DEC[gc * 16 + h] = __expf(aend);
    }
    __syncthreads();
    if (!dry) ((f32x4*)(a.ws + WS_DTA))[(size_t)item * 512 + tid] = ((const LAS f32x4*)dtv)[tid];
    const int fr = lane & 15, grp = lane >> 4, q = tid & 7, r = tid >> 3;
#pragma unroll 1
    for (int k = 0; k < 12; k = (k == 1) ? 4 : k + 1) {
        ConvRaw cur = raw;
        { const int kn = (k == 1) ? 4 : k + 1; if (kn < 12) conv_load(U, HALO, R0, gc, c, blk_chb(kn), tid, raw); }
        float o0[8], o1[8];
        if (dry && MK_ABL == 22) {
#pragma unroll
            for (int i = 0; i < 8; ++i) { o0[i] = bflo(cur.r[0].x) + i; o1[i] = bfhi(cur.r[4].w) + i; } }
        else conv_apply(cur, cw, blk_lc(k) + 8 * q, o0, o1);
        const u32x4 p0 = pack8(o0), p1 = pack8(o1);
        __syncthreads();
        bf16_t* up = U + uoff(R0 + 2 * r, C_X + blk_chb(k) + 8 * q);
        if (!dry || p0.x == 0x12345678u) { *(u32x4*)up = p0; *(u32x4*)(up + 64) = p1; }
        if (k < 2) { *(LAS u32x4*)(Bn + (2 * r) * 136 + 64 * k + 8 * q) = p0; *(LAS u32x4*)(Bn + (2 * r + 1) * 136 + 64 * k + 8 * q) = p1; }
        if (k >= 4) {
            const int e = k - 4, h = 8 * g + e;
            LAS bf16_t* Xw = Xw0 + (e & 1) * (128 * 72);
            const float w0 = wv[e * 128 + 2 * r], w1 = wv[e * 128 + 2 * r + 1];
#pragma unroll
            for (int i = 0; i < 8; ++i) { o0[i] *= w0; o1[i] *= w1; }
            *(LAS u32x4*)(Xw + (2 * r) * 72 + 8 * q) = pack8(o0); *(LAS u32x4*)(Xw + (2 * r + 1) * 72 + 8 * q) = pack8(o1);
            __syncthreads();
            if (dry && MK_ABL == 21) continue;
            f32x4 acc[4];
#pragma unroll
            for (int pt = 0; pt < 4; ++pt) acc[pt] = (f32x4){0.f, 0.f, 0.f, 0.f};
#pragma unroll
            for (int ks = 0; ks < 4; ++ks) {
                const int l0 = 32 * ks + 8 * grp + (fr >> 2);
                const u32x2 a0 = lds_tr16(Bn + l0 * 136 + 16 * wave + 4 * (fr & 3)), a1 = lds_tr16(Bn + (l0 + 4) * 136 + 16 * wave + 4 * (fr & 3));
                u32x2 b0[4], b1[4];
#pragma unroll
                for (int pt = 0; pt < 4; ++pt) { b0[pt] = lds_tr16(Xw + l0 * 72 + 16 * pt + 4 * (fr & 3)); b1[pt] = lds_tr16(Xw + (l0 + 4) * 72 + 16 * pt + 4 * (fr & 3)); }
                __builtin_amdgcn_sched_barrier(0);
                u32x4 aw; aw.x = a0.x; aw.y = a0.y; aw.z = a1.x; aw.w = a1.y;
#pragma unroll
                for (int pt = 0; pt < 4; ++pt) {
                    u32x4 bw; bw.x = b0[pt].x; bw.y = b0[pt].y; bw.z = b1[pt].x; bw.w = b1[pt].y;
                    acc[pt] = mfma16(__builtin_bit_cast(bf16x8, aw), __builtin_bit_cast(bf16x8, bw), acc[pt]);
                }
            }
            bf16_t* stp = ST + ((size_t)(gc * 16 + h) * 64) * 128 + 16 * wave + 4 * grp;
#pragma unroll
            for (int pt = 0; pt < 4; ++pt) { u32x2 o; o.x = pk2(acc[pt][0], acc[pt][1]); o.y = pk2(acc[pt][2], acc[pt][3]); if (!dry || o.x == 0x12345678u) *(u32x2*)(stp + (size_t)(16 * pt + fr) * 128) = o; }
        }
    }
    __syncthreads();
}

__device__ __forceinline__ void ssd_scan(const Args& a, LAS unsigned char* lds, int bx, int G, int tid, int wave, int lane, const bool dry) {
    u32x4* ST = (u32x4*)(a.ws + WS_ST); const float* DEC = (const float*)(a.ws + WS_DEC);
    LAS float* agg = (LAS float*)lds;
    const int seg = wave >> 1, gl = (wave & 1) * 64 + lane;
    for (int blk = bx; blk < NB * 16 * 8; blk += G) {
        const int bh = blk >> 3, b = bh >> 4, h = bh & 15, g8 = (blk & 7) * 128 + gl;
        u32x4* p = ST + ((size_t)(b * 64 + 16 * seg) * 16 + h) * 1024 + g8;
        const float* dp = DEC + (b * 64) * 16 + h;
        u32x4 v[16]; float d[16];
#pragma unroll
        for (int c = 0; c < 16; ++c) v[c] = p[(size_t)c * 16 * 1024];
        float pr[4];
#pragma unroll
        for (int s4 = 0; s4 < 4; ++s4) { float q = 1.f;
#pragma unroll
            for (int c = 0; c < 16; ++c) { const float dd = dp[(16 * s4 + c) * 16]; q *= dd; if (s4 == seg) d[c] = dd; }
            pr[s4] = q; }
        float cr[8];
#pragma unroll
        for (int i = 0; i < 8; ++i) cr[i] = 0.f;
#pragma unroll
        for (int c = 0; c < 16; ++c) { const u32x4 w = v[c]; const float f[8] = {bflo(w.x), bfhi(w.x), bflo(w.y), bfhi(w.y), bflo(w.z), bfhi(w.z), bflo(w.w), bfhi(w.w)};
#pragma unroll
            for (int i = 0; i < 8; ++i) cr[i] = cr[i] * d[c] + f[i]; }
        __syncthreads();
        *(LAS f32x4*)(agg + (seg * 128 + gl) * 8) = (f32x4){cr[0], cr[1], cr[2], cr[3]}; *(LAS f32x4*)(agg + (seg * 128 + gl) * 8 + 4) = (f32x4){cr[4], cr[5], cr[6], cr[7]};
        __syncthreads();
        float cin[8];
#pragma unroll
        for (int i = 0; i < 8; ++i) cin[i] = 0.f;
#pragma unroll
        for (int s4 = 0; s4 < 3; ++s4) if (s4 < seg) { const f32x4 a0 = *(const LAS f32x4*)(agg + (s4 * 128 + gl) * 8), a1 = *(const LAS f32x4*)(agg + (s4 * 128 + gl) * 8 + 4);
            const float av[8] = {a0.x, a0.y, a0.z, a0.w, a1.x, a1.y, a1.z, a1.w};
#pragma unroll
            for (int i = 0; i < 8; ++i) cin[i] = cin[i] * pr[s4] + av[i]; }
#pragma unroll
        for (int c = 0; c < 16; ++c) { const u32x4 w = v[c]; const float f[8] = {bflo(w.x), bfhi(w.x), bflo(w.y), bfhi(w.y), bflo(w.z), bfhi(w.z), bflo(w.w), bfhi(w.w)};
            u32x4 o; o.x = pk2(cin[0], cin[1]); o.y = pk2(cin[2], cin[3]); o.z = pk2(cin[4], cin[5]); o.w = pk2(cin[6], cin[7]);
            if (!dry) p[(size_t)c * 16 * 1024] = o;
#pragma unroll
            for (int i = 0; i < 8; ++i) cin[i] = cin[i] * d[c] + f[i]; }
        if (seg == 3 && (!dry || cin[0] == 12345.678f)) { float* o = a.out + O_SP + (size_t)bh * 8192 + 8 * g8;
            *(f32x4*)o = (f32x4){cin[0], cin[1], cin[2], cin[3]}; *(f32x4*)(o + 4) = (f32x4){cin[4], cin[5], cin[6], cin[7]}; }
    }
}

struct HeadRegs { u32x4 x[2], s[2]; u32x2 z[4]; };
__device__ __forceinline__ void ssd_out_load(const bf16_t* U, const bf16_t* ST, int R0, int gc, int h, int tid, int l, int grp, HeadRegs& o) {
#pragma unroll
    for (int i = 0; i < 2; ++i) { const int ci = tid + NT * i;
        o.x[i] = *(const u32x4*)(U + uoff(R0 + (ci >> 3), C_X + 64 * h + 8 * (ci & 7)));
        o.s[i] = *(const u32x4*)(ST + ((size_t)(gc * 16 + h) * 64 + (ci >> 4)) * 128 + 8 * (ci & 15)); }
    const bf16_t* zrow = U + uoff(R0 + l, C_Z + 64 * h + 4 * grp);
#pragma unroll
    for (int pt = 0; pt < 4; ++pt) o.z[pt] = *(const u32x2*)(zrow + 16 * pt);
}
__device__ __forceinline__ void ssd_out_stage(const HeadRegs& in, LAS bf16_t* X, LAS bf16_t* St, int tid) {
#pragma unroll
    for (int i = 0; i < 2; ++i) { const int ci = tid + NT * i;
        *(LAS u32x4*)(X + (ci >> 3) * 72 + 8 * (ci & 7)) = in.x[i];
        *(LAS u32x4*)(St + (ci >> 4) * 136 + 8 * (ci & 15)) = in.s[i]; }
}
__device__ __forceinline__ void ssd_out_item(const Args& a, LAS unsigned char* lds, int item, int tid, int wave, int lane, const bool dry) {
    const int b = item >> 7, c = (item >> 1) & 63, g = item & 1, gc = b * 64 + c;
    const int R0 = b * SEQ + c * 128;
    bf16_t* U = (bf16_t*)(a.ws + WS_U); const float* DT = (const float*)(a.ws + WS_DT); const bf16_t* ST = (const bf16_t*)(a.ws + WS_ST);
    LAS bf16_t* Cn = (LAS bf16_t*)lds;
    LAS bf16_t* setA = (LAS bf16_t*)(lds + 34816);
    LAS bf16_t* setB = (LAS bf16_t*)(lds + 70656);
    LAS bf16_t* Bn = setB;
    LAS float* dtv = (LAS float*)(lds + 106496); LAS float* acum = dtv + 1024;
    const int fr = lane & 15, grp = lane >> 4;
    const int l = 16 * wave + fr;
    HeadRegs hr;
    {
        u32x4 bv[4];
        LAS float* cwC = (LAS float*)(lds + 131072);
        float cwv[5] = {0.f, 0.f, 0.f, 0.f, 0.f};
        if (tid < 128) { const float* wp = a.conv_w + 1280 + 128 * g + tid;
#pragma unroll
            for (int t = 0; t < 4; ++t) cwv[t] = wp[t * CONVD];
            cwv[4] = a.conv_b[1280 + 128 * g + tid]; }
        ConvRaw c0, c1;
        conv_load(U, (const bf16_t*)(a.ws + WS_HALO), R0, gc, c, 1280 + 128 * g, tid, c0); conv_load(U, (const bf16_t*)(a.ws + WS_HALO), R0, gc, c, 1280 + 128 * g + 64, tid, c1);
#pragma unroll
        for (int i = 0; i < 4; ++i) { const int ci = tid + NT * i; bv[i] = *(const u32x4*)(U + uoff(R0 + (ci >> 4), C_B + 128 * g + 8 * (ci & 15))); }
        const f32x4 dta = ((const f32x4*)(a.ws + WS_DTA))[(size_t)item * 512 + tid];
        if (tid < 128) {
#pragma unroll
            for (int t = 0; t < 5; ++t) cwC[t * 128 + tid] = cwv[t]; }
#pragma unroll
        for (int i = 0; i < 4; ++i) { const int ci = tid + NT * i; *(LAS u32x4*)(Bn + (ci >> 4) * 136 + 8 * (ci & 15)) = bv[i]; }
        ((LAS f32x4*)dtv)[tid] = dta;
        __syncthreads();
        ssd_out_load(U, ST, R0, gc, 8 * g, tid, l, grp, hr);
        {   const int q = tid & 7, r = tid >> 3; float o0[8], o1[8];
            conv_apply<128>(c0, cwC, 8 * q, o0, o1);
            *(LAS u32x4*)(Cn + (2 * r) * 136 + 8 * q) = pack8(o0); *(LAS u32x4*)(Cn + (2 * r + 1) * 136 + 8 * q) = pack8(o1);
            conv_apply<128>(c1, cwC, 64 + 8 * q, o0, o1);
            *(LAS u32x4*)(Cn + (2 * r) * 136 + 64 + 8 * q) = pack8(o0); *(LAS u32x4*)(Cn + (2 * r + 1) * 136 + 64 + 8 * q) = pack8(o1); }
    }
    ssd_out_stage(hr, setA, setA + 128 * 72, tid);
    u32x2 zc[4];
#pragma unroll
    for (int pt = 0; pt < 4; ++pt) zc[pt] = hr.z[pt];
    __syncthreads();
    f32x4 cb[8];
#pragma unroll
    for (int st = 0; st < 8; ++st) cb[st] = (f32x4){0.f, 0.f, 0.f, 0.f};
#pragma unroll
    for (int ks = 0; ks < 4; ++ks) {
        const bf16x8 cf = *(const LAS bf16x8*)(Cn + (16 * wave + fr) * 136 + 32 * ks + 8 * grp);
#pragma unroll
        for (int st = 0; st < 8; ++st) if (st <= wave) { const bf16x8 bfm = *(const LAS bf16x8*)(Bn + (16 * st + fr) * 136 + 32 * ks + 8 * grp); cb[st] = mfma16(bfm, cf, cb[st]); }
    }
    __syncthreads();
    float ssq = 0.f;
    LAS bf16_t* stg = (LAS bf16_t*)(lds + 114688) + wave * (16 * 64);
    const int ybr = R0 + 16 * wave, ybc = C_Z + 512 * g;
    const int e_n = (dry && MK_ABL == 13) ? 0 : 8;
#pragma unroll 1
    for (int e = 0; e < e_n; ++e) {
        const int h = 8 * g + e;
        LAS bf16_t* X = (e & 1) ? setB : setA; LAS bf16_t* St = X + 128 * 72;
        if (e < 7) ssd_out_load(U, ST, R0, gc, h + 1, tid, l, grp, hr);
        f32x4 accd[4], acco[4];
#pragma unroll
        for (int pt = 0; pt < 4; ++pt) { accd[pt] = (f32x4){0.f, 0.f, 0.f, 0.f}; acco[pt] = (f32x4){0.f, 0.f, 0.f, 0.f}; }
        const float al = acum[e * 128 + l];
#pragma unroll
        for (int ks = 0; ks < 4; ++ks) {
            if (dry && MK_ABL == 11) break;
            const int sA = 32 * ks + 4 * grp, sB = sA + 16;
            const bool diag = (2 * ks <= wave);
            const bf16x8 cf = *(const LAS bf16x8*)(Cn + (16 * wave + fr) * 136 + 32 * ks + 8 * grp);
            bf16x8 sf[4];
#pragma unroll
            for (int pt = 0; pt < 4; ++pt) sf[pt] = *(const LAS bf16x8*)(St + (16 * pt + fr) * 136 + 32 * ks + 8 * grp);
            f32x4 acA = (f32x4){0.f, 0.f, 0.f, 0.f}, acB = acA, dtA = acA, dtB = acA; u32x2 xlo[4], xhi[4];
            if (diag) {
                acA = *(const LAS f32x4*)(acum + e * 128 + sA); acB = *(const LAS f32x4*)(acum + e * 128 + sB);
                dtA = *(const LAS f32x4*)(dtv + e * 128 + sA); dtB = *(const LAS f32x4*)(dtv + e * 128 + sB);
#pragma unroll
                for (int pt = 0; pt < 4; ++pt) { xlo[pt] = lds_tr16(X + (sA + (fr >> 2)) * 72 + 16 * pt + 4 * (fr & 3)); xhi[pt] = lds_tr16(X + (sB + (fr >> 2)) * 72 + 16 * pt + 4 * (fr & 3)); }
            }
            __builtin_amdgcn_sched_barrier(0);
            if (diag) {
                float m[8];
#pragma unroll
                for (int j = 0; j < 4; ++j) {
                    const float va = cb[2 * ks][j] * dtA[j] * __expf(al - acA[j]); m[j] = (sA + j <= l) ? va : 0.f;
                    const float vb = cb[2 * ks + 1][j] * dtB[j] * __expf(al - acB[j]); m[4 + j] = (sB + j <= l) ? vb : 0.f;
                }
                u32x4 mw; mw.x = pk2(m[0], m[1]); mw.y = pk2(m[2], m[3]); mw.z = pk2(m[4], m[5]); mw.w = pk2(m[6], m[7]);
                const bf16x8 mf = __builtin_bit_cast(bf16x8, mw);
#pragma unroll
                for (int pt = 0; pt < 4; ++pt) {
                    u32x4 aw; aw.x = xlo[pt].x; aw.y = xlo[pt].y; aw.z = xhi[pt].x; aw.w = xhi[pt].y;
                    accd[pt] = mfma16(__builtin_bit_cast(bf16x8, aw), mf, accd[pt]);
                }
            }
#pragma unroll
            for (int pt = 0; pt < 4; ++pt) acco[pt] = mfma16(sf[pt], cf, acco[pt]);
        }
        const float eal = __expf(al), dsk = a.d_skip[h];
#pragma unroll
        for (int pt = 0; pt < 4; ++pt) {
            if (dry && MK_ABL == 12) break;
            const u32x2 zz = zc[pt];
            const u32x2 xx = *(const LAS u32x2*)(X + l * 72 + 16 * pt + 4 * grp);
            const float z[4] = {bflo(zz.x), bfhi(zz.x), bflo(zz.y), bfhi(zz.y)};
            const float xv[4] = {bflo(xx.x), bfhi(xx.x), bflo(xx.y), bfhi(xx.y)};
            float gy[4];
#pragma unroll
            for (int r = 0; r < 4; ++r) {
                const float y = accd[pt][r] + eal * acco[pt][r] + dsk * xv[r];
                gy[r] = y * silu_f(z[r]); ssq += gy[r] * gy[r];
            }
            u32x2 o; o.x = pk2(gy[0], gy[1]); o.y = pk2(gy[2], gy[3]);
            *(LAS u32x2*)(stg + fr * 64 + 8 * ((2 * pt + (grp >> 1)) ^ (fr & 7)) + 4 * (grp & 1)) = o;
        }
        LDS_WAIT(); asm volatile("" ::: "memory");
#pragma unroll
        for (int i = 0; i < 2; ++i) { const int row = 8 * i + (lane >> 3), ch = lane & 7;
            const u32x4 v = *(const LAS u32x4*)(stg + row * 64 + 8 * (ch ^ (row & 7)));
            if (!dry) *(u32x4*)(U + uoff(ybr + row, ybc + 64 * e + 8 * ch)) = v; }
        if (e < 7) {
            ssd_out_stage(hr, (e & 1) ? setA : setB, ((e & 1) ? setA : setB) + 128 * 72, tid);
#pragma unroll
            for (int pt = 0; pt < 4; ++pt) zc[pt] = hr.z[pt]; }
        __syncthreads();
    }
    ssq += __shfl_xor(ssq, 16); ssq += __shfl_xor(ssq, 32);
    const float rstd = __builtin_amdgcn_rsqf(ssq * (1.f / 512.f) + EPS);
    if (grp == 0 && !dry) ((float*)(a.ws + WS_RS))[(size_t)g * MP + R0 + l] = rstd;
    __syncthreads();
}

__device__ __forceinline__ int rel_bucket(int d) {
    if (d < 16) return d;
    const int lg = 16 + (int)(logf((float)d * (1.0f / 16.0f)) * (16.0f / 2.0794415416798357f));
    return lg < 31 ? lg : 31;
}
struct AttnKV { u32x4 k[4], v[4]; };
__device__ __forceinline__ void attn_load_kv(const bf16_t* U, int unit, int tid, AttnKV& r) {
    const int b = unit >> 8, blk = (unit >> 2) & 63, kvh = unit & 3; const int R0 = b * SEQ + blk * 128;
    const int j = tid >> 1, hf = tid & 1;
    const bool z = (blk == 0 && j < 128);
    const int urow = R0 - 128 + (z ? 128 : j);
    const u32x4* kp = (const u32x4*)(U + uoff(urow, C_K + 64 * kvh + 32 * hf)); const u32x4* vp = (const u32x4*)(U + uoff(urow, C_V + 64 * kvh + 32 * hf));
#pragma unroll
    for (int i = 0; i < 4; ++i) { r.k[i] = kp[i]; r.v[i] = vp[i]; }
}
__device__ __forceinline__ void attn_tables(const Args& a, LAS unsigned char* lds, int tid, float m2, float rt) {
    LAS float* bias2 = (LAS float*)(lds + 131072); LAS float* qnw = (LAS float*)(lds + 143360); LAS float* rts = (LAS float*)(lds + 143616);
    rts[tid] = rt;
    __syncthreads();
    for (int i = tid; i < 16 * 192; i += NT) { const int hh = i / 192, t = i % 192, d = 128 - (t - 32); bias2[i] = (d >= 0 && d <= 128) ? rts[rel_bucket(d) * 16 + hh] * LOG2E - m2 : -1e30f; }
    if (tid < 64) qnw[tid] = a.q_norm_w[tid] * (0.125f * LOG2E);
}
typedef float f32x16 __attribute__((ext_vector_type(16)));
__device__ __forceinline__ f32x16 mfma32(bf16x8 a, bf16x8 b, f32x16 c) { return __builtin_amdgcn_mfma_f32_32x32x16_bf16(a, b, c, 0, 0, 0); }
__device__ __forceinline__ void attn_phase(const Args& a, LAS unsigned char* lds, int unit0, int unit_end, int G, int tid, int wave, int lane, float m2, const bool dry, unsigned long long& amp_d, const bool init, const XcdBarrier& xb, unsigned xold) {
    unsigned long long amp_t = 0ull;
#define AMPB(k) do { if (MK_AMP == (k)) amp_t = __builtin_amdgcn_s_memrealtime(); } while (0)
#define AMPE(k) do { if (MK_AMP == (k)) amp_d += __builtin_amdgcn_s_memrealtime() - amp_t; } while (0)
    AMPB(210);
    bf16_t* U = (bf16_t*)(a.ws + WS_U);
    LAS bf16_t* Kn = (LAS bf16_t*)lds;
    LAS bf16_t* Vn = (LAS bf16_t*)(lds + 41472);
    LAS float* bias2 = (LAS float*)(lds + 131072);
    LAS float* qnw = (LAS float*)(lds + 143360);
    asm volatile("" : "+v"(tid), "+v"(lane));
    int unit = unit0; if (unit >= unit_end) { xcd_arrive_end(xb, xold); return; }
    AttnKV kv; attn_load_kv(U, unit, tid, kv);
    xcd_arrive_end(xb, xold);
    __syncthreads();
    (void)init;
    const int r32 = lane & 31, hh = lane >> 5;
    while (unit < unit_end) {
        const int b = unit >> 8, blk = (unit >> 2) & 63, kvh = unit & 3;
        const int R0 = b * SEQ + blk * 128;
        const int gq = wave >> 1, hq = 4 * kvh + gq;
        u32x4 qraw[2][4];
#pragma unroll
        for (int qt = 0; qt < 2; ++qt) {
            const bf16_t* qrow = U + uoff(R0 + 64 * (wave & 1) + 32 * qt + r32, C_Q + 64 * hq + 8 * hh);
#pragma unroll
            for (int ks = 0; ks < 4; ++ks) qraw[qt][ks] = *(const u32x4*)(qrow + 16 * ks);
        }
        {
            const int j = tid >> 1, hf = tid & 1;
            const bool zero = (blk == 0 && j < 128);
            f32x4 kf[8];
#pragma unroll
            for (int i = 0; i < 4; ++i) { const u32x4 w = kv.k[i]; kf[2 * i] = (f32x4){bflo(w.x), bfhi(w.x), bflo(w.y), bfhi(w.y)}; kf[2 * i + 1] = (f32x4){bflo(w.z), bfhi(w.z), bflo(w.w), bfhi(w.w)}; }
            float ss = 0.f;
#pragma unroll
            for (int i = 0; i < 8; ++i) ss += (kf[i].x * kf[i].x + kf[i].y * kf[i].y) + (kf[i].z * kf[i].z + kf[i].w * kf[i].w);
            ss += __shfl_xor(ss, 1);
            const float rstd = zero ? 0.f : __builtin_amdgcn_rsqf(ss * (1.f / 64.f) + EPS);
#pragma unroll
            for (int i = 0; i < 8; ++i) { const f32x4 w = *(const f32x4*)(a.k_norm_w + 32 * hf + 4 * i); kf[i] = kf[i] * rstd * w; }
#pragma unroll
            for (int i = 0; i < 4; ++i) { u32x4 w; w.x = pk2(kf[2 * i].x, kf[2 * i].y); w.y = pk2(kf[2 * i].z, kf[2 * i].w); w.z = pk2(kf[2 * i + 1].x, kf[2 * i + 1].y); w.w = pk2(kf[2 * i + 1].z, kf[2 * i + 1].w);
                *(LAS u32x4*)(Kn + j * 72 + 32 * hf + 8 * i) = w;
                u32x4 vw = kv.v[i]; if (zero) vw = (u32x4){0u, 0u, 0u, 0u};
                *(LAS u32x4*)(Vn + j * 72 + 32 * hf + 8 * i) = vw; }
            if (blk == 63 && j >= 128 && !dry) {
                float* ok = a.out + O_KP + ((size_t)(b * 128 + (j - 128)) * 4 + kvh) * 64 + 32 * hf; float* ov = a.out + O_VP + ((size_t)(b * 128 + (j - 128)) * 4 + kvh) * 64 + 32 * hf;
#pragma unroll
                for (int i = 0; i < 8; ++i) *(f32x4*)(ok + 4 * i) = kf[i];
#pragma unroll
                for (int i = 0; i < 4; ++i) { const u32x4 w = kv.v[i]; *(f32x4*)(ov + 8 * i) = (f32x4){bflo(w.x), bfhi(w.x), bflo(w.y), bfhi(w.y)}; *(f32x4*)(ov + 8 * i + 4) = (f32x4){bflo(w.z), bfhi(w.z), bflo(w.w), bfhi(w.w)}; }
            }
        }
        const int nxt = unit + G;
        if (nxt < unit_end) attn_load_kv(U, nxt, tid, kv);
        __syncthreads();
        AMPE(210); AMPB(211);
        const float sink2 = a.sinks[hq] * LOG2E;
#pragma unroll
        for (int qt = 0; qt < 2; ++qt) {
            if (dry && MK_ABL == 2) break;
            const int i0 = 64 * (wave & 1) + 32 * qt, iq = i0 + r32;
            bf16_t* qrow = U + uoff(R0 + iq, C_Q + 64 * hq);
            u32x2 zraw[8];
            { const bf16_t* zrow = U + uoff(R0 + iq, C_ZA + 64 * hq + 4 * hh);
#pragma unroll
              for (int i = 0; i < 8; ++i) zraw[i] = *(const u32x2*)(zrow + 8 * i); }
            bf16x8 qf[4];
            {
                float qv[4][8]; float ss = 0.f;
#pragma unroll
                for (int ks = 0; ks < 4; ++ks) { const u32x4 w = qraw[qt][ks];
                    qv[ks][0] = bflo(w.x); qv[ks][1] = bfhi(w.x); qv[ks][2] = bflo(w.y); qv[ks][3] = bfhi(w.y); qv[ks][4] = bflo(w.z); qv[ks][5] = bfhi(w.z); qv[ks][6] = bflo(w.w); qv[ks][7] = bfhi(w.w);
#pragma unroll
                    for (int i = 0; i < 8; ++i) ss += qv[ks][i] * qv[ks][i]; }
                ss += __shfl_xor(ss, 32);
                const float rs = __builtin_amdgcn_rsqf(ss * (1.f / 64.f) + EPS);
#pragma unroll
                for (int ks = 0; ks < 4; ++ks) { const f32x4 w0 = *(const LAS f32x4*)(qnw + 16 * ks + 8 * hh), w1 = *(const LAS f32x4*)(qnw + 16 * ks + 8 * hh + 4);
                    u32x4 p; p.x = pk2(qv[ks][0] * rs * w0.x, qv[ks][1] * rs * w0.y); p.y = pk2(qv[ks][2] * rs * w0.z, qv[ks][3] * rs * w0.w);
                    p.z = pk2(qv[ks][4] * rs * w1.x, qv[ks][5] * rs * w1.y); p.w = pk2(qv[ks][6] * rs * w1.z, qv[ks][7] * rs * w1.w);
                    qf[ks] = __builtin_bit_cast(bf16x8, p); }
            }
            f32x16 oacc[2];
#pragma unroll
            for (int dt = 0; dt < 2; ++dt)
#pragma unroll
                for (int r = 0; r < 16; ++r) oacc[dt][r] = 0.f;
            float lsum = 0.f;
            const int kk_n = (dry && MK_ABL == 1) ? 0 : 5;
#pragma unroll 1
            for (int kk = 0; kk < kk_n; ++kk) {
                const int j0 = i0 + 32 * kk;
                bf16x8 kfr[4]; u32x2 vfr[2][2][2]; float btv[16];
#pragma unroll
                for (int ks = 0; ks < 4; ++ks) kfr[ks] = *(const LAS bf16x8*)(Kn + (j0 + r32) * 72 + 16 * ks + 8 * hh);
                const LAS float* bt = bias2 + hq * 192 + (32 * kk + 4 * hh - r32 + 32);
#pragma unroll
                for (int r = 0; r < 16; ++r) btv[r] = bt[(r & 3) + 8 * (r >> 2)];
                {   const int i16 = lane & 15, dsub = ((lane >> 4) & 1) * 16;
                    const LAS bf16_t* vb = Vn + (j0 + 4 * hh + (i16 >> 2)) * 72 + dsub + 4 * (i16 & 3);
#pragma unroll
                    for (int s2 = 0; s2 < 2; ++s2)
#pragma unroll
                        for (int dt = 0; dt < 2; ++dt) { vfr[s2][dt][0] = lds_tr16(vb + (16 * s2) * 72 + 32 * dt); vfr[s2][dt][1] = lds_tr16(vb + (16 * s2 + 8) * 72 + 32 * dt); }
                }
                __builtin_amdgcn_sched_barrier(0);
                f32x16 sacc;
#pragma unroll
                for (int r = 0; r < 16; ++r) sacc[r] = 0.f;
#pragma unroll
                for (int ks = 0; ks < 4; ++ks) sacc = mfma32(kfr[ks], qf[ks], sacc);
                float p[16];
#pragma unroll
                for (int r = 0; r < 16; ++r) p[r] = __builtin_amdgcn_exp2f(sacc[r] + btv[r]);
                if (blk == 0) {
#pragma unroll
                    for (int r = 0; r < 16; ++r) if (j0 + (r & 3) + 8 * (r >> 2) + 4 * hh < 128) p[r] = 0.f;
                }
#pragma unroll
                for (int r = 0; r < 16; ++r) lsum += p[r];
                u32x4 pw0, pw1;
                pw0.x = pk2(p[0], p[1]); pw0.y = pk2(p[2], p[3]); pw0.z = pk2(p[4], p[5]); pw0.w = pk2(p[6], p[7]);
                pw1.x = pk2(p[8], p[9]); pw1.y = pk2(p[10], p[11]); pw1.z = pk2(p[12], p[13]); pw1.w = pk2(p[14], p[15]);
                const bf16x8 pf0 = __builtin_bit_cast(bf16x8, pw0), pf1 = __builtin_bit_cast(bf16x8, pw1);
#pragma unroll
                for (int dt = 0; dt < 2; ++dt) {
                    u32x4 a0; a0.x = vfr[0][dt][0].x; a0.y = vfr[0][dt][0].y; a0.z = vfr[0][dt][1].x; a0.w = vfr[0][dt][1].y;
                    u32x4 a1; a1.x = vfr[1][dt][0].x; a1.y = vfr[1][dt][0].y; a1.z = vfr[1][dt][1].x; a1.w = vfr[1][dt][1].y;
                    oacc[dt] = mfma32(__builtin_bit_cast(bf16x8, a0), pf0, oacc[dt]);
                    oacc[dt] = mfma32(__builtin_bit_cast(bf16x8, a1), pf1, oacc[dt]);
                }
            }
            lsum += __shfl_xor(lsum, 32);
            const float rl = __builtin_amdgcn_rcpf(lsum + __builtin_amdgcn_exp2f(sink2 - m2));
#pragma unroll
            for (int dt = 0; dt < 2; ++dt)
#pragma unroll
                for (int g4 = 0; g4 < 4; ++g4) {
                    const u32x2 zz = zraw[4 * dt + g4];
                    u32x2 o; o.x = pk2(oacc[dt][4 * g4] * rl * silu_f(bflo(zz.x)), oacc[dt][4 * g4 + 1] * rl * silu_f(bfhi(zz.x))); o.y = pk2(oacc[dt][4 * g4 + 2] * rl * silu_f(bflo(zz.y)), oacc[dt][4 * g4 + 3] * rl * silu_f(bfhi(zz.y)));
                    if (!dry || o.x == 0x12345678u) *(u32x2*)(qrow + 32 * dt + 8 * g4 + 4 * hh) = o;
                }
        }
        unit = nxt;
        __syncthreads();
        AMPE(211); AMPB(210);
    }
#undef AMPB
#undef AMPE
}
__device__ __forceinline__ float attn_shift(const Args& a, int lane, float& bmax2) {
    float wq = fabsf(a.q_norm_w[lane]), wk = fabsf(a.k_norm_w[lane]);
    float rb = 0.f;
    for (int i = lane; i < 512; i += 64) rb = fmaxf(rb, fabsf(a.rel_table[i]));
    if (lane < 16) rb = fmaxf(rb, fabsf(a.sinks[lane]));
#pragma unroll
    for (int o = 1; o < 64; o <<= 1) { wq = fmaxf(wq, __shfl_xor(wq, o)); wk = fmaxf(wk, __shfl_xor(wk, o)); rb = fmaxf(rb, __shfl_xor(rb, o)); }
    bmax2 = rb * LOG2E;
    return (8.0f * wq * wk + rb) * LOG2E;
}

__device__ __forceinline__ void samp_ssm_item(const Args& a, LAS unsigned char* lds, int item, int tid, int wave, int lane, const bool dry) {
    const int b = item >> 1, g = item & 1;
    const int Rs = MP + 4 * b;
    bf16_t* U = (bf16_t*)(a.ws + WS_U); const float* DT = (const float*)(a.ws + WS_DT);
    LAS float* xs = (LAS float*)lds;
    LAS float* Bs = xs + 2048;
    LAS float* Cs = Bs + 512;
    LAS float* gy = Cs + 512;
    LAS float* dts = gy + 2048;
    LAS float* avs = dts + 32;
    LAS float* rstd_s = avs + 32;
    LAS bf16_t* zs = (LAS bf16_t*)(rstd_s + 4);
    __syncthreads();
    for (int cc = tid; cc < 768; cc += NT) {
        int ch; LAS float* dst;
        if (cc < 512) { ch = 512 * g + cc; dst = xs + cc; } else if (cc < 640) { ch = 1024 + 128 * g + (cc - 512); dst = Bs + (cc - 512); } else { ch = 1280 + 128 * g + (cc - 640); dst = Cs + (cc - 640); }
        const int stride = (cc < 512) ? 512 : 128;
        const float w0 = a.conv_w[ch], w1 = a.conv_w[CONVD + ch], w2 = a.conv_w[2 * CONVD + ch], w3 = a.conv_w[3 * CONVD + ch], cb = a.conv_b[ch];
        const float* sc = a.state_conv + (size_t)b * 3 * CONVD + ch;
        float f[7]; f[0] = sc[0]; f[1] = sc[CONVD]; f[2] = sc[2 * CONVD];
#pragma unroll
        for (int t = 0; t < 4; ++t) f[3 + t] = bf2f(U[uoff(Rs + t, C_X + ch)]);
#pragma unroll
        for (int t = 0; t < 4; ++t) dst[t * stride] = silu_f(cb + w0 * f[t] + w1 * f[t + 1] + w2 * f[t + 2] + w3 * f[t + 3]);
    }
    if (tid < 256) { const int t = tid >> 6, c8 = tid & 63; *(LAS u32x4*)(zs + t * 512 + 8 * c8) = *(const u32x4*)(U + uoff(Rs + t, C_Z + 512 * g + 8 * c8)); }
    if (tid < 32) { const int e = tid >> 2, t = tid & 3, h = 8 * g + e; const float d = softplus_f(DT[(size_t)(Rs + t) * 16 + h] + a.dt_bias[h]); dts[tid] = d; avs[tid] = d * (-expf(a.a_log[h])); }
    __syncthreads();
    const int p = tid >> 3, nq = tid & 7;
    f32x4 Sn[4];
    { const float* sp0 = a.state_ssm + ((size_t)(b * 16 + 8 * g) * 64 + p) * 128 + 4 * nq;
#pragma unroll
      for (int i = 0; i < 4; ++i) Sn[i] = __builtin_nontemporal_load((const f32x4*)(sp0 + 32 * i)); }
#pragma unroll 1
    for (int e = 0; e < 8; ++e) {
        const int h = 8 * g + e;
        f32x4 S[4];
#pragma unroll
        for (int i = 0; i < 4; ++i) S[i] = Sn[i];
        if (e < 7) { const float* sp = a.state_ssm + ((size_t)(b * 16 + h + 1) * 64 + p) * 128 + 4 * nq;
#pragma unroll
            for (int i = 0; i < 4; ++i) Sn[i] = __builtin_nontemporal_load((const f32x4*)(sp + 32 * i)); }
        float yv[4];
#pragma unroll
        for (int t = 0; t < 4; ++t) {
            const float dA = __expf(avs[e * 4 + t]); const float coef = dts[e * 4 + t] * xs[t * 512 + 64 * e + p];
            float acc = 0.f;
#pragma unroll
            for (int i = 0; i < 4; ++i) { const f32x4 Bv = *(const LAS f32x4*)(Bs + t * 128 + 4 * nq + 32 * i), Cv = *(const LAS f32x4*)(Cs + t * 128 + 4 * nq + 32 * i);
                S[i] = S[i] * dA + coef * Bv; acc += (Cv.x * S[i].x + Cv.y * S[i].y) + (Cv.z * S[i].z + Cv.w * S[i].w); }
            acc += __shfl_xor(acc, 1); acc += __shfl_xor(acc, 2); acc += __shfl_xor(acc, 4);
            yv[t] = acc;
        }
        float* op = a.out + O_SS + ((size_t)(b * 16 + h) * 64 + p) * 128 + 4 * nq;
#pragma unroll
        for (int i = 0; i < 4; ++i) if (!dry || S[i].x == 12345.678f) __builtin_nontemporal_store(S[i], (f32x4*)(op + 32 * i));
        if (nq < 4) { const int t = nq; const float xv = xs[t * 512 + 64 * e + p];
            const float yt = (nq == 0) ? yv[0] : (nq == 1) ? yv[1] : (nq == 2) ? yv[2] : yv[3];
            const float y = yt + a.d_skip[h] * xv; const float z = bf2f(zs[t * 512 + 64 * e + p]);
            gy[t * 512 + 64 * e + p] = y * silu_f(z); }
    }
    __syncthreads();
    if (wave < 4) { float s = 0.f;
#pragma unroll
        for (int i = 0; i < 8; ++i) { const float v = gy[wave * 512 + lane + 64 * i]; s += v * v; }
        s = wave_sum(s); if (lane == 0) rstd_s[wave] = __builtin_amdgcn_rsqf(s * (1.f / 512.f) + EPS); }
    __syncthreads();
    {
#pragma unroll
        for (int t = 0; t < 4; ++t) { const int i = tid + NT * t;
            const unsigned ov = f2bf(gy[i] * rstd_s[t]); if (!dry || ov == 0x12345u) U[uoff(Rs + t, C_Z + 512 * g + tid)] = (bf16_t)ov; } }
}

struct SampAttnRegs { f32x4 k[4], v[4]; unsigned kx, vx, q0, q1; };
__device__ __forceinline__ void samp_attn_load(const Args& a, const bf16_t* U, int item, int tid, int wave, int lane, SampAttnRegs& r) {
    const int b = item >> 2, kvh = item & 3, Rs = MP + 4 * b;
    const int w = tid >> 2, qd = tid & 3;
    const float* kp = a.cache_k + ((size_t)(b * 128 + w) * 4 + kvh) * 64 + 16 * qd; const float* vp = a.cache_v + ((size_t)(b * 128 + w) * 4 + kvh) * 64 + 16 * qd;
#pragma unroll
    for (int i = 0; i < 4; ++i) { r.k[i] = __builtin_nontemporal_load((const f32x4*)(kp + 4 * i)); r.v[i] = __builtin_nontemporal_load((const f32x4*)(vp + 4 * i)); }
    const int t = wave & 3;
    r.kx = U[uoff(Rs + t, C_K + 64 * kvh + lane)]; r.vx = U[uoff(Rs + t, C_V + 64 * kvh + lane)];
    { const int qi = 2 * wave, gq = qi >> 2, tt = qi & 3; r.q0 = U[uoff(Rs + tt, C_Q + 64 * (4 * kvh + gq) + lane)]; }
    { const int qi = 2 * wave + 1, gq = qi >> 2, tt = qi & 3; r.q1 = U[uoff(Rs + tt, C_Q + 64 * (4 * kvh + gq) + lane)]; }
}
__device__ __forceinline__ void samp_attn_phase(const Args& a, LAS unsigned char* lds, int bx, int G, int tid, int wave, int lane, const bool dry, float bmax2) {
    bf16_t* U = (bf16_t*)(a.ws + WS_U);
    LAS bf16_t* Kn = (LAS bf16_t*)lds;
    LAS bf16_t* Vn = (LAS bf16_t*)(lds + 23040);
    LAS float* tb = (LAS float*)(lds + 46080);
    LAS f32x4* redo = (LAS f32x4*)(lds + 49152);
    LAS float* redl = (LAS float*)(lds + 69632);
    LAS unsigned* kmx = (LAS unsigned*)(lds + 70912);
    LAS float* rts = (LAS float*)(lds + 70928);
    int item = bx; if (item >= 512) return;
    SampAttnRegs rg; samp_attn_load(a, U, item, tid, wave, lane, rg);
    __syncthreads();
    for (int i = tid; i < 28 * 72 / 8; i += NT) { *(LAS u32x4*)(Kn + 132 * 72 + 8 * i) = (u32x4){0u, 0u, 0u, 0u}; *(LAS u32x4*)(Vn + 132 * 72 + 8 * i) = (u32x4){0u, 0u, 0u, 0u}; }
    { int t2 = tid; asm volatile("" : "+v"(t2)); rts[t2] = a.rel_table[t2]; }
    __syncthreads();
    const int fr = lane & 15, grp = lane >> 4;
    while (item < 512) {
        const int b = item >> 2, kvh = item & 3;
        const int Rs = MP + 4 * b;
        if (tid == 0) kmx[0] = 0u;
        for (int i = tid; i < 4 * 168; i += NT) { const int gq = i / 168, u = (i % 168) - 3, d = 128 - u; tb[i] = (d >= 0 && d <= 128) ? rts[rel_bucket(d) * 16 + 4 * kvh + gq] * LOG2E : -1e30f; }
        __syncthreads();
        float k2 = 0.f;
        {
            const int w = tid >> 2, qd = tid & 3;
#pragma unroll
            for (int i = 0; i < 4; ++i) k2 += (rg.k[i].x * rg.k[i].x + rg.k[i].y * rg.k[i].y) + (rg.k[i].z * rg.k[i].z + rg.k[i].w * rg.k[i].w);
            u32x4 k0, k1, v0, v1;
            k0.x = pk2(rg.k[0].x, rg.k[0].y); k0.y = pk2(rg.k[0].z, rg.k[0].w); k0.z = pk2(rg.k[1].x, rg.k[1].y); k0.w = pk2(rg.k[1].z, rg.k[1].w);
            k1.x = pk2(rg.k[2].x, rg.k[2].y); k1.y = pk2(rg.k[2].z, rg.k[2].w); k1.z = pk2(rg.k[3].x, rg.k[3].y); k1.w = pk2(rg.k[3].z, rg.k[3].w);
            v0.x = pk2(rg.v[0].x, rg.v[0].y); v0.y = pk2(rg.v[0].z, rg.v[0].w); v0.z = pk2(rg.v[1].x, rg.v[1].y); v0.w = pk2(rg.v[1].z, rg.v[1].w);
            v1.x = pk2(rg.v[2].x, rg.v[2].y); v1.y = pk2(rg.v[2].z, rg.v[2].w); v1.z = pk2(rg.v[3].x, rg.v[3].y); v1.w = pk2(rg.v[3].z, rg.v[3].w);
            *(LAS u32x4*)(Kn + w * 72 + 16 * qd) = k0; *(LAS u32x4*)(Kn + w * 72 + 16 * qd + 8) = k1;
            *(LAS u32x4*)(Vn + w * 72 + 16 * qd) = v0; *(LAS u32x4*)(Vn + w * 72 + 16 * qd + 8) = v1;
            k2 += __shfl_xor(k2, 1); k2 += __shfl_xor(k2, 2);
        }
        if (wave < 4) {
            const int t = wave;
            const float kx = bf2f(rg.kx), vx = bf2f(rg.vx);
            const float ss = wave_sum(kx * kx); const float kn = kx * __builtin_amdgcn_rsqf(ss * (1.f / 64.f) + EPS) * a.k_norm_w[lane];
            Kn[(128 + t) * 72 + lane] = (bf16_t)f2bf(kn); Vn[(128 + t) * 72 + lane] = (bf16_t)rg.vx;
            k2 = fmaxf(k2, wave_sum(kn * kn));
            if (!dry) { a.out[O_KS + ((size_t)(b * 128 + 124 + t) * 4 + kvh) * 64 + lane] = kn; a.out[O_VS + ((size_t)(b * 128 + 124 + t) * 4 + kvh) * 64 + lane] = vx; }
        }
#pragma unroll
        for (int o = 1; o < 64; o <<= 1) k2 = fmaxf(k2, __shfl_xor(k2, o));
        if (lane == 0) (void)__hip_atomic_fetch_max(kmx, __builtin_bit_cast(unsigned, k2), __ATOMIC_RELAXED, __HIP_MEMORY_SCOPE_WORKGROUP);
        bf16x8 qf[2]; float qn2 = 0.f;
        const int tq = fr & 3, hq = 4 * kvh + (fr >> 2);
        if (wave < 5) {
            const bf16_t* qrow = U + uoff(Rs + tq, C_Q + 64 * hq + 8 * grp);
            const u32x4 w0 = *(const u32x4*)(qrow), w1 = *(const u32x4*)(qrow + 32);
            float qv[16] = {bflo(w0.x), bfhi(w0.x), bflo(w0.y), bfhi(w0.y), bflo(w0.z), bfhi(w0.z), bflo(w0.w), bfhi(w0.w),
                            bflo(w1.x), bfhi(w1.x), bflo(w1.y), bfhi(w1.y), bflo(w1.z), bfhi(w1.z), bflo(w1.w), bfhi(w1.w)};
            float ss = 0.f;
#pragma unroll
            for (int i = 0; i < 16; ++i) ss += qv[i] * qv[i];
            ss += __shfl_xor(ss, 16); ss += __shfl_xor(ss, 32);
            const float rs = (0.125f * LOG2E) * __builtin_amdgcn_rsqf(ss * (1.f / 64.f) + EPS);
#pragma unroll
            for (int i = 0; i < 16; ++i) { qv[i] *= rs * a.q_norm_w[(i < 8 ? 0 : 32) + 8 * grp + (i & 7)]; qn2 += qv[i] * qv[i]; }
            qn2 += __shfl_xor(qn2, 16); qn2 += __shfl_xor(qn2, 32);
            u32x4 p0, p1;
            p0.x = pk2(qv[0], qv[1]); p0.y = pk2(qv[2], qv[3]); p0.z = pk2(qv[4], qv[5]); p0.w = pk2(qv[6], qv[7]);
            p1.x = pk2(qv[8], qv[9]); p1.y = pk2(qv[10], qv[11]); p1.z = pk2(qv[12], qv[13]); p1.w = pk2(qv[14], qv[15]);
            qf[0] = __builtin_bit_cast(bf16x8, p0); qf[1] = __builtin_bit_cast(bf16x8, p1);
        }
        const int nxt = item + G;
        if (nxt < 512) samp_attn_load(a, U, nxt, tid, wave, lane, rg);
        __syncthreads();
        const float mq = sqrtf(qn2 * __builtin_bit_cast(float, kmx[0])) + bmax2;
        if (wave < 5) {
            const int j0 = 32 * wave;
            bf16x8 kfr[2][2]; u32x2 vlo[4], vhi[4]; float btv[8];
#pragma unroll
            for (int ks = 0; ks < 2; ++ks) { kfr[0][ks] = *(const LAS bf16x8*)(Kn + (j0 + fr) * 72 + 32 * ks + 8 * grp); kfr[1][ks] = *(const LAS bf16x8*)(Kn + (j0 + 16 + fr) * 72 + 32 * ks + 8 * grp); }
            const LAS float* bt = tb + (fr >> 2) * 168 + (j0 + 4 * grp - tq + 3);
#pragma unroll
            for (int r = 0; r < 4; ++r) { btv[r] = bt[r]; btv[4 + r] = bt[16 + r]; }
#pragma unroll
            for (int dt = 0; dt < 4; ++dt) { vlo[dt] = lds_tr16(Vn + (j0 + 4 * grp + (fr >> 2)) * 72 + 16 * dt + 4 * (fr & 3)); vhi[dt] = lds_tr16(Vn + (j0 + 16 + 4 * grp + (fr >> 2)) * 72 + 16 * dt + 4 * (fr & 3)); }
            __builtin_amdgcn_sched_barrier(0);
            f32x4 s0 = (f32x4){0.f, 0.f, 0.f, 0.f}, s1 = (f32x4){0.f, 0.f, 0.f, 0.f};
#pragma unroll
            for (int ks = 0; ks < 2; ++ks) { s0 = mfma16(kfr[0][ks], qf[ks], s0); s1 = mfma16(kfr[1][ks], qf[ks], s1); }
            float p[8]; float lsum = 0.f;
#pragma unroll
            for (int r = 0; r < 4; ++r) { p[r] = __builtin_amdgcn_exp2f(s0[r] + btv[r] - mq); p[4 + r] = __builtin_amdgcn_exp2f(s1[r] + btv[4 + r] - mq); }
#pragma unroll
            for (int r = 0; r < 8; ++r) lsum += p[r];
            u32x4 pw; pw.x = pk2(p[0], p[1]); pw.y = pk2(p[2], p[3]); pw.z = pk2(p[4], p[5]); pw.w = pk2(p[6], p[7]);
            const bf16x8 pf = __builtin_bit_cast(bf16x8, pw);
#pragma unroll
            for (int dt = 0; dt < 4; ++dt) {
                u32x4 aw; aw.x = vlo[dt].x; aw.y = vlo[dt].y; aw.z = vhi[dt].x; aw.w = vhi[dt].y;
                redo[(wave * 4 + dt) * 64 + lane] = mfma16(__builtin_bit_cast(bf16x8, aw), pf, (f32x4){0.f, 0.f, 0.f, 0.f});
            }
            redl[wave * 64 + lane] = lsum;
        }
        __syncthreads();
        if (wave < 4) {
            const int dt = wave;
            f32x4 o = redo[(0 * 4 + dt) * 64 + lane]; float l = redl[lane];
#pragma unroll
            for (int k5 = 1; k5 < 5; ++k5) { o += redo[(k5 * 4 + dt) * 64 + lane]; l += redl[k5 * 64 + lane]; }
            l += __shfl_xor(l, 16); l += __shfl_xor(l, 32);
            const float rl = __builtin_amdgcn_rcpf(l + __builtin_amdgcn_exp2f(a.sinks[hq] * LOG2E - mq));
            const u32x2 zz = *(const u32x2*)(U + uoff(Rs + tq, C_ZA + 64 * hq + 16 * dt + 4 * grp));
            u32x2 ov; ov.x = pk2(o[0] * rl * silu_f(bflo(zz.x)), o[1] * rl * silu_f(bfhi(zz.x))); ov.y = pk2(o[2] * rl * silu_f(bflo(zz.y)), o[3] * rl * silu_f(bfhi(zz.y)));
            if (!dry || ov.x == 0x12345678u) *(u32x2*)(U + uoff(Rs + tq, C_Q + 64 * hq + 16 * dt + 4 * grp)) = ov;
        }
        item = nxt;
    }
}
__device__ __forceinline__ void cache_shift_copy(const Args& a, int it, int tid) {
    const int b = it >> 1; const float* src = (it & 1) ? a.cache_v : a.cache_k; float* dst = a.out + ((it & 1) ? O_VS : O_KS);
    const f32x4* s4 = (const f32x4*)(src + (size_t)(b * 128 + 4) * 256); f32x4* d4 = (f32x4*)(dst + (size_t)(b * 128) * 256);
#pragma unroll 8
    for (int i = tid; i < 124 * 64; i += NT) __builtin_nontemporal_store(__builtin_nontemporal_load(s4 + i), d4 + i);
}

__device__ __forceinline__ void conv_out_item(const Args& a, int item, int tid) {
    const bf16_t* U = (const bf16_t*)(a.ws + WS_U);
    for (int i = tid; i < 3 * CONVD; i += NT) {
        const int r = i / CONVD, ch = i % CONVD;
        if (item < NB) a.out[O_CP + (size_t)item * 3 * CONVD + i] = bf2f(((const bf16_t*)(a.ws + WS_HALO))[(size_t)((item * 64 + 63) * 3 + r) * CONVD + ch]);
        else { const int b = item - NB; a.out[O_CS + (size_t)b * 3 * CONVD + i] = bf2f(U[uoff(MP + 4 * b + 1 + r, C_X + ch)]); }
    }
}

__device__ __forceinline__ void samp_outproj_tile(const Args& a, LAS unsigned char* lds, int it, int tid, int wave, int lane, const XcdBarrier& xb, unsigned xold) {
    const bf16_t* U = (const bf16_t*)(a.ws + WS_U); const bf16_t* Wt = (const bf16_t*)(a.ws + WS_WOUT);
    LAS bf16_t* T = (LAS bf16_t*)lds;
    LAS f32x4* red = (LAS f32x4*)(lds + 131584);
    const int r0 = 32 * (it >> 4), c0 = 64 * (it & 15);
    const int fr = lane & 15, grp = lane >> 4, kh = wave >> 2, cg = wave & 3;
    __syncthreads();
    const bf16_t* wp = Wt + (size_t)(c0 + 16 * cg + fr) * 2048 + 1024 * kh + 8 * grp;
    const LAS bf16_t* tp = T + fr * 2056 + 1024 * kh + 8 * grp;
    bf16x8 wa[16], wb[16];
#pragma unroll
    for (int i = 0; i < 16; ++i) wa[i] = *(const bf16x8*)(wp + 32 * i);
    {   u32x4 tv[16];
#pragma unroll
        for (int i = 0; i < 16; ++i) { const int ci = tid + NT * i, row = ci >> 8, k = 8 * (ci & 255);
            tv[i] = *(const u32x4*)(U + uoff(MP + r0 + row, (k < 1024 ? C_Z + k : C_Q + (k - 1024)))); }
        xcd_arrive_end(xb, xold);
#pragma unroll
        for (int i = 0; i < 16; ++i) { const int ci = tid + NT * i, row = ci >> 8, k = 8 * (ci & 255); *(LAS u32x4*)(T + row * 2056 + k) = tv[i]; }
    }
#pragma unroll
    for (int i = 0; i < 16; ++i) wb[i] = *(const bf16x8*)(wp + 32 * (16 + i));
    f32x4 acc0 = (f32x4){0.f, 0.f, 0.f, 0.f}, acc1 = (f32x4){0.f, 0.f, 0.f, 0.f};
    const size_t o0 = (size_t)(r0 + fr) * DM + c0 + 16 * cg + 4 * grp, o1 = o0 + (size_t)16 * DM;
    f32x4 xr0 = (f32x4){0.f, 0.f, 0.f, 0.f}, xr1 = xr0;
    if (!kh) { xr0 = *(const f32x4*)(a.x_sample + o0); xr1 = *(const f32x4*)(a.x_sample + o1); }
    __syncthreads();
#pragma unroll
    for (int i = 0; i < 16; ++i) { const bf16x8 t0 = *(const LAS bf16x8*)(tp + 32 * i), t1 = *(const LAS bf16x8*)(tp + 16 * 2056 + 32 * i);
        acc0 = mfma16(wa[i], t0, acc0); acc1 = mfma16(wa[i], t1, acc1); }
#pragma unroll
    for (int i = 0; i < 16; ++i) { const int ks = 16 + i; const bf16x8 t0 = *(const LAS bf16x8*)(tp + 32 * ks), t1 = *(const LAS bf16x8*)(tp + 16 * 2056 + 32 * ks);
        acc0 = mfma16(wb[i], t0, acc0); acc1 = mfma16(wb[i], t1, acc1); }
    if (kh) { red[(cg * 2 + 0) * 64 + lane] = acc0; red[(cg * 2 + 1) * 64 + lane] = acc1; }
    __syncthreads();
    if (!kh) {
        acc0 += red[(cg * 2 + 0) * 64 + lane]; acc1 += red[(cg * 2 + 1) * 64 + lane];
        *(f32x4*)(a.out + O_YS + o0) = xr0 + acc0;
        *(f32x4*)(a.out + O_YS + o1) = xr1 + acc1;
    }
}

__global__ void __launch_bounds__(NT, 2) mk_fwd(Args args) {
    extern __shared__ __attribute__((aligned(16))) unsigned char lds_raw[];
    LAS unsigned char* lds = (LAS unsigned char*)lds_raw;
    volatile LAS unsigned* MISC = (volatile LAS unsigned*)(lds + MISC_OFF);
    const int tid = threadIdx.x, lane = tid & 63, wave = __builtin_amdgcn_readfirstlane(tid >> 6);
    const int G = gridDim.x; const int bx = blockIdx.x; const int vcu = (G % 8 == 0) ? (bx % 8) * (G / 8) + bx / 8 : bx;
    gu32* ctl = (gu32*)(args.ws + WS_CTL);
    for (int u = tid; u < 512 / 4; u += NT) ((LAS unsigned*)(lds + MISC_OFF))[u] = 0u;
    __syncthreads();
    XcdBarrier bar; bar.bar = (unsigned*)(ctl + CW_BAR); bar.x = 0; bar.st = nullptr;
    if (MK_N_LAUNCHES == 1) bar = xcd_barrier_post((unsigned*)(ctl + CW_BAR), MISC + 8);
    const int lo = args.ph_lo, hi = args.ph_hi;
#define IN(k) (lo <= (k) && (k) < hi)
#define GRID_BAR() do { if (MK_N_LAUNCHES == 1) xcd_barrier(bar); } while (0)

    const bool dry = (args.dry != 0);
    unsigned long long amp_t = 0ull, amp_d = 0ull;
#define AMP_BEGIN(k) do { if (MK_AMP == (k)) amp_t = __builtin_amdgcn_s_memrealtime(); } while (0)
#define AMP_END(k) do { if (MK_AMP == (k)) amp_d += __builtin_amdgcn_s_memrealtime() - amp_t; } while (0)
    AMP_BEGIN(0);
    p0_prologue(args, lds, vcu, G, wave, lane, amp_d);
    float bmax2; const float m2 = attn_shift(args, lane, bmax2);
    AMP_BEGIN(102);
    { const unsigned ao = xcd_arrive_begin(bar); const float rt = args.rel_table[tid]; xcd_arrive_end(bar, ao);
      attn_tables(args, lds, tid, m2, rt); }
    xcd_wait(bar, 1u); AMP_END(102);
    AMP_END(0);

    AMP_BEGIN(1);
    {
        pg8::Gemm g{(const bf16_t*)(args.ws + WS_H), (const bf16_t*)(args.ws + WS_WIN), MT, NINP, DM, DM, 1 << 20, 0, (size_t)(pg8::BK * 2)};
        pg8::StaticOrder S; S.init(MT, NINP, G, bx);
        pg8::EpiU E{(bf16_t*)(args.ws + WS_U), (float*)(args.ws + WS_DT), (bf16_t*)(args.ws + WS_HALO)};
        pg8::gemm_phase<pg8::EpiU, pg8::StaticOrder, true>(lds, g, S, E);
        xcd_arrive(bar);
        { const int rem = S.nwg % G;
          if (rem == 0) { for (int it = bx; it < 2 * DB; it += G) cache_shift_copy(args, it, tid); }
          else if (bx >= rem) { for (int it = bx - rem; it < 2 * DB; it += G - rem) cache_shift_copy(args, it, tid); } }
        AMP_BEGIN(14); xcd_wait(bar, 2u); AMP_END(14);
    }
    AMP_END(1);

    AMP_BEGIN(2);
    AMP_BEGIN(20); for (int it = bx; it < 256; it += G) ssd_state_item(args, lds, it, tid, wave, lane); AMP_END(20);
    { const unsigned ao = xcd_arrive_begin(bar);
    AMP_BEGIN(21); attn_phase(args, lds, bx, 256, G, tid, wave, lane, m2, dry, amp_d, true, bar, ao); AMP_END(21); }
    AMP_BEGIN(22); for (int it = bx; it < 256; it += G) samp_ssm_item(args, lds, it, tid, wave, lane, dry); AMP_END(22);
    AMP_BEGIN(23); samp_attn_phase(args, lds, bx, G, tid, wave, lane, dry, bmax2); AMP_END(23);
    for (int it = bx; it < NB + DB; it += G) conv_out_item(args, it, tid);
    AMP_BEGIN(24); xcd_wait(bar, 3u); AMP_END(24);
    AMP_END(2);

    AMP_BEGIN(3);
    ssd_scan(args, lds, bx, G, tid, wave, lane, dry);
    { const unsigned ao = xcd_arrive_begin(bar);
    AMP_BEGIN(21); attn_phase(args, lds, 256 + bx, 512, G, tid, wave, lane, m2, dry, amp_d, false, bar, ao); AMP_END(21); }
    AMP_BEGIN(34); xcd_wait(bar, 4u); AMP_END(34);
    AMP_END(3);

    AMP_BEGIN(4);
    for (int it = bx; it < 256; it += G) ssd_out_item(args, lds, it, tid, wave, lane, dry);
    { unsigned ao = xcd_arrive_begin(bar); bool pend = true;
    AMP_BEGIN(50); for (int it = bx; it < 256; it += G) { samp_outproj_tile(args, lds, it, tid, wave, lane, bar, pend ? ao : XB_NONE); pend = false; } AMP_END(50);
      if (pend) xcd_arrive_end(bar, ao); }
    AMP_BEGIN(44); xcd_wait(bar, 5u); AMP_END(44);
    AMP_END(4);

    AMP_BEGIN(5);
    {
        pg8::Gemm g{(const bf16_t*)(args.ws + WS_U), (const bf16_t*)(args.ws + WS_WOUT), MP, DM, 2048, 64, 16, (size_t)(C_Q / 64 - 16) * MT * 128, (size_t)MT * 128};
        pg8::StaticOrder S; S.init(MP, DM, G, bx);
        pg8::EpiOut E{args.x_prompt, args.x_sample, args.out, (const float*)(args.ws + WS_RS)};
        pg8::gemm_phase<pg8::EpiOut, pg8::StaticOrder, false>(lds, g, S, E);
    }
    AMP_END(5);
    if (MK_AMP >= 0 && bx == MK_AMPBLK && tid == 0) {
        const unsigned long long t0 = __builtin_amdgcn_s_memrealtime();
        while (__builtin_amdgcn_s_memrealtime() - t0 < 4ull * amp_d) __builtin_amdgcn_s_sleep(8);
    }
#undef AMP_BEGIN
#undef AMP_END
#undef IN
#undef GRID_BAR
}

extern "C" void kernel_launch(void* const* d_in, const int* in_sizes, int n_in, void* d_out, int out_size, void* d_ws, size_t ws_size, hipStream_t stream) {
    static int grid = 0;
    if (grid == 0) {
        if (n_in != 19 || (size_t)out_size != O_END || ws_size < WS_END) { fprintf(stderr, "kernel_launch: unexpected shapes (n_in %d, out %d, ws %zu)\n", n_in, out_size, ws_size); grid = -1; return; }
        int dev = 0, cus = 0;
        if (hipGetDevice(&dev) != hipSuccess || hipDeviceGetAttribute(&cus, hipDeviceAttributeMultiprocessorCount, dev) != hipSuccess) { grid = -1; return; }
        if (hipFuncSetAttribute((const void*)mk_fwd, hipFuncAttributeMaxDynamicSharedMemorySize, LDS_BYTES) != hipSuccess) { fprintf(stderr, "kernel_launch: hipFuncSetAttribute failed\n"); grid = -1; return; }
        int per_cu = 0;
        if (hipOccupancyMaxActiveBlocksPerMultiprocessor(&per_cu, (const void*)mk_fwd, NT, LDS_BYTES) != hipSuccess || per_cu < 1) fprintf(stderr, "kernel_launch: occupancy query reports %d blocks per CU\n", per_cu);
        (void)hipGetLastError();
        grid = cus;
    }
    if (grid < 0) return;
    (void)hipMemsetAsync((char*)d_ws + WS_CTL + (size_t)CW_BAR * 4, 0, 14336, stream);
    Args a{};
    const float** ap = (const float**)&a;
    for (int i = 0; i < 19; ++i) ap[i] = (const float*)d_in[i];
    a.out = (float*)d_out; a.ws = (unsigned char*)d_ws;
    a.sub = 31; a.dry = 0; a.ph_lo = 0; a.ph_hi = 6;
    hipLaunchKernelGGL(mk_fwd, dim3(grid), dim3(NT), LDS_BYTES, stream, a);
}
```
